# Optimizing an MI355X kernel written in HIP

```python
import math
import jax, jax.numpy as jnp
from jax import lax
import numpy as np

D_MODEL = 2048
BATCH = 2
SEQ = 16384
DEPTH = 1

N_MEM = 256
HEAD_DIM = 128
N_ATTN_HEADS = 8
ATTN_WIDTH = N_ATTN_HEADS * HEAD_DIM
CONV_CH = D_MODEL // 2
MIX_WIDTH = ATTN_WIDTH + CONV_CH
IN_WIDTH = 3 * ATTN_WIDTH + 2 * CONV_CH
CONV_K = 31
MOBA_BLOCK = 256
MOBA_TOPK = 3
Q_CHUNK = 64
N_BUCKETS = 32
MAX_DISTANCE = 2048
N_CROSS_HEADS = 4
CROSS_HEAD_DIM = 128
CROSS_WIDTH = N_CROSS_HEADS * CROSS_HEAD_DIM
D_FF = 4 * D_MODEL
EPS = 1e-6

kernel_name = "hybrid_moba_conformer_xattn_block"


def rmsnorm(x, g):
    xf = x.astype(jnp.float32)
    y = xf * lax.rsqrt(jnp.mean(xf * xf, axis=-1, keepdims=True) + EPS)
    return (y * g.astype(jnp.float32)).astype(x.dtype)


def layernorm(x, g, b):
    xf = x.astype(jnp.float32)
    mu = jnp.mean(xf, axis=-1, keepdims=True)
    xc = xf - mu
    var = jnp.mean(xc * xc, axis=-1, keepdims=True)
    y = xc * lax.rsqrt(var + EPS) * g.astype(jnp.float32) + b.astype(jnp.float32)
    return y.astype(x.dtype)


def t5_bucket(dist):
    max_exact = N_BUCKETS // 2
    nf = jnp.maximum(dist, max_exact).astype(jnp.float32)
    large = max_exact + (jnp.log(nf / max_exact) / math.log(MAX_DISTANCE / max_exact)
                         * (N_BUCKETS - max_exact)).astype(jnp.int32)
    large = jnp.minimum(large, N_BUCKETS - 1)
    return jnp.where(dist < max_exact, dist, large)


def moba_attention(q, k, v, dist_bias):
    B, H, S, Dh = q.shape
    nb = -(-S // MOBA_BLOCK)
    pad = nb * MOBA_BLOCK - S
    kp = jnp.pad(k, ((0, 0), (0, 0), (0, pad), (0, 0)))
    vp = jnp.pad(v, ((0, 0), (0, 0), (0, pad), (0, 0)))
    kb = kp.reshape(B, H, nb, MOBA_BLOCK, Dh)
    vb = vp.reshape(B, H, nb, MOBA_BLOCK, Dh)
    kbar = jnp.mean(kb.astype(jnp.float32), axis=3)
    k_eff = min(MOBA_TOPK, nb)
    scale = HEAD_DIM ** -0.5
    bi = jnp.arange(B)[:, None, None, None]
    hi = jnp.arange(H)[None, :, None, None]
    blk_offs = jnp.arange(MOBA_BLOCK)

    def chunk(ci):
        start = ci * Q_CHUNK
        qc = lax.dynamic_slice_in_dim(q, start, Q_CHUNK, axis=2)
        own = start // MOBA_BLOCK
        qpos = start + jnp.arange(Q_CHUNK)
        gate = jnp.einsum('bhqd,bhnd->bhqn', qc.astype(jnp.float32), kbar)
        gate = jnp.where(jnp.arange(nb) < own, gate, -jnp.inf)
        _, idx = lax.top_k(gate, k_eff)
        valid = jnp.arange(k_eff) < own
        ks = kb[bi, hi, idx]
        vs = vb[bi, hi, idx]
        kpos = idx[..., None] * MOBA_BLOCK + blk_offs
        d_sel = jnp.maximum(qpos[:, None, None] - kpos, 0)
        s_sel = (jnp.einsum('bhqd,bhqjkd->bhqjk', qc, ks).astype(jnp.float32) * scale
                 + dist_bias[hi[..., None], d_sel])
        s_sel = jnp.where(valid[:, None], s_sel, -jnp.inf)
        s_sel = s_sel.reshape(B, H, Q_CHUNK, k_eff * MOBA_BLOCK)
        ko = lax.dynamic_slice_in_dim(kp, own * MOBA_BLOCK, MOBA_BLOCK, axis=2)
        vo = lax.dynamic_slice_in_dim(vp, own * MOBA_BLOCK, MOBA_BLOCK, axis=2)
        d_own = qpos[:, None] - (own * MOBA_BLOCK + blk_offs)[None, :]
        s_own = (jnp.einsum('bhqd,bhkd->bhqk', qc, ko).astype(jnp.float32) * scale
                 + dist_bias[:, jnp.maximum(d_own, 0)][None])
        s_own = jnp.where(d_own >= 0, s_own, -jnp.inf)
        p = jax.nn.softmax(jnp.concatenate([s_sel, s_own], axis=-1), axis=-1)
        p_sel = p[..., :k_eff * MOBA_BLOCK].reshape(B, H, Q_CHUNK, k_eff, MOBA_BLOCK)
        p_own = p[..., k_eff * MOBA_BLOCK:]
        out = (jnp.einsum('bhqjk,bhqjkd->bhqd', p_sel.astype(vs.dtype), vs)
               + jnp.einsum('bhqk,bhkd->bhqd', p_own.astype(vo.dtype), vo))
        return out.astype(q.dtype)

    outs = lax.map(chunk, jnp.arange(S // Q_CHUNK))
    return outs.transpose(1, 0, 3, 2, 4).reshape(B, S, H * Dh)


def conformer_conv(u, conv_w, conv_b, ln_g, ln_b):
    val, gt = jnp.split(u, 2, axis=-1)
    h = val * jax.nn.sigmoid(gt)
    h = lax.conv_general_dilated(h, conv_w[:, None, :].astype(h.dtype), window_strides=(1,),
                                 padding=[(CONV_K - 1, 0)],
                                 dimension_numbers=('NWC', 'WIO', 'NWC'),
                                 feature_group_count=CONV_CH) + conv_b
    h = layernorm(h, ln_g, ln_b)
    return jax.nn.silu(h)


def cross_attention(n, m, wq, wk, wv, wo):
    B, S, _ = n.shape
    M = m.shape[1]
    q = (n @ wq).reshape(B, S, N_CROSS_HEADS, CROSS_HEAD_DIM)
    k = (m @ wk).reshape(B, M, N_CROSS_HEADS, CROSS_HEAD_DIM)
    v = (m @ wv).reshape(B, M, N_CROSS_HEADS, CROSS_HEAD_DIM)
    s = jnp.einsum('bshd,bmhd->bhsm', q, k).astype(jnp.float32) * CROSS_HEAD_DIM ** -0.5
    p = jax.nn.softmax(s, axis=-1).astype(v.dtype)
    o = jnp.einsum('bhsm,bmhd->bshd', p, v).reshape(B, S, CROSS_WIDTH)
    return o @ wo


def setup_inputs(seed: int = 0) -> dict:
    key = jax.random.key(seed)
    ks = jax.random.split(key, 24)
    f32 = jnp.float32
    nrm = lambda k, shape, s: jax.random.normal(k, shape, f32) * s
    gain = lambda k, shape: 1.0 + 0.02 * jax.random.normal(k, shape, f32)
    L = DEPTH
    return {
        "x": jax.random.normal(ks[0], (BATCH, SEQ, D_MODEL), f32),
        "mem": jax.random.normal(ks[1], (BATCH, N_MEM, D_MODEL), f32),
        "g_mix": gain(ks[2], (L, D_MODEL)),
        "w_in": nrm(ks[3], (L, D_MODEL, IN_WIDTH), D_MODEL ** -0.5),
        "conv_w": nrm(ks[4], (L, CONV_K, CONV_CH), CONV_K ** -0.5),
        "conv_b": nrm(ks[5], (L, CONV_CH), 0.02),
        "conv_ln_g": gain(ks[6], (L, CONV_CH)),
        "conv_ln_b": nrm(ks[7], (L, CONV_CH), 0.02),
        "w_out": nrm(ks[8], (L, MIX_WIDTH, D_MODEL), MIX_WIDTH ** -0.5),
        "rel_bias": nrm(ks[9], (N_BUCKETS, N_ATTN_HEADS), 0.5),
        "g_cross": gain(ks[10], (L, D_MODEL)),
        "g_mem": gain(ks[11], (L, D_MODEL)),
        "wq_c": nrm(ks[12], (L, D_MODEL, CROSS_WIDTH), D_MODEL ** -0.5),
        "wk_c": nrm(ks[13], (L, D_MODEL, CROSS_WIDTH), D_MODEL ** -0.5),
        "wv_c": nrm(ks[14], (L, D_MODEL, CROSS_WIDTH), D_MODEL ** -0.5),
        "wo_c": nrm(ks[15], (L, CROSS_WIDTH, D_MODEL), CROSS_WIDTH ** -0.5),
        "g_mlp": gain(ks[16], (L, D_MODEL)),
        "w1": nrm(ks[17], (L, D_MODEL, D_FF), D_MODEL ** -0.5),
        "w2": nrm(ks[18], (L, D_FF, D_MODEL), D_FF ** -0.5),
        "g_final": gain(ks[19], (D_MODEL,)),
    }


def reference(x, mem, g_mix, w_in, conv_w, conv_b, conv_ln_g, conv_ln_b, w_out, rel_bias,
              g_cross, g_mem, wq_c, wk_c, wv_c, wo_c, g_mlp, w1, w2, g_final):
    B, S, _ = x.shape
    dist_bias = rel_bias[t5_bucket(jnp.arange(S))].T.astype(jnp.float32)

    def to_heads(t):
        return t.reshape(B, S, N_ATTN_HEADS, HEAD_DIM).transpose(0, 2, 1, 3)

    h = x
    for l in range(DEPTH):
        n = rmsnorm(h, g_mix[l])
        z = n @ w_in[l]
        q, k, v, u = jnp.split(z, [ATTN_WIDTH, 2 * ATTN_WIDTH, 3 * ATTN_WIDTH], axis=-1)
        a = moba_attention(to_heads(q), to_heads(k), to_heads(v), dist_bias)
        c = conformer_conv(u, conv_w[l], conv_b[l], conv_ln_g[l], conv_ln_b[l])
        h = h + jnp.concatenate([a, c], axis=-1) @ w_out[l]
        h = h + cross_attention(rmsnorm(h, g_cross[l]), rmsnorm(mem, g_mem[l]),
                                wq_c[l], wk_c[l], wv_c[l], wo_c[l])
        nm = rmsnorm(h, g_mlp[l])
        h = h + jnp.square(jax.nn.relu(nm @ w1[l])) @ w2[l]
    return rmsnorm(h, g_final)
```

```cpp
#include <hip/hip_runtime.h>
#include <cstdio>
#include <cstdint>
namespace pg8 {
#define PG8_LAS __attribute__((address_space(3)))
typedef unsigned short bf16_t;
typedef short bf16x8 __attribute__((ext_vector_type(8)));
typedef float f32x4 __attribute__((ext_vector_type(4)));
typedef unsigned u32x4 __attribute__((ext_vector_type(4)));
constexpr int BM = 256, BK = 64, HALF = 128, HTB = HALF * BK * 2  , STAGE_BYTES = 8 * HTB, NXCD = 8, WGM = 8;

__host__ __device__ __forceinline__ int lds_byte(int r, int c) { const int st = (r >> 4) * 2 + (c >> 5), rr = r & 15, cc = c & 31, ob = rr * 64 + cc * 2; return st * 1024 + (ob ^ (((ob >> 9) & 1) << 5)); }
__host__ __device__ __forceinline__ void stage_rc(int b, int& R, int& C) { const int st = b / 1024, sb = b % 1024, swz = sb ^ (((sb >> 9) & 1) << 5); R = (st >> 1) * 16 + swz / 64; C = (st & 1) * 32 + (swz % 64) / 2; }
__host__ __device__ __forceinline__ int perm32(int rho) { const int n = rho >> 4, i = rho & 15; return 8 * (i >> 2) + 4 * n + (i & 3); }

struct Unit { int pm, pn; };
struct Gemm { const bf16_t* A; const bf16_t* Bt; int M, N, K; };

struct StaticOrder {
    int nM, nN, nwg, G, c;
    __host__ __device__ void init(int M, int N, int G_, int c_) { nM = M / BM; nN = N / BM; nwg = nM * nN; G = G_; c = c_; }
    __host__ __device__ bool next(int i, Unit& u) const {
        const long L = (long)i * G + c; if (L >= nwg) return false;
        int wgid = (int)L; { const int q = nwg / NXCD, r = nwg % NXCD, xcd = wgid % NXCD, off = wgid / NXCD; wgid = (xcd < r ? xcd * (q + 1) : r * (q + 1) + (xcd - r) * q) + off; }
        const int nig = WGM * nN, gid = wgid / nig, fm = gid * WGM, gsz = (nM - fm) < WGM ? (nM - fm) : WGM;
        u.pm = fm + ((wgid % nig) % gsz); u.pn = (wgid % nig) / gsz; return true;
    }
    __device__ __forceinline__ void a_ready(const Unit&) const {}
    __device__ __forceinline__ void done(const Unit&) const {}
};

__device__ __forceinline__ unsigned cvt_pk_bf16(float lo, float hi) { unsigned r; asm volatile("v_cvt_pk_bf16_f32 %0, %1, %2" : "=v"(r) : "v"(lo), "v"(hi)); return r; }
typedef float f32x2 __attribute__((ext_vector_type(2)));
__device__ __forceinline__ f32x2 gelu_pk(f32x2 v) {
    const f32x2 av = __builtin_elementwise_abs(v), d = av * 0.2316418882f + 1.0f;
    f32x2 t; t.x = __builtin_amdgcn_rcpf(d.x); t.y = __builtin_amdgcn_rcpf(d.y);
    f32x2 q = t * 0.5307027145f + (-0.7265760135f); q = q * t + 0.7107068705f; q = q * t + (-0.142248368f); q = q * t + 0.127414796f; q = q * t;
    const f32x2 s = (v * v) * (-0.72134752044f);
    f32x2 e; e.x = __builtin_amdgcn_exp2f(s.x); e.y = __builtin_amdgcn_exp2f(s.y);
    const f32x2 m = v * (q * e), r = v - m;
    f32x2 o; o.x = v.x < 0.f ? m.x : r.x; o.y = v.y < 0.f ? m.y : r.y; return o;
}


__device__ __forceinline__ unsigned short bf16_1(float v) { return (unsigned short)(cvt_pk_bf16(v, v) & 0xffffu); }
template <int ACT  , int RS = 0  > struct EpiBf16X {
    static constexpr bool PERM = true, AFTER_DRAIN = false;
    bf16_t* O; int ldc; int split_cols; size_t split_stride; int tr_tile; bf16_t* OT; int seqlen; int nheads; const float* ssq;
    __device__ __forceinline__ void operator()(const f32x4 (&acc)[2][2][4][2], const Unit& u, int wr, int wc, int fr, int fq) const {
        const int row0 = u.pm * BM + wr * 64 + fr; int colt = u.pn * BM; bf16_t* base = O; int t = 0;
        if (split_cols) { t = colt / split_cols; base += (size_t)t * split_stride; colt -= t * split_cols; }
        const int col0 = colt + wc * 32 + 8 * fq;
        if (RS == 0 && t == tr_tile) {
#pragma unroll
            for (int ai = 0; ai < 2; ++ai)
#pragma unroll
                for (int m = 0; m < 4; ++m) { const int row = row0 + ai * HALF + m * 16; const int b = row / seqlen, s = row - b * seqlen;
#pragma unroll
                    for (int bj = 0; bj < 2; ++bj)
#pragma unroll
                        for (int n = 0; n < 2; ++n)
#pragma unroll
                            for (int j = 0; j < 4; ++j) { const int col = col0 + bj * HALF + 4 * n + j; const int hh = col >> 7, d = col & 127;
                                OT[((size_t)(b * nheads + hh) * 128 + d) * (size_t)seqlen + s] = bf16_1(acc[ai][bj][m][n][j]); } }
        } else {
#pragma unroll
            for (int ai = 0; ai < 2; ++ai)
#pragma unroll
                for (int m = 0; m < 4; ++m) { bf16_t* rowp = base + (size_t)(row0 + ai * HALF + m * 16) * ldc + col0;
                    float rsc = 1.f;
                    if (RS) { const float r = 1.0f / sqrtf(ssq[row0 + ai * HALF + m * 16] * (1.0f / 2048.0f) + 1e-6f); rsc = (ACT == 2) ? r * r : r; }
#pragma unroll
                    for (int bj = 0; bj < 2; ++bj) { f32x4 v0 = acc[ai][bj][m][0], v1 = acc[ai][bj][m][1];
                        if (RS && ACT != 2) { v0 = v0 * rsc; v1 = v1 * rsc; }
                        if (ACT == 2) {
#pragma unroll
                            for (int j = 0; j < 4; ++j) { float a = v0[j] > 0.f ? v0[j] : 0.f; v0[j] = a * a * rsc; float b = v1[j] > 0.f ? v1[j] : 0.f; v1[j] = b * b * rsc; } }
                        u32x4 w; w.x = cvt_pk_bf16(v0[0], v0[1]); w.y = cvt_pk_bf16(v0[2], v0[3]); w.z = cvt_pk_bf16(v1[0], v1[1]); w.w = cvt_pk_bf16(v1[2], v1[3]);
                        *(u32x4*)(rowp + bj * HALF) = w; } }
        }
    }
};
struct EpiResNorm {
    static constexpr bool PERM = false, AFTER_DRAIN = false;
    const float* base; float* out; int ldc; const float* gain; bf16_t* HG; float* ssq;
    __device__ __forceinline__ void operator()(const f32x4 (&acc)[2][2][4][2], const Unit& u, int wr, int wc, int fr, int fq) const {
        const int row0 = u.pm * BM + wr * 64 + fr, col0 = u.pn * BM + wc * 32 + 4 * fq;
        f32x4 gv[2][2];
#pragma unroll
        for (int bj = 0; bj < 2; ++bj)
#pragma unroll
            for (int n = 0; n < 2; ++n) gv[bj][n] = *(const f32x4*)(gain + col0 + bj * HALF + n * 16);
#pragma unroll
        for (int ai = 0; ai < 2; ++ai)
#pragma unroll
            for (int m = 0; m < 4; ++m) { const int row = row0 + ai * HALF + m * 16; const size_t off = (size_t)row * ldc + col0; float sq = 0.f;
#pragma unroll
                for (int bj = 0; bj < 2; ++bj)
#pragma unroll
                    for (int n = 0; n < 2; ++n) { const f32x4 h = *(const f32x4*)(base + off + bj * HALF + n * 16) + acc[ai][bj][m][n]; *(f32x4*)(out + off + bj * HALF + n * 16) = h;
                        sq += (h[0] * h[0] + h[1] * h[1]) + (h[2] * h[2] + h[3] * h[3]);
                        const f32x4 hg = h * gv[bj][n]; unsigned w0 = cvt_pk_bf16(hg[0], hg[1]), w1 = cvt_pk_bf16(hg[2], hg[3]);
                        typedef unsigned u32x2v __attribute__((ext_vector_type(2))); u32x2v w; w.x = w0; w.y = w1; *(u32x2v*)(HG + off + bj * HALF + n * 16) = w; }
                sq += __shfl_xor(sq, 16); sq += __shfl_xor(sq, 32);
                if (fq == 0) unsafeAtomicAdd(ssq + row, sq); }
    }
};
template <int B16  , int RS2 = 0  > struct EpiResBf16Ssq {
    static constexpr bool PERM = true, AFTER_DRAIN = false;
    const void* base; bf16_t* HB; int ldc; float* ssq; const float* ssq_in;
    __device__ __forceinline__ void operator()(const f32x4 (&acc)[2][2][4][2], const Unit& u, int wr, int wc, int fr, int fq) const {
        const int row0 = u.pm * BM + wr * 64 + fr, col0 = u.pn * BM + wc * 32 + 8 * fq;
        float rq[2][4], sqv[2][4];
#pragma unroll
        for (int ai = 0; ai < 2; ++ai)
#pragma unroll
            for (int m = 0; m < 4; ++m) rq[ai][m] = RS2 ? ssq_in[row0 + ai * HALF + m * 16] : 0.f;
#pragma unroll
        for (int ai = 0; ai < 2; ++ai)
#pragma unroll
            for (int m = 0; m < 4; ++m) { const int row = row0 + ai * HALF + m * 16; const size_t off = (size_t)row * ldc + col0; float sq = 0.f;
                float rs2 = 1.f; if (RS2) rs2 = 1.0f / (rq[ai][m] * (1.0f / 2048.0f) + 1e-6f);
#pragma unroll
                for (int bj = 0; bj < 2; ++bj) { f32x4 b0, b1;
                    if (B16) { const u32x4 bw = *(const u32x4*)((const bf16_t*)base + off + bj * HALF);
                        b0 = (f32x4){__uint_as_float(bw.x << 16), __uint_as_float(bw.x & 0xffff0000u), __uint_as_float(bw.y << 16), __uint_as_float(bw.y & 0xffff0000u)};
                        b1 = (f32x4){__uint_as_float(bw.z << 16), __uint_as_float(bw.z & 0xffff0000u), __uint_as_float(bw.w << 16), __uint_as_float(bw.w & 0xffff0000u)}; }
                    else { b0 = *(const f32x4*)((const float*)base + off + bj * HALF); b1 = *(const f32x4*)((const float*)base + off + bj * HALF + 4); }
                    const f32x4 h0 = RS2 ? b0 + acc[ai][bj][m][0] * rs2 : b0 + acc[ai][bj][m][0], h1 = RS2 ? b1 + acc[ai][bj][m][1] * rs2 : b1 + acc[ai][bj][m][1];
                    sq += ((h0[0] * h0[0] + h0[1] * h0[1]) + (h0[2] * h0[2] + h0[3] * h0[3])) + ((h1[0] * h1[0] + h1[1] * h1[1]) + (h1[2] * h1[2] + h1[3] * h1[3]));
                    u32x4 w; w.x = cvt_pk_bf16(h0[0], h0[1]); w.y = cvt_pk_bf16(h0[2], h0[3]); w.z = cvt_pk_bf16(h1[0], h1[1]); w.w = cvt_pk_bf16(h1[2], h1[3]);
                    *(u32x4*)(HB + off + bj * HALF) = w; }
                sqv[ai][m] = sq; }
#pragma unroll
        for (int ai = 0; ai < 2; ++ai)
#pragma unroll
            for (int m = 0; m < 4; ++m) { float sq = sqv[ai][m]; sq += __shfl_xor(sq, 16); sq += __shfl_xor(sq, 32); if (fq == 0) unsafeAtomicAdd(ssq + row0 + ai * HALF + m * 16, sq); }
    }
};
struct EpiResF32 {
    static constexpr bool PERM = false, AFTER_DRAIN = false;
    const float* base; float* out; int ldc;
    __device__ __forceinline__ void operator()(const f32x4 (&acc)[2][2][4][2], const Unit& u, int wr, int wc, int fr, int fq) const {
        const int row0 = u.pm * BM + wr * 64 + fr, col0 = u.pn * BM + wc * 32 + 4 * fq;
#pragma unroll
        for (int ai = 0; ai < 2; ++ai)
#pragma unroll
            for (int m = 0; m < 4; ++m) { const size_t off = (size_t)(row0 + ai * HALF + m * 16) * ldc + col0;
#pragma unroll
                for (int bj = 0; bj < 2; ++bj)
#pragma unroll
                    for (int n = 0; n < 2; ++n) { const f32x4 bs = *(const f32x4*)(base + off + bj * HALF + n * 16); *(f32x4*)(out + off + bj * HALF + n * 16) = bs + acc[ai][bj][m][n]; } }
    }
};

template <class Epi, class Sched, bool ALIGN_EPI = false, bool SP2 = false>
__device__ __forceinline__ void gemm_phase(PG8_LAS unsigned char* lds, const Gemm g, const Sched& S, const Epi& E, const int tid) {
    const int wid = __builtin_amdgcn_readfirstlane(tid >> 6), lane = tid & 63, wr = wid >> 2, wc = wid & 3, fr = lane & 15, fq = lane >> 4;
    const int K = g.K, nt = K / BK;
    unsigned voffA[2], voffB[2];
#pragma unroll
    for (int i = 0; i < 2; ++i) { int R, C; stage_rc(tid * 16 + i * 8192, R, C); const int Rb = Epi::PERM ? ((R & ~31) + perm32(R & 31)) : R;
        voffA[i] = (unsigned)(R * K + C) * 2u; voffB[i] = (unsigned)(Rb * K + C) * 2u; }
    const size_t kstep = (size_t)(BK * 2);
    const size_t hstep = (size_t)HALF * K * 2;
    const size_t tstep = 2 * hstep;
    const unsigned ldsw = (unsigned)wid * 1024u;
    const int aoff = lds_byte(wr * 64 + fr, fq * 8), boff = lds_byte(wc * 32 + fr, fq * 8);
#define PG8_SA(b, h) (((b) * 2 + (h)) * HTB)
#define PG8_SB(b, h) ((4 + (b) * 2 + (h)) * HTB)
#define PG8_STAGE(bufoff, gbase, voff) do { _Pragma("unroll") for (int _i = 0; _i < 2; ++_i) \
        __builtin_amdgcn_global_load_lds((const unsigned*)((const char*)(gbase) + (voff)[_i]), (PG8_LAS unsigned*)(lds + (bufoff) + ldsw + _i * 8192), 16, 0, 0); } while (0)
#define PG8_LDA(dst, b, h) do { _Pragma("unroll") for (int m = 0; m < 4; ++m) _Pragma("unroll") for (int k = 0; k < 2; ++k) dst[m][k] = *(const PG8_LAS bf16x8*)(lds + PG8_SA(b, h) + aoff + m * 2048 + k * 1024); } while (0)
#define PG8_LDB(dst, b, h) do { _Pragma("unroll") for (int n = 0; n < 2; ++n) _Pragma("unroll") for (int k = 0; k < 2; ++k) dst[n][k] = *(const PG8_LAS bf16x8*)(lds + PG8_SB(b, h) + boff + n * 2048 + k * 1024); } while (0)
#define PG8_MMA(ai, bj, At, Bt) do { __builtin_amdgcn_s_setprio(1); _Pragma("unroll") for (int m = 0; m < 4; ++m) _Pragma("unroll") for (int n = 0; n < 2; ++n) _Pragma("unroll") for (int k = 0; k < 2; ++k) \
        acc[ai][bj][m][n] = __builtin_amdgcn_mfma_f32_16x16x32_bf16(Bt[n][k], At[m][k], acc[ai][bj][m][n], 0, 0, 0); __builtin_amdgcn_s_setprio(0); } while (0)
#define PG8_WAIT_V(n) asm volatile("s_waitcnt vmcnt(" #n ")" ::: "memory")
#define PG8_WAIT_L(n) asm volatile("s_waitcnt lgkmcnt(" #n ")" ::: "memory")
#define PG8_BAR __builtin_amdgcn_s_barrier()
#define PG8_SCHED __builtin_amdgcn_sched_barrier(0)
    Unit cur, nxt; int ui = 0;
    if (!S.next(0, cur)) return;
    f32x4 acc[2][2][4][2];
#pragma unroll
    for (int a = 0; a < 2; ++a)
#pragma unroll
        for (int b = 0; b < 2; ++b)
#pragma unroll
            for (int m = 0; m < 4; ++m)
#pragma unroll
                for (int n = 0; n < 2; ++n) acc[a][b][m][n] = (f32x4){0.f, 0.f, 0.f, 0.f};
    bf16x8 At[4][2], B0[2][2], B1[2][2];
    const char* cA = (const char*)g.A + (size_t)cur.pm * tstep; const char* cB = (const char*)g.Bt + (size_t)cur.pn * tstep;
    S.a_ready(cur);
    if constexpr (SP2) {
        PG8_STAGE(PG8_SB(0, 0), cB, voffB); PG8_STAGE(PG8_SB(0, 1), cB + hstep, voffB); PG8_STAGE(PG8_SA(0, 0), cA, voffA); PG8_STAGE(PG8_SA(0, 1), cA + hstep, voffA);
        if (wr == 1) PG8_BAR;
        PG8_WAIT_V(2); PG8_BAR;
        PG8_STAGE(PG8_SB(1, 0), cB + kstep, voffB); PG8_STAGE(PG8_SA(1, 0), cA + kstep, voffA); PG8_STAGE(PG8_SB(1, 1), cB + hstep + kstep, voffB);
        PG8_WAIT_V(6); PG8_BAR;
    } else {
        PG8_STAGE(PG8_SB(0, 0), cB, voffB); PG8_STAGE(PG8_SA(0, 0), cA, voffA); PG8_STAGE(PG8_SB(0, 1), cB + hstep, voffB); PG8_STAGE(PG8_SA(0, 1), cA + hstep, voffA);
        if (wr == 1) PG8_BAR;
        PG8_WAIT_V(4); PG8_BAR;
        PG8_STAGE(PG8_SB(1, 0), cB + kstep, voffB); PG8_STAGE(PG8_SA(1, 0), cA + kstep, voffA); PG8_STAGE(PG8_SB(1, 1), cB + hstep + kstep, voffB);
        PG8_WAIT_V(6); PG8_BAR;
    }
    for (;;) {
        const bool has_next = S.next(ui + 1, nxt);
        const char* nA = has_next ? (const char*)g.A + (size_t)nxt.pm * tstep : cA; const char* nB = has_next ? (const char*)g.Bt + (size_t)nxt.pn * tstep : cB;
        for (int t = 0; t < nt; t += 2) {
            const bool last = (t == nt - 2);
            const char* a1 = cA + (size_t)(t + 1) * kstep;
            const char* a2 = last ? nA : cA + (size_t)(t + 2) * kstep; const char* b2 = last ? nB : cB + (size_t)(t + 2) * kstep;
            const char* a3 = a2 + kstep; const char* b3 = b2 + kstep;
            if (last && has_next) S.a_ready(nxt);
            if constexpr (SP2) {
            PG8_LDB(B0, 0, 0); PG8_LDB(B1, 0, 1); PG8_SCHED; PG8_LDA(At, 0, 0); PG8_STAGE(PG8_SA(1, 1), a1 + hstep, voffA);
            PG8_WAIT_V(8); PG8_WAIT_L(0); PG8_BAR; PG8_MMA(0, 0, At, B0); PG8_MMA(0, 1, At, B1); PG8_BAR; PG8_SCHED;
            PG8_LDA(At, 0, 1); PG8_STAGE(PG8_SB(0, 0), b2, voffB); PG8_STAGE(PG8_SB(0, 1), b2 + hstep, voffB); PG8_STAGE(PG8_SA(0, 0), a2, voffA);
            PG8_WAIT_V(8); PG8_WAIT_L(0); PG8_BAR; PG8_MMA(1, 0, At, B0); PG8_MMA(1, 1, At, B1); PG8_BAR; PG8_SCHED;
            PG8_LDB(B0, 1, 0); PG8_LDB(B1, 1, 1); PG8_SCHED; PG8_LDA(At, 1, 0); PG8_STAGE(PG8_SA(0, 1), a2 + hstep, voffA);
            PG8_WAIT_V(8); PG8_WAIT_L(0); PG8_BAR; PG8_MMA(0, 0, At, B0); PG8_MMA(0, 1, At, B1); PG8_BAR; PG8_SCHED;
            PG8_LDA(At, 1, 1); PG8_STAGE(PG8_SB(1, 0), b3, voffB); PG8_STAGE(PG8_SB(1, 1), b3 + hstep, voffB); PG8_STAGE(PG8_SA(1, 0), a3, voffA);
            PG8_WAIT_V(8); PG8_WAIT_L(0); PG8_BAR; PG8_MMA(1, 0, At, B0); PG8_MMA(1, 1, At, B1); PG8_BAR; PG8_SCHED;
            } else {
            PG8_LDB(B0, 0, 0); PG8_SCHED; PG8_LDA(At, 0, 0); PG8_STAGE(PG8_SA(1, 1), a1 + hstep, voffA);
            PG8_WAIT_L(8); PG8_BAR; PG8_WAIT_L(0); PG8_MMA(0, 0, At, B0); PG8_BAR; PG8_SCHED;
            PG8_LDB(B1, 0, 1); PG8_STAGE(PG8_SB(0, 0), b2, voffB);
            PG8_BAR; PG8_WAIT_L(0); PG8_MMA(0, 1, At, B1); PG8_BAR;
            PG8_LDA(At, 0, 1); PG8_STAGE(PG8_SA(0, 0), a2, voffA);
            PG8_BAR; PG8_WAIT_L(0); PG8_MMA(1, 0, At, B0); PG8_BAR; PG8_SCHED;
            PG8_STAGE(PG8_SB(0, 1), b2 + hstep, voffB);
            PG8_WAIT_V(6); PG8_BAR; PG8_MMA(1, 1, At, B1); PG8_BAR;
            PG8_LDB(B0, 1, 0); PG8_SCHED; PG8_LDA(At, 1, 0); PG8_STAGE(PG8_SA(0, 1), a2 + hstep, voffA);
            PG8_WAIT_L(8); PG8_BAR; PG8_WAIT_L(0); PG8_MMA(0, 0, At, B0); PG8_BAR; PG8_SCHED;
            PG8_LDB(B1, 1, 1); PG8_STAGE(PG8_SB(1, 0), b3, voffB);
            PG8_BAR; PG8_WAIT_L(0); PG8_MMA(0, 1, At, B1); PG8_BAR;
            PG8_LDA(At, 1, 1); PG8_STAGE(PG8_SA(1, 0), a3, voffA);
            PG8_BAR; PG8_WAIT_L(0); PG8_MMA(1, 0, At, B0); PG8_BAR; PG8_SCHED;
            PG8_STAGE(PG8_SB(1, 1), b3 + hstep, voffB);
            PG8_WAIT_V(6); PG8_BAR; PG8_MMA(1, 1, At, B1); PG8_BAR;
            }
        }
        if constexpr (ALIGN_EPI) { if (wr == 0) PG8_BAR; }
        if constexpr (!Epi::AFTER_DRAIN) { E(acc, cur, wr, wc, fr, fq); S.done(cur); }
        if (!has_next) break;
#pragma unroll
        for (int a = 0; a < 2; ++a)
#pragma unroll
            for (int b = 0; b < 2; ++b)
#pragma unroll
                for (int m = 0; m < 4; ++m)
#pragma unroll
                    for (int n = 0; n < 2; ++n) acc[a][b][m][n] = (f32x4){0.f, 0.f, 0.f, 0.f};
        cur = nxt; cA = nA; cB = nB; ++ui;
        if constexpr (ALIGN_EPI) { if (wr == 1) PG8_BAR; }
    }
    PG8_WAIT_V(0);
    if constexpr (!ALIGN_EPI) { if (wr == 0) PG8_BAR; }
    PG8_BAR;
    if constexpr (Epi::AFTER_DRAIN) { E.fused(acc, cur, wr, wc, fr, fq, lds, wid, lane); S.done(cur); }
#undef PG8_SA
#undef PG8_SB
#undef PG8_STAGE
#undef PG8_LDA
#undef PG8_LDB
#undef PG8_MMA
#undef PG8_WAIT_V
#undef PG8_WAIT_L
#undef PG8_BAR
#undef PG8_SCHED
}
}

#include <hip/hip_cooperative_groups.h>
namespace cg = cooperative_groups;
#define LAS __attribute__((address_space(3)))
typedef unsigned short bf16;
typedef unsigned v4u __attribute__((ext_vector_type(4)));
typedef unsigned v2u __attribute__((ext_vector_type(2)));
typedef float f32x4 __attribute__((ext_vector_type(4)));
typedef float f32x2 __attribute__((ext_vector_type(2)));
typedef float f32x16 __attribute__((ext_vector_type(16)));
typedef short bf16x8 __attribute__((ext_vector_type(8)));

#ifndef MK_PER_PHASE
#define MK_PER_PHASE 0
#endif
constexpr int NB = 2, S = 16384, DM = 2048, T = NB * S, NH = 8, HD = 128, AW = 1024, CC = 1024, INW = 5120, FF = 8192, NMEM = 256, XH = 4, XW = 512, CONVK = 31, NBLK = 64;
constexpr float EPS = 1e-6f, LOG2E = 1.4426950408889634f;
constexpr int NPHASE = 15;
constexpr size_t MiB = 1u << 20;
constexpr size_t WS_CTL = 0; constexpr int CW_BAR = 4096;
constexpr size_t WS_WIN = 2 * MiB, WS_WOUT = 22 * MiB, WS_WQ = 30 * MiB, WS_WKV = 32 * MiB, WS_WO = 36 * MiB, WS_W1 = 38 * MiB, WS_W2 = 70 * MiB;
constexpr size_t WS_KBAR = 102 * MiB, WS_TB = 103 * MiB, WS_MN = 104 * MiB, WS_KC = 106 * MiB, WS_VCT = 107 * MiB;
constexpr size_t WS_NB = 112 * MiB;
constexpr size_t WS_Q = 240 * MiB, WS_K = 304 * MiB, WS_VT = 368 * MiB, WS_UV = 432 * MiB, WS_UG = 496 * MiB;
constexpr size_t WS_AC = 560 * MiB;
constexpr size_t WS_F = 240 * MiB;
constexpr size_t WS_QC = 240 * MiB, WS_OC = 272 * MiB;
constexpr size_t WS_PO = 752 * MiB;
constexpr size_t WS_PML = 944 * MiB;
constexpr size_t WS_LIST = 952 * MiB;
constexpr size_t WS_END = 1016 * MiB;
constexpr int LDS_BYTES = 152064;
constexpr int KS_OFF = 0, KROW = 272, VS_OFF = 256 * 272, VROW = 528, TB_OFF = VS_OFF + 128 * 528, RED_OFF = TB_OFF + 8192, CNT_OFF = RED_OFF + 2048, PT_OFF = CNT_OFF + 4096, ST_OFF = PT_OFF + 192;
static_assert(PT_OFF + 256 <= LDS_BYTES, "LDS map");

__device__ __forceinline__ float bf_lo(unsigned w) { return __uint_as_float(w << 16); }
__device__ __forceinline__ float bf_hi(unsigned w) { return __uint_as_float(w & 0xffff0000u); }
typedef __bf16 bf16x2_t __attribute__((ext_vector_type(2)));
__device__ __forceinline__ unsigned pk2(float lo, float hi) { return pg8::cvt_pk_bf16(lo, hi); }
__device__ __forceinline__ unsigned pk2s(float lo, float hi) { f32x2 v = {lo, hi}; bf16x2_t b = __builtin_convertvector(v, bf16x2_t); return __builtin_bit_cast(unsigned, b); }
__device__ __forceinline__ float ex2(float x) { return __builtin_amdgcn_exp2f(x); }
__device__ __forceinline__ float wave_sum(float v) {
#pragma unroll
    for (int o = 1; o < 64; o <<= 1) v += __shfl_xor(v, o);
    return v;
}
__device__ __forceinline__ float sigmoidf_(float x) { return 1.0f / (1.0f + __expf(-x)); }

__device__ __forceinline__ void p0_transpose_item(const float* W, int K, int N, bf16* WT, int row_off, LAS float* scr, int item, int lane, const float* gk = nullptr) {
    const int nblk = N / 32, kb = item / nblk, nb = item % nblk, k0 = 64 * kb, n0 = 32 * nb;
    float wv[32];
#pragma unroll
    for (int i = 0; i < 32; ++i) { const int kk = 2 * i + (lane >> 5); wv[i] = W[(size_t)(k0 + kk) * N + n0 + (lane & 31)]; }
    if (gk) {
#pragma unroll
        for (int i = 0; i < 32; ++i) wv[i] *= gk[k0 + 2 * i + (lane >> 5)];
    }
#pragma unroll
    for (int i = 0; i < 32; ++i) { const int kk = 2 * i + (lane >> 5); scr[kk * 33 + (lane & 31)] = wv[i]; }
    asm volatile("s_waitcnt lgkmcnt(0)" ::: "memory");
    const int c = lane & 7;
#pragma unroll
    for (int j = 0; j < 4; ++j) { const int n = (lane >> 3) + 8 * j; const LAS float* s = scr + (8 * c) * 33 + n;
        v4u o; o.x = pk2(s[0 * 33], s[1 * 33]); o.y = pk2(s[2 * 33], s[3 * 33]); o.z = pk2(s[4 * 33], s[5 * 33]); o.w = pk2(s[6 * 33], s[7 * 33]);
        *(v4u*)(WT + (size_t)(row_off + n0 + n) * K + k0 + 8 * c) = o; }
    asm volatile("s_waitcnt lgkmcnt(0)" ::: "memory");
}
__device__ __forceinline__ void rms_row_bf16(const float* xrow, const float* g, bf16* orow, int lane) {
    const f32x4* xr = (const f32x4*)xrow + lane; f32x4 v[8]; float s = 0.f;
#pragma unroll
    for (int j = 0; j < 8; ++j) { v[j] = xr[64 * j]; s += (v[j].x * v[j].x + v[j].y * v[j].y) + (v[j].z * v[j].z + v[j].w * v[j].w); }
    const float rstd = 1.0f / sqrtf(wave_sum(s) * (1.0f / DM) + EPS);
    const f32x4* gr = (const f32x4*)g + lane; v2u* o8 = (v2u*)orow + lane;
#pragma unroll
    for (int j = 0; j < 8; ++j) { const f32x4 gv = gr[64 * j]; v2u w; w.x = pk2(v[j].x * rstd * gv.x, v[j].y * rstd * gv.y); w.y = pk2(v[j].z * rstd * gv.z, v[j].w * rstd * gv.w); o8[64 * j] = w; }
}
__device__ __forceinline__ void rms_row_f32(const float* xrow, const float* g, float* orow, int lane) {
    const f32x4* xr = (const f32x4*)xrow + lane; f32x4 v[8]; float s = 0.f;
#pragma unroll
    for (int j = 0; j < 8; ++j) { v[j] = xr[64 * j]; s += (v[j].x * v[j].x + v[j].y * v[j].y) + (v[j].z * v[j].z + v[j].w * v[j].w); }
    const float rstd = 1.0f / sqrtf(wave_sum(s) * (1.0f / DM) + EPS);
    const f32x4* gr = (const f32x4*)g + lane; f32x4* o = (f32x4*)orow + lane;
#pragma unroll
    for (int j = 0; j < 8; ++j) { const f32x4 gv = gr[64 * j]; o[64 * j] = v[j] * rstd * gv; }
}

__device__ __forceinline__ int crow(int r, int hi) { return (r & 3) + 8 * (r >> 2) + 4 * hi; }
__device__ __forceinline__ void attn_stage(LAS unsigned char* lds, const bf16* Kg, unsigned kstride, const bf16* VTg, unsigned vstride, const float* tbg, int tid) {
    const unsigned ko = (unsigned)(tid >> 4) * (kstride * 2u) + (unsigned)(tid & 15) * 16u, vo = (unsigned)(tid >> 5) * (vstride * 2u) + (unsigned)(tid & 31) * 16u;
    const unsigned kl = (unsigned)(tid >> 4) * KROW + (unsigned)(tid & 15) * 16u, vl = (unsigned)(tid >> 5) * VROW + (unsigned)(tid & 31) * 16u;
    v4u kx[8], vx[8];
#pragma unroll
    for (int p = 0; p < 8; ++p) kx[p] = *(const v4u*)((const unsigned char*)Kg + (size_t)p * 32 * kstride * 2 + ko);
#pragma unroll
    for (int p = 0; p < 8; ++p) vx[p] = *(const v4u*)((const unsigned char*)VTg + (size_t)p * 16 * vstride * 2 + vo);
#pragma unroll
    for (int p = 0; p < 8; ++p) *(LAS v4u*)(lds + KS_OFF + p * 32 * KROW + kl) = kx[p];
#pragma unroll
    for (int p = 0; p < 8; ++p) *(LAS v4u*)(lds + VS_OFF + p * 16 * VROW + vl) = vx[p];
    if (tbg) { const f32x4 x = ((const f32x4*)tbg)[tid]; ((LAS f32x4*)(lds + TB_OFF))[tid] = x; }
}
__device__ __forceinline__ void load_q(bf16x8 (&qf)[8], const bf16* qp, int hi) {
#pragma unroll
    for (int ks = 0; ks < 8; ++ks) qf[ks] = *(const bf16x8*)(qp + 16 * ks + 8 * hi);
}
__device__ __forceinline__ void store_o16(bf16* rowbase, const f32x16 (&O)[4], float scale, int hi, bool doit) {
#pragma unroll
    for (int dt = 0; dt < 4; ++dt)
#pragma unroll
        for (int gp = 0; gp < 2; ++gp) {
            const int ga = 2 * gp, gb = 2 * gp + 1;
            const unsigned ax = pk2(O[dt][4 * ga] * scale, O[dt][4 * ga + 1] * scale), ay = pk2(O[dt][4 * ga + 2] * scale, O[dt][4 * ga + 3] * scale);
            const unsigned bx = pk2(O[dt][4 * gb] * scale, O[dt][4 * gb + 1] * scale), by = pk2(O[dt][4 * gb + 2] * scale, O[dt][4 * gb + 3] * scale);
            const v2u r1 = __builtin_amdgcn_permlane32_swap(ax, bx, false, false), r2 = __builtin_amdgcn_permlane32_swap(ay, by, false, false);
            v4u w; w.x = r1.x; w.y = r2.x; w.z = r1.y; w.w = r2.y;
            if (doit) *(v4u*)(rowbase + 32 * dt + 8 * (hi ? gb : ga)) = w;
        }
}
template <int MODE>
__device__ __forceinline__ void attn_core(LAS unsigned char* lds, const bf16x8 (&qf)[8], int qrel, float sc, int nchunks, bool fast, float cbias, f32x16 (&O)[4], float& m, float& l, int lane) {
    const int l31 = lane & 31, hi = lane >> 5;
#pragma unroll
    for (int dt = 0; dt < 4; ++dt)
#pragma unroll
        for (int r = 0; r < 16; ++r) O[dt][r] = 0.f;
    m = -1e30f; l = 0.f;
    const LAS float* tb = (const LAS float*)(lds + TB_OFF);
#pragma unroll 1
    for (int c = 0; c < nchunks; ++c) {
        f32x16 s0, s1;
#pragma unroll
        for (int r = 0; r < 16; ++r) { s0[r] = 0.f; s1[r] = 0.f; }
        const LAS unsigned char* kp = lds + KS_OFF + (64 * c + l31) * KROW + 16 * hi;
#pragma unroll
        for (int h2 = 0; h2 < 2; ++h2) {
            bf16x8 ka[4], kb[4];
#pragma unroll
            for (int ks = 0; ks < 4; ++ks) { ka[ks] = *(const LAS bf16x8*)(kp + 32 * (4 * h2 + ks)); kb[ks] = *(const LAS bf16x8*)(kp + 32 * KROW + 32 * (4 * h2 + ks)); }
#pragma unroll
            for (int ks = 0; ks < 4; ++ks) {
                s0 = __builtin_amdgcn_mfma_f32_32x32x16_bf16(ka[ks], qf[4 * h2 + ks], s0, 0, 0, 0);
                s1 = __builtin_amdgcn_mfma_f32_32x32x16_bf16(kb[ks], qf[4 * h2 + ks], s1, 0, 0, 0);
            }
        }
        float mx = -INFINITY;
#pragma unroll
        for (int r = 0; r < 16; ++r) {
            const int d0 = qrel - (64 * c + crow(r, hi)), d1 = d0 - 32;
            float t0 = s0[r] * sc, t1 = s1[r] * sc;
            if (MODE == 0) { if (fast) { t0 += cbias; t1 += cbias; } else { t0 += tb[d0 < 2047 ? d0 : 2047]; t1 += tb[d1 < 2047 ? d1 : 2047]; } }
            if (MODE == 1) { t0 = d0 >= 0 ? t0 + tb[d0 > 0 ? d0 : 0] : -INFINITY; t1 = d1 >= 0 ? t1 + tb[d1 > 0 ? d1 : 0] : -INFINITY; }
            s0[r] = t0; s1[r] = t1; mx = fmaxf(mx, fmaxf(t0, t1));
        }
        mx = fmaxf(mx, __shfl_xor(mx, 32));
        const float mn = fmaxf(m, mx), alpha = ex2(m - mn); m = mn;
        float ls = 0.f;
#pragma unroll
        for (int r = 0; r < 16; ++r) { s0[r] = ex2(s0[r] - mn); s1[r] = ex2(s1[r] - mn); ls += s0[r] + s1[r]; }
        l = l * alpha + ls;
#pragma unroll
        for (int dt = 0; dt < 4; ++dt)
#pragma unroll
            for (int r = 0; r < 16; ++r) O[dt][r] *= alpha;
#pragma unroll
        for (int kt2 = 0; kt2 < 2; ++kt2) {
            bf16x8 pb[2];
#pragma unroll
            for (int sp = 0; sp < 2; ++sp) {
                v4u pw;
                if (kt2 == 0) { pw.x = pk2s(s0[8 * sp + 0], s0[8 * sp + 1]); pw.y = pk2s(s0[8 * sp + 2], s0[8 * sp + 3]); pw.z = pk2s(s0[8 * sp + 4], s0[8 * sp + 5]); pw.w = pk2s(s0[8 * sp + 6], s0[8 * sp + 7]); }
                else          { pw.x = pk2s(s1[8 * sp + 0], s1[8 * sp + 1]); pw.y = pk2s(s1[8 * sp + 2], s1[8 * sp + 3]); pw.z = pk2s(s1[8 * sp + 4], s1[8 * sp + 5]); pw.w = pk2s(s1[8 * sp + 6], s1[8 * sp + 7]); }
                pb[sp] = __builtin_bit_cast(bf16x8, pw);
            }
            const LAS unsigned char* vp = lds + VS_OFF + l31 * VROW + (64 * c + 32 * kt2 + 4 * hi) * 2;
            v2u va[2][4][2];
#pragma unroll
            for (int sp = 0; sp < 2; ++sp)
#pragma unroll
                for (int dt = 0; dt < 4; ++dt) { va[sp][dt][0] = *(const LAS v2u*)(vp + sp * 32 + dt * 32 * VROW); va[sp][dt][1] = *(const LAS v2u*)(vp + sp * 32 + dt * 32 * VROW + 16); }
#pragma unroll
            for (int sp = 0; sp < 2; ++sp)
#pragma unroll
                for (int dt = 0; dt < 4; ++dt) {
                    v4u aw; aw.x = va[sp][dt][0].x; aw.y = va[sp][dt][0].y; aw.z = va[sp][dt][1].x; aw.w = va[sp][dt][1].y;
                    O[dt] = __builtin_amdgcn_mfma_f32_32x32x16_bf16(__builtin_bit_cast(bf16x8, aw), pb[sp], O[dt], 0, 0, 0);
                }
        }
    }
    l += __shfl_xor(l, 32);
}

#define XB_TMO      128
#define XB_XCNT(j)  (256  + 64 * (j))
#define XB_XSUB(j)  (1280 + 64 * (j))
#define XB_XGEN(j)  (2304 + 64 * (j))
#define XB_TOP      3328
#define XB_TOPGEN   3392
#define XCD_BAR_WORDS 3456
#define XB_SPIN_CAP (1u << 18)

__device__ __forceinline__ unsigned xb_ld(unsigned* p)              { return __hip_atomic_load(p, __ATOMIC_RELAXED, __HIP_MEMORY_SCOPE_AGENT); }
__device__ __forceinline__ unsigned xb_add(unsigned* p, unsigned v) { return __hip_atomic_fetch_add(p, v, __ATOMIC_RELAXED, __HIP_MEMORY_SCOPE_AGENT); }
__device__ __forceinline__ unsigned xb_xcc_id() { return (unsigned)__builtin_amdgcn_s_getreg((3 << 11) | 20) & 0xFu; }
#define XB_SPIN(cond, bar) do { unsigned _sp = 0; while (cond) { __builtin_amdgcn_s_sleep(1); \
    if ((++_sp & 255u) == 0u) { if (xb_ld(&(bar)[XB_TMO])) break; if (_sp > XB_SPIN_CAP) { atomicAdd(&(bar)[XB_TMO], 1u); break; } } } } while (0)

struct XcdBarrier {
    unsigned* bar; unsigned x;
    volatile LAS unsigned* st;
};

__device__ __forceinline__ XcdBarrier xcd_barrier_post(unsigned* bar, volatile LAS unsigned* st, int tid) {
    XcdBarrier b; b.bar = bar; b.x = xb_xcc_id(); b.st = st;
    if (tid == 0) (void)xb_add(&bar[XB_XCNT(b.x)], 1u);
    return b;
}
__device__ __forceinline__ void xcd_barrier_complete(unsigned* bar, unsigned x, unsigned& nloc, unsigned& nx) {
    const unsigned G = gridDim.x * gridDim.y * gridDim.z;
    unsigned sum, cnt, mine, sp = 0u;
    for (;;) {
        sum = 0u; cnt = 0u; mine = 0u;
#pragma unroll
        for (unsigned j = 0; j < 16; ++j) { const unsigned c = xb_ld(&bar[XB_XCNT(j)]); sum += c; cnt += (c > 0u) ? 1u : 0u; mine = (j == x) ? c : mine; }
        if (sum == G) break;
        __builtin_amdgcn_s_sleep(1);
        if ((++sp & 255u) == 0u) { if (xb_ld(&bar[XB_TMO])) break; if (sp > XB_SPIN_CAP) { atomicAdd(&bar[XB_TMO], 1u); break; } }
    }
    nloc = mine > 0u ? mine : 1u; nx = cnt > 0u ? cnt : 1u;
}

__device__ __forceinline__ void xcd_barrier(const XcdBarrier& b, int tid) {
    asm volatile("s_waitcnt vmcnt(0)" ::: "memory");
    __syncthreads();
    if (tid == 0) {
        unsigned* bar = b.bar;
        __builtin_amdgcn_s_waitcnt(0);
        unsigned nloc = b.st[0], nx = b.st[1];
        if (nloc == 0u) { xcd_barrier_complete(bar, b.x, nloc, nx); b.st[0] = nloc; b.st[1] = nx; }
        const unsigned old = xb_add(&bar[XB_XSUB(b.x)], 1u);
        const unsigned gen = old / nloc;
        if (old + 1u == (gen + 1u) * nloc) {
            __builtin_amdgcn_fence(__ATOMIC_RELEASE, "agent");
            asm volatile("s_waitcnt vmcnt(0)" ::: "memory");
            const unsigned og = xb_add(&bar[XB_TOP], 1u);
            const unsigned tg = og / nx;
            if (og + 1u == (tg + 1u) * nx) xb_add(&bar[XB_TOPGEN], 1u);
            else XB_SPIN(xb_ld(&bar[XB_TOPGEN]) == tg, bar);
            __builtin_amdgcn_fence(__ATOMIC_ACQUIRE, "agent");
            xb_add(&bar[XB_XGEN(b.x)], 1u);
            asm volatile("s_waitcnt vmcnt(0)" ::: "memory");
        } else {
            XB_SPIN(xb_ld(&bar[XB_XGEN(b.x)]) == gen, bar);
            __builtin_amdgcn_fence(__ATOMIC_ACQUIRE, "agent");
            asm volatile("s_waitcnt vmcnt(0)" ::: "memory");
        }
    }
    __syncthreads();
}

struct Args { const float* in[20]; float* out; unsigned char* ws; int ph_lo, ph_hi; };

__global__ void __launch_bounds__(512, 2) fwd(Args a) {
    extern __shared__ __attribute__((aligned(16))) unsigned char lds_raw[];
    LAS unsigned char* lds = (LAS unsigned char*)lds_raw;
    const int wave = __builtin_amdgcn_readfirstlane((int)threadIdx.x >> 6);
    const int G = gridDim.x, blk = blockIdx.x;
    const int lo = a.ph_lo, hiP = a.ph_hi;
    LAS unsigned long long* ptab = (LAS unsigned long long*)(lds + PT_OFF);
    if (threadIdx.x == 0) {
#pragma unroll
        for (int i = 0; i < 20; ++i) ptab[i] = (unsigned long long)a.in[i];
        ptab[20] = (unsigned long long)a.out; ptab[21] = (unsigned long long)a.ws;
        ((LAS unsigned*)(lds + ST_OFF))[0] = 0u; ((LAS unsigned*)(lds + ST_OFF))[1] = 0u;
    }
    __syncthreads();
    if (a.ph_hi - a.ph_lo > 1) {
        cg::this_grid().sync();
        const int lane_ = (int)__builtin_amdgcn_mbcnt_hi(~0u, __builtin_amdgcn_mbcnt_lo(~0u, 0u));
        (void)xcd_barrier_post((unsigned*)(a.ws + WS_CTL) + CW_BAR, (volatile LAS unsigned*)(lds + ST_OFF), wave * 64 + lane_);
    }
#define LDP(i) ((unsigned char*)(__attribute__((address_space(1))) unsigned char*)(((unsigned long long)(unsigned)__builtin_amdgcn_readfirstlane((int)(unsigned)(ptab[i] >> 32)) << 32) | (unsigned long long)(unsigned)__builtin_amdgcn_readfirstlane((int)(unsigned)ptab[i])))
#define DECL_PTRS \
    const int lane = (int)__builtin_amdgcn_mbcnt_hi(~0u, __builtin_amdgcn_mbcnt_lo(~0u, 0u)), tid = wave * 64 + lane, l31 = lane & 31, hi = lane >> 5; (void)tid; (void)l31; (void)hi; \
    const float* const x = (const float*)LDP(0); (void)x; \
    const float* const mem = (const float*)LDP(1); (void)mem; \
    const float* const g_mix = (const float*)LDP(2); (void)g_mix; \
    const float* const w_in = (const float*)LDP(3); (void)w_in; \
    const float* const conv_w = (const float*)LDP(4); (void)conv_w; \
    const float* const conv_b = (const float*)LDP(5); (void)conv_b; \
    const float* const ln_g = (const float*)LDP(6); (void)ln_g; \
    const float* const ln_b = (const float*)LDP(7); (void)ln_b; \
    const float* const w_out = (const float*)LDP(8); (void)w_out; \
    const float* const rel_bias = (const float*)LDP(9); (void)rel_bias; \
    const float* const g_cross = (const float*)LDP(10); (void)g_cross; \
    const float* const g_mem = (const float*)LDP(11); (void)g_mem; \
    const float* const wq_c = (const float*)LDP(12); (void)wq_c; \
    const float* const wk_c = (const float*)LDP(13); (void)wk_c; \
    const float* const wv_c = (const float*)LDP(14); (void)wv_c; \
    const float* const wo_c = (const float*)LDP(15); (void)wo_c; \
    const float* const g_mlp = (const float*)LDP(16); (void)g_mlp; \
    const float* const w1 = (const float*)LDP(17); (void)w1; \
    const float* const w2 = (const float*)LDP(18); (void)w2; \
    const float* const g_final = (const float*)LDP(19); (void)g_final; \
    float* const out = (float*)LDP(20); (void)out; unsigned char* const ws = LDP(21); (void)ws; \
    unsigned* const CNT = (unsigned*)(ws + WS_CTL); (void)CNT; float* const SSQ1 = (float*)(ws + WS_CTL + 262144); (void)SSQ1; float* const SSQ2 = (float*)(ws + WS_CTL + 524288); (void)SSQ2; float* const SSQ3 = (float*)(ws + WS_CTL + 786432); (void)SSQ3; \
    bf16* const WIN_T = (bf16*)(ws + WS_WIN); (void)WIN_T; \
    bf16* const WOUT_T = (bf16*)(ws + WS_WOUT); (void)WOUT_T; \
    bf16* const WQ_T = (bf16*)(ws + WS_WQ); (void)WQ_T; \
    bf16* const WKV_T = (bf16*)(ws + WS_WKV); (void)WKV_T; \
    bf16* const WO_T = (bf16*)(ws + WS_WO); (void)WO_T; \
    bf16* const W1_T = (bf16*)(ws + WS_W1); (void)W1_T; \
    bf16* const W2_T = (bf16*)(ws + WS_W2); (void)W2_T; \
    float* const KBAR = (float*)(ws + WS_KBAR); (void)KBAR; \
    float* const TB = (float*)(ws + WS_TB); (void)TB; \
    bf16* const MN = (bf16*)(ws + WS_MN); (void)MN; \
    bf16* const KC = (bf16*)(ws + WS_KC); (void)KC; \
    bf16* const VCT = (bf16*)(ws + WS_VCT); (void)VCT; \
    bf16* const NBUF = (bf16*)(ws + WS_NB); (void)NBUF; \
    bf16* const Q = (bf16*)(ws + WS_Q); (void)Q; \
    bf16* const K = (bf16*)(ws + WS_K); (void)K; \
    bf16* const VT = (bf16*)(ws + WS_VT); (void)VT; \
    bf16* const UV = (bf16*)(ws + WS_UV); (void)UV; \
    bf16* const UG = (bf16*)(ws + WS_UG); (void)UG; \
    bf16* const AC = (bf16*)(ws + WS_AC); (void)AC; \
    bf16* const FB = (bf16*)(ws + WS_F); (void)FB; \
    bf16* const QC = (bf16*)(ws + WS_QC); (void)QC; \
    bf16* const OC = (bf16*)(ws + WS_OC); (void)OC; \
    bf16* const PO = (bf16*)(ws + WS_PO); (void)PO; \
    float* const PML = (float*)(ws + WS_PML); (void)PML; \
    unsigned* const LIST = (unsigned*)(ws + WS_LIST); (void)LIST; \
    do {} while (0)
    const float SC = 0.08838834764831845f * LOG2E;
#ifndef DBG
#define DBG 0
#endif
#ifndef REP_MASK
#define REP_MASK 0
#endif
#ifndef PH_MASK
#define PH_MASK 0x7fff
#endif
#define IN(k) (((PH_MASK >> (k)) & 1) && lo <= (k) && (k) < hiP)
#define SEAM2(k, kn) do { if (IN(k) && IN(kn)) { const int lane_ = (int)__builtin_amdgcn_mbcnt_hi(~0u, __builtin_amdgcn_mbcnt_lo(~0u, 0u)); \
        XcdBarrier b_; b_.bar = (unsigned*)(LDP(21) + WS_CTL) + CW_BAR; b_.x = xb_xcc_id(); b_.st = (volatile LAS unsigned*)(lds + ST_OFF); xcd_barrier(b_, wave * 64 + lane_); } } while (0)
#define SEAM(k) SEAM2(k, (k) + 1)

    for (int rep_ = 0; rep_ < (IN(0) ? 1 + ((REP_MASK >> 0) & 1) : 0); ++rep_) { DECL_PTRS;
        LAS float* scr = (LAS float*)(lds + wave * 16384);
        const int gw = blk * 8 + wave, NGW = G * 8;
        constexpr int I_IN = (DM / 64) * (INW / 32), I_OUT = (DM / 64) * (DM / 32), I_X = (DM / 64) * (XW / 32), I_O = (XW / 64) * (DM / 32), I_1 = (DM / 64) * (FF / 32), I_2 = (FF / 64) * (DM / 32);
        constexpr int NITEMS = I_IN + I_OUT + 3 * I_X + I_O + I_1 + I_2;
        for (int it = gw; it < NITEMS; it += NGW) {
            int r = it;
            if (r < I_IN) { p0_transpose_item(w_in, DM, INW, WIN_T, 0, scr, r, lane); continue; } r -= I_IN;
            if (r < I_OUT) { p0_transpose_item(w_out, DM, DM, WOUT_T, 0, scr, r, lane); continue; } r -= I_OUT;
            if (r < I_X) { p0_transpose_item(wq_c, DM, XW, WQ_T, 0, scr, r, lane, g_cross); continue; } r -= I_X;
            if (r < I_X) { p0_transpose_item(wk_c, DM, XW, WKV_T, 0, scr, r, lane); continue; } r -= I_X;
            if (r < I_X) { p0_transpose_item(wv_c, DM, XW, WKV_T, XW, scr, r, lane); continue; } r -= I_X;
            if (r < I_O) { p0_transpose_item(wo_c, XW, DM, WO_T, 0, scr, r, lane); continue; } r -= I_O;
            if (r < I_1) { p0_transpose_item(w1, DM, FF, W1_T, 0, scr, r, lane, g_mlp); continue; } r -= I_1;
            p0_transpose_item(w2, FF, DM, W2_T, 0, scr, r, lane);
        }
        for (int mrow = gw; mrow < T; mrow += 2 * NGW) {
            const int r2 = mrow + NGW;
            const f32x4* xa = (const f32x4*)(x + (size_t)mrow * DM) + lane; const f32x4* xb = (const f32x4*)(x + (size_t)(r2 < T ? r2 : mrow) * DM) + lane;
            f32x4 va[8], vb[8]; float sa = 0.f, sb = 0.f;
#pragma unroll
            for (int jj = 0; jj < 8; ++jj) { va[jj] = xa[64 * jj]; vb[jj] = xb[64 * jj]; }
#pragma unroll
            for (int jj = 0; jj < 8; ++jj) { sa += (va[jj].x * va[jj].x + va[jj].y * va[jj].y) + (va[jj].z * va[jj].z + va[jj].w * va[jj].w); sb += (vb[jj].x * vb[jj].x + vb[jj].y * vb[jj].y) + (vb[jj].z * vb[jj].z + vb[jj].w * vb[jj].w); }
            const float ra = 1.0f / sqrtf(wave_sum(sa) * (1.0f / DM) + EPS), rb = 1.0f / sqrtf(wave_sum(sb) * (1.0f / DM) + EPS);
            const f32x4* gr = (const f32x4*)g_mix + lane; v2u* oa = (v2u*)(NBUF + (size_t)mrow * DM) + lane; v2u* ob = (v2u*)(NBUF + (size_t)(r2 < T ? r2 : mrow) * DM) + lane;
#pragma unroll
            for (int jj = 0; jj < 8; ++jj) { const f32x4 gv = gr[64 * jj]; v2u w; w.x = pk2(va[jj].x * ra * gv.x, va[jj].y * ra * gv.y); w.y = pk2(va[jj].z * ra * gv.z, va[jj].w * ra * gv.w); oa[64 * jj] = w;
                if (r2 < T) { v2u w2; w2.x = pk2(vb[jj].x * rb * gv.x, vb[jj].y * rb * gv.y); w2.y = pk2(vb[jj].z * rb * gv.z, vb[jj].w * rb * gv.w); ob[64 * jj] = w2; } }
        }
        for (int mrow = gw; mrow < NB * NMEM; mrow += NGW) rms_row_bf16(mem + (size_t)mrow * DM, g_mem, MN + (size_t)mrow * DM, lane);
        for (int i = blk * 512 + tid; i < NH * 2048; i += G * 512) {
            const int hh = i >> 11, d = i & 2047; int bucket = d;
            if (d >= 16) { const int lg = 16 + (int)(logf((float)d / 16.0f) / 4.852030263919617f * 16.0f); bucket = lg < 31 ? lg : 31; }
            TB[i] = rel_bias[bucket * NH + hh] * LOG2E;
        }
        __syncthreads();
    }
    SEAM(0);

    for (int rep_ = 0; rep_ < (IN(1) ? 1 + ((REP_MASK >> 1) & 1) : 0); ++rep_) { DECL_PTRS;
        { pg8::Gemm g{NBUF, WIN_T, T, INW, DM}; pg8::StaticOrder So; So.init(T, INW, G, blk);
          pg8::EpiBf16X<0> E{Q, AW, AW, (size_t)T * AW, 2, VT, S, NH, nullptr};
          pg8::gemm_phase<pg8::EpiBf16X<0>, pg8::StaticOrder, true, true>(lds, g, So, E, tid); }
        { pg8::Gemm g{MN, WKV_T, NB * NMEM, 2 * XW, DM}; pg8::StaticOrder So; So.init(NB * NMEM, 2 * XW, G, blk);
          pg8::EpiBf16X<0> E{KC, XW, XW, (size_t)NB * NMEM * XW, 1, VCT, NMEM, XH, nullptr};
          pg8::gemm_phase<pg8::EpiBf16X<0>, pg8::StaticOrder, true, true>(lds, g, So, E, tid); }
    }
    SEAM(1);

#if DBG == 9
    { DECL_PTRS; for (size_t i = (size_t)blk * 512 + tid; i < (size_t)T * DM; i += (size_t)G * 512) { out[i] = i < 262144 ? __uint_as_float(((unsigned)KC[i] << 16)) : (i < 524288 ? __uint_as_float(((unsigned)VCT[i - 262144] << 16)) : 0.f); } return; }
#endif
#if DBG == 1
    { DECL_PTRS; for (size_t i = (size_t)blk * 512 + tid; i < (size_t)T * DM; i += (size_t)G * 512) { const size_t t = i >> 11, c = i & 2047, e = t * 1024 + (c & 1023);
        const unsigned short v = c < 1024 ? (unsigned short)(Q[e] ^ UV[e]) : (unsigned short)(K[e] ^ UG[e] ^ VT[e]); out[i] = __uint_as_float(((unsigned)v << 16)) ; } return; }
#endif
    for (int rep_ = 0; rep_ < (IN(2) ? 1 + ((REP_MASK >> 2) & 1) : 0); ++rep_) { DECL_PTRS;
        for (int it = blk; it < 256; it += G) {
            const int b = it >> 7, j = (it >> 1) & 63, chh = it & 1, cp = tid & 255, rh = tid >> 8;
            const bf16* kp = K + (size_t)(b * S + j * 256 + rh * 128) * AW + chh * 512 + 2 * cp;
            float s0 = 0.f, s1 = 0.f;
#pragma unroll 8
            for (int r = 0; r < 128; ++r) { const unsigned w = *(const unsigned*)(kp + (size_t)r * AW); s0 += bf_lo(w); s1 += bf_hi(w); }
            LAS f32x2* red = (LAS f32x2*)lds;
            if (rh == 1) red[cp] = (f32x2){s0, s1};
            __syncthreads();
            if (rh == 0) { const f32x2 o = red[cp]; const int col = chh * 512 + 2 * cp, hh = col >> 7, d = col & 127;
                *(f32x2*)(KBAR + ((size_t)((b * NH + hh) * NBLK + j)) * HD + d) = (f32x2){(s0 + o.x) * (1.0f / 256.0f), (s1 + o.y) * (1.0f / 256.0f)}; }
            __syncthreads();
        }
        for (int seg = blk; seg < T / 128; seg += G) {
            const int t0 = seg * 128, c0 = 2 * tid;
            float w0[CONVK], w1r[CONVK];
#pragma unroll
            for (int k = 0; k < CONVK; ++k) { const f32x2 wv = *(const f32x2*)(conv_w + k * CC + c0); w0[k] = wv.x; w1r[k] = wv.y; }
            const f32x2 cb = *(const f32x2*)(conv_b + c0), lg = *(const f32x2*)(ln_g + c0), lb = *(const f32x2*)(ln_b + c0);
            float r0[32], r1[32];
#pragma unroll
            for (int i = 0; i < 32; ++i) { r0[i] = 0.f; r1[i] = 0.f; }
            LAS f32x2* red = (LAS f32x2*)(lds + RED_OFF);
#pragma unroll 1
            for (int ch = -1; ch < 4; ++ch) {
                const int tb0 = t0 + ch * 32;
                const bool zero = (ch < 0) && ((t0 & (S - 1)) == 0);
#pragma unroll
                for (int hf = 0; hf < 2; ++hf) {
                    float y0[16], y1[16];
#pragma unroll
                    for (int ii = 0; ii < 16; ++ii) {
                        const int i = hf * 16 + ii;
                        float h0 = 0.f, h1 = 0.f;
                        if (!zero) { const size_t off = (size_t)(tb0 + i) * CC + c0; const unsigned vv = *(const unsigned*)(UV + off), gg = *(const unsigned*)(UG + off);
                            h0 = bf_lo(vv) * sigmoidf_(bf_lo(gg)); h1 = bf_hi(vv) * sigmoidf_(bf_hi(gg)); }
                        r0[i] = h0; r1[i] = h1;
                        float a0 = cb.x, a1 = cb.y;
                        if (ch >= 0) {
#pragma unroll
                            for (int k = 0; k < CONVK; ++k) { a0 += r0[(i - 30 + k) & 31] * w0[k]; a1 += r1[(i - 30 + k) & 31] * w1r[k]; }
                        }
                        y0[ii] = a0; y1[ii] = a1;
                    }
                    if (ch >= 0) {
#pragma unroll
                        for (int ii = 0; ii < 16; ++ii) { const float s1 = wave_sum(y0[ii] + y1[ii]), s2 = wave_sum(y0[ii] * y0[ii] + y1[ii] * y1[ii]); if (lane == 0) red[ii * 8 + wave] = (f32x2){s1, s2}; }
                        __syncthreads();
#pragma unroll
                        for (int ii = 0; ii < 16; ++ii) {
                            float s1 = 0.f, s2 = 0.f;
#pragma unroll
                            for (int w = 0; w < 8; ++w) { const f32x2 p = red[ii * 8 + w]; s1 += p.x; s2 += p.y; }
                            const float mean = s1 * (1.0f / CC), var = fmaxf(s2 * (1.0f / CC) - mean * mean, 0.f), rstd = 1.0f / sqrtf(var + EPS);
                            float o0 = (y0[ii] - mean) * rstd * lg.x + lb.x, o1 = (y1[ii] - mean) * rstd * lg.y + lb.y;
                            o0 = o0 * sigmoidf_(o0); o1 = o1 * sigmoidf_(o1);
                            *(unsigned*)(AC + (size_t)(tb0 + hf * 16 + ii) * DM + AW + c0) = pk2(o0, o1);
                        }
                        __syncthreads();
                    }
                }
            }
        }
    }
    SEAM(2);

    for (int rep_ = 0; rep_ < (IN(3) ? 1 : 0); ++rep_) { DECL_PTRS;
        constexpr int KH_OFF = 0, KL_OFF = 64 * KROW;
        for (int it = blk; it < NB * NH * NBLK; it += G) {
            const int bh = it >> 6, own = it & 63, b = bh >> 3, hh = bh & 7;
            if (own == 0) continue;
            f32x2 kvv[8];
#pragma unroll
            for (int i = 0; i < 8; ++i) { const int p2 = tid + 512 * i; kvv[i] = *(const f32x2*)(KBAR + (size_t)bh * NBLK * HD + 2 * p2); }
#pragma unroll
            for (int i = 0; i < 8; ++i) { const int p2 = tid + 512 * i, jr = p2 >> 6, d = (p2 & 63) * 2; const f32x2 kv = kvv[i];
                const unsigned hw = pk2s(kv.x, kv.y); const unsigned lw = pk2s(kv.x - bf_lo(hw), kv.y - bf_hi(hw));
                *(LAS unsigned*)(lds + KH_OFF + jr * KROW + d * 2) = hw; *(LAS unsigned*)(lds + KL_OFF + jr * KROW + d * 2) = lw; }
            const int ql = own * 256 + wave * 32 + l31;
            bf16x8 qf[8]; load_q(qf, Q + (size_t)(b * S + ql) * AW + hh * HD, hi);
            __syncthreads();
            f32x16 g0, g1;
#pragma unroll
            for (int r = 0; r < 16; ++r) { g0[r] = 0.f; g1[r] = 0.f; }
            const LAS unsigned char* kp = lds + l31 * KROW + 16 * hi;
#pragma unroll
            for (int ks = 0; ks < 8; ++ks) {
                g0 = __builtin_amdgcn_mfma_f32_32x32x16_bf16(*(const LAS bf16x8*)(kp + KH_OFF + 32 * ks), qf[ks], g0, 0, 0, 0);
                g0 = __builtin_amdgcn_mfma_f32_32x32x16_bf16(*(const LAS bf16x8*)(kp + KL_OFF + 32 * ks), qf[ks], g0, 0, 0, 0);
            }
            if (own > 32) {
#pragma unroll
                for (int ks = 0; ks < 8; ++ks) {
                    g1 = __builtin_amdgcn_mfma_f32_32x32x16_bf16(*(const LAS bf16x8*)(kp + KH_OFF + 32 * KROW + 32 * ks), qf[ks], g1, 0, 0, 0);
                    g1 = __builtin_amdgcn_mfma_f32_32x32x16_bf16(*(const LAS bf16x8*)(kp + KL_OFF + 32 * KROW + 32 * ks), qf[ks], g1, 0, 0, 0);
                }
            }
            float v0 = -INFINITY, v1 = -INFINITY, v2 = -INFINITY; int i0 = 64, i1 = 64, i2 = 64;
#define TOP3_INS(val, idx) do { const float dv_ = (val); const int di_ = (idx); if (di_ < own && dv_ > v2) { if (dv_ > v1) { v2 = v1; i2 = i1; if (dv_ > v0) { v1 = v0; i1 = i0; v0 = dv_; i0 = di_; } else { v1 = dv_; i1 = di_; } } else { v2 = dv_; i2 = di_; } } } while (0)
#pragma unroll
            for (int r = 0; r < 16; ++r) TOP3_INS(g0[r], crow(r, hi));
            if (own > 32) {
#pragma unroll
                for (int r = 0; r < 16; ++r) TOP3_INS(g1[r], 32 + crow(r, hi));
            }
            const float pv0 = __shfl_xor(v0, 32), pv1 = __shfl_xor(v1, 32), pv2 = __shfl_xor(v2, 32); const int pi0 = __shfl_xor(i0, 32), pi1 = __shfl_xor(i1, 32), pi2 = __shfl_xor(i2, 32);
#define TOP3_MRG(val, idx) do { const float dv_ = (val); const int di_ = (idx); if (di_ < own) { \
                if (dv_ > v2 || (dv_ == v2 && di_ < i2)) { if (dv_ > v1 || (dv_ == v1 && di_ < i1)) { v2 = v1; i2 = i1; if (dv_ > v0 || (dv_ == v0 && di_ < i0)) { v1 = v0; i1 = i0; v0 = dv_; i0 = di_; } else { v1 = dv_; i1 = di_; } } else { v2 = dv_; i2 = di_; } } } } while (0)
            TOP3_MRG(pv0, pi0); TOP3_MRG(pv1, pi1); TOP3_MRG(pv2, pi2);
            const int nsel = own < 3 ? own : 3;
            LAS unsigned char* sel = lds + 2 * 64 * KROW;
            if (hi == 0) { const int qi = wave * 32 + l31; sel[qi] = (unsigned char)(nsel > 0 ? i0 : 255); sel[256 + qi] = (unsigned char)(nsel > 1 ? i1 : 255); sel[512 + qi] = (unsigned char)(nsel > 2 ? i2 : 255); }
            __syncthreads();
            for (int jl = wave; jl < own; jl += 8) {
                unsigned long long bm[12]; bool mt[12]; unsigned total = 0u;
#pragma unroll
                for (int sk = 0; sk < 12; ++sk) { mt[sk] = sel[(sk >> 2) * 256 + lane + 64 * (sk & 3)] == (unsigned char)jl; bm[sk] = __ballot(mt[sk]); total += (unsigned)__popcll(bm[sk]); }
                if (total == 0u) continue;
                unsigned basep = 0u; if (lane == 0) basep = atomicAdd(&CNT[bh * NBLK + jl], total);
                unsigned run = (unsigned)__builtin_amdgcn_readfirstlane((int)basep);
                const unsigned long long lt = (1ull << lane) - 1ull;
#pragma unroll
                for (int sk = 0; sk < 12; ++sk) {
                    if (mt[sk]) __hip_atomic_store(&LIST[(size_t)(bh * NBLK + jl) * S + run + (unsigned)__popcll(bm[sk] & lt)], (unsigned)((own * 256 + lane + 64 * (sk & 3)) | ((sk >> 2) << 14)), __ATOMIC_RELAXED, __HIP_MEMORY_SCOPE_AGENT);
                    run += (unsigned)__popcll(bm[sk]);
                }
            }
            __syncthreads();
        }
    }
    SEAM(3);

    for (int rep_ = 0; rep_ < (IN(4) ? 1 + ((REP_MASK >> 4) & 1) : 0); ++rep_) { DECL_PTRS;
        LAS unsigned* pf = (LAS unsigned*)(lds + CNT_OFF);
        LAS unsigned* wtot = (LAS unsigned*)(lds + RED_OFF);
        {
            const unsigned c0 = __hip_atomic_load(&CNT[2 * tid], __ATOMIC_RELAXED, __HIP_MEMORY_SCOPE_AGENT), c1 = __hip_atomic_load(&CNT[2 * tid + 1], __ATOMIC_RELAXED, __HIP_MEMORY_SCOPE_AGENT);
            const unsigned ua = (c0 + 31u) >> 5, ub = (c1 + 31u) >> 5, us = ua + ub;
            unsigned v = us;
#pragma unroll
            for (int o = 1; o < 64; o <<= 1) { const unsigned u = __shfl_up(v, o); if (lane >= o) v += u; }
            if (lane == 63) wtot[wave] = v;
            __syncthreads();
            unsigned off = 0u;
            for (int w = 0; w < wave; ++w) off += wtot[w];
            const unsigned excl = off + v - us;
            pf[2 * tid] = excl + ua; pf[2 * tid + 1] = excl + us;
            __syncthreads();
        }
        const unsigned total = pf[NB * NH * NBLK - 1];
        const unsigned glo = (unsigned)(((unsigned long long)total * (unsigned)blk) / (unsigned)G), ghi = (unsigned)(((unsigned long long)total * (unsigned)(blk + 1)) / (unsigned)G);
        int lo_ = 0, hi_ = NB * NH * NBLK - 1;
        while (lo_ < hi_) { const int mid = (lo_ + hi_) >> 1; if (pf[mid] > glo) hi_ = mid; else lo_ = mid + 1; }
        int bhj = __builtin_amdgcn_readfirstlane(lo_); unsigned g = glo;
        while (g < ghi) {
            const unsigned base = (unsigned)__builtin_amdgcn_readfirstlane((int)(bhj ? pf[bhj - 1] : 0u)), lend = (unsigned)__builtin_amdgcn_readfirstlane((int)pf[bhj]);
            const unsigned end = lend < ghi ? lend : ghi;
            const int cnt = __builtin_amdgcn_readfirstlane((int)__hip_atomic_load(&CNT[bhj], __ATOMIC_RELAXED, __HIP_MEMORY_SCOPE_AGENT));
            const int bh = bhj >> 6, j = bhj & 63, b = bh >> 3, hh = bh & 7;
            attn_stage(lds, K + (size_t)(b * S + j * 256) * AW + hh * HD, AW, VT + (size_t)(bh * HD) * S + j * 256, S, TB + hh * 2048, tid);
            __syncthreads();
            const float cbias = ((const LAS float*)(lds + TB_OFF))[2047];
            unsigned gg = g + (unsigned)wave;
            unsigned e1 = (unsigned)(S - 1), e2 = (unsigned)(S - 1); bool v1 = false, v2 = false;
            bf16x8 qn[8];
            if (gg < end) { const int ix = (int)(gg - base) * 32 + l31; v1 = ix < cnt; if (v1) e1 = __hip_atomic_load(&LIST[(size_t)bhj * S + ix], __ATOMIC_RELAXED, __HIP_MEMORY_SCOPE_AGENT); }
            if (gg + 8u < end) { const int ix = (int)(gg + 8u - base) * 32 + l31; v2 = ix < cnt; if (v2) e2 = __hip_atomic_load(&LIST[(size_t)bhj * S + ix], __ATOMIC_RELAXED, __HIP_MEMORY_SCOPE_AGENT); }
            if (gg < end) load_q(qn, Q + (size_t)(b * S + (int)(e1 & 0x3fff)) * AW + hh * HD, hi);
            for (; gg < end; gg += 8u) {
                const unsigned e = e1; const bool valid = v1;
                bf16x8 qf[8];
#pragma unroll
                for (int ks = 0; ks < 8; ++ks) qf[ks] = qn[ks];
                e1 = e2; v1 = v2; e2 = (unsigned)(S - 1); v2 = false;
                if (gg + 16u < end) { const int ix = (int)(gg + 16u - base) * 32 + l31; v2 = ix < cnt; if (v2) e2 = __hip_atomic_load(&LIST[(size_t)bhj * S + ix], __ATOMIC_RELAXED, __HIP_MEMORY_SCOPE_AGENT); }
                if (gg + 8u < end) load_q(qn, Q + (size_t)(b * S + (int)(e1 & 0x3fff)) * AW + hh * HD, hi);
                const int ql = e & 0x3fff, slot = e >> 14, qrow = b * S + ql, qrel = ql - j * 256;
                const bool fast = __all(qrel - 255 >= 1512);
                f32x16 O[4]; float m, l;
                attn_core<0>(lds, qf, qrel, SC, 4, fast, cbias, O, m, l, lane);
                store_o16(PO + ((size_t)slot * T + qrow) * AW + hh * HD, O, 1.0f / l, hi, valid);
                if (valid) {
                    if (hi == 0) __hip_atomic_store((unsigned long long*)PML + ((size_t)(qrow * NH + hh) * 3 + slot), ((unsigned long long)__float_as_uint(l) << 32) | (unsigned long long)__float_as_uint(m), __ATOMIC_RELAXED, __HIP_MEMORY_SCOPE_AGENT);
                }
            }
            __syncthreads();
            g = end; ++bhj;
            while (bhj < NB * NH * NBLK && (unsigned)__builtin_amdgcn_readfirstlane((int)pf[bhj]) == lend) ++bhj;
        }
    }
    SEAM(4);

    for (int rep_ = 0; rep_ < (IN(5) ? 1 + ((REP_MASK >> 5) & 1) : 0); ++rep_) { DECL_PTRS;
        for (int it = blk; it < NB * NH * NBLK; it += G) {
            const int bh = it >> 6, j = it & 63, b = bh >> 3, hh = bh & 7;
            attn_stage(lds, K + (size_t)(b * S + j * 256) * AW + hh * HD, AW, VT + (size_t)(bh * HD) * S + j * 256, S, TB + hh * 2048, tid);
            __syncthreads();
            const int qrel = wave * 32 + l31, qrow = b * S + j * 256 + qrel;
            f32x16 O[4]; float m, l;
            bf16x8 qf[8]; load_q(qf, Q + (size_t)qrow * AW + hh * HD, hi);
            unsigned long long pw[3];
#pragma unroll
            for (int s = 0; s < 3; ++s) { pw[s] = 0ull; if (s < (j < 3 ? j : 3)) pw[s] = __hip_atomic_load((unsigned long long*)PML + ((size_t)(qrow * NH + hh) * 3 + s), __ATOMIC_RELAXED, __HIP_MEMORY_SCOPE_AGENT); }
            attn_core<1>(lds, qf, qrel, SC, (wave >> 1) + 1, false, 0.f, O, m, l, lane);
            const int nsel = j < 3 ? j : 3;
            float M = m, ms[3], lsv[3];
#pragma unroll
            for (int s = 0; s < 3; ++s) { ms[s] = -1e30f; lsv[s] = 0.f; if (s < nsel) { ms[s] = __uint_as_float((unsigned)pw[s]); lsv[s] = __uint_as_float((unsigned)(pw[s] >> 32)); M = fmaxf(M, ms[s]); } }
            const float wown = ex2(m - M); float den = l * wown, wsl[3];
#pragma unroll
            for (int s = 0; s < 3; ++s) { wsl[s] = lsv[s] * ex2(ms[s] - M); den += wsl[s]; }
            const float inv = 1.0f / den;
            bf16* op = AC + (size_t)qrow * DM + hh * HD + 4 * hi;
#pragma unroll
            for (int hf = 0; hf < 2; ++hf) {
                v2u pp[3][2][4];
#pragma unroll
                for (int s = 0; s < 3; ++s) if (s < nsel) {
#pragma unroll
                    for (int d2 = 0; d2 < 2; ++d2)
#pragma unroll
                        for (int g4 = 0; g4 < 4; ++g4) pp[s][d2][g4] = *(const v2u*)(PO + ((size_t)s * T + qrow) * AW + hh * HD + 4 * hi + 32 * (2 * hf + d2) + 8 * g4);
                }
#pragma unroll
                for (int d2 = 0; d2 < 2; ++d2)
#pragma unroll
                    for (int g4 = 0; g4 < 4; ++g4) { const int dt = 2 * hf + d2;
                        float o0 = O[dt][4 * g4] * wown, o1 = O[dt][4 * g4 + 1] * wown, o2 = O[dt][4 * g4 + 2] * wown, o3 = O[dt][4 * g4 + 3] * wown;
#pragma unroll
                        for (int s = 0; s < 3; ++s) if (s < nsel) { const v2u p = pp[s][d2][g4];
                            o0 += wsl[s] * bf_lo(p.x); o1 += wsl[s] * bf_hi(p.x); o2 += wsl[s] * bf_lo(p.y); o3 += wsl[s] * bf_hi(p.y); }
                        v2u w; w.x = pk2(o0 * inv, o1 * inv); w.y = pk2(o2 * inv, o3 * inv); *(v2u*)(op + 32 * dt + 8 * g4) = w;
                    }
            }
            __syncthreads();
        }
    }
    SEAM(5);

#if DBG == 2
    { DECL_PTRS; for (size_t i = (size_t)blk * 512 + tid; i < (size_t)T * DM; i += (size_t)G * 512) out[i] = __uint_as_float(((unsigned)AC[i] << 16)); return; }
#endif
    for (int rep_ = 0; rep_ < (IN(6) ? 1 + ((REP_MASK >> 6) & 1) : 0); ++rep_) { DECL_PTRS;
        pg8::Gemm g{AC, WOUT_T, T, DM, DM}; pg8::StaticOrder So; So.init(T, DM, G, blk);
        pg8::EpiResBf16Ssq<0> E{x, NBUF, DM, SSQ1, nullptr};
        pg8::gemm_phase<pg8::EpiResBf16Ssq<0>, pg8::StaticOrder, true, true>(lds, g, So, E, tid);
    }
    SEAM2(6, 8);
#if DBG == 3
    return;
#endif
    for (int rep_ = 0; rep_ < (IN(8) ? 1 + ((REP_MASK >> 8) & 1) : 0); ++rep_) { DECL_PTRS;
        pg8::Gemm g{NBUF, WQ_T, T, XW, DM}; pg8::StaticOrder So; So.init(T, XW, G, blk);
        pg8::EpiBf16X<0, 1> E{QC, XW, 0, 0, -1, nullptr, 1, 1, SSQ1};
        pg8::gemm_phase<pg8::EpiBf16X<0, 1>, pg8::StaticOrder, true, true>(lds, g, So, E, tid);
    }
    for (int rep_ = 0; rep_ < (IN(9) ? 1 + ((REP_MASK >> 9) & 1) : 0); ++rep_) { DECL_PTRS;
        asm volatile("s_waitcnt vmcnt(0)" ::: "memory"); __syncthreads();
        pg8::StaticOrder So8; So8.init(T, XW, G, blk); pg8::Unit u8;
        for (int ui = 0; So8.next(ui >> 1, u8); ++ui) {
            const int tl = u8.pm, hc = 2 * u8.pn + (ui & 1), b = tl / (S / 256);
            attn_stage(lds, KC + (size_t)(b * NMEM) * XW + hc * HD, XW, VCT + (size_t)((b * XH + hc) * HD) * NMEM, NMEM, nullptr, tid);
            __syncthreads();
            const int qrow = tl * 256 + wave * 32 + l31;
            f32x16 O[4]; float m, l;
            bf16x8 qf[8]; load_q(qf, QC + (size_t)qrow * XW + hc * HD, hi);
            attn_core<2>(lds, qf, 0, SC, 4, false, 0.f, O, m, l, lane);
            store_o16(OC + (size_t)qrow * XW + hc * HD, O, 1.0f / l, hi, true);
            __syncthreads();
        }
    }
    SEAM(9);
#if DBG == 10
    return;
#endif
#if DBG == 7
    { DECL_PTRS; for (size_t i = (size_t)blk * 512 + tid; i < (size_t)T * DM; i += (size_t)G * 512) { const size_t t = i >> 11, c = i & 2047; out[i] = c < 512 ? __uint_as_float(((unsigned)QC[t * 512 + c] << 16)) : 0.f; } return; }
#endif
#if DBG == 8
    { DECL_PTRS; for (size_t i = (size_t)blk * 512 + tid; i < (size_t)T * DM; i += (size_t)G * 512) { const size_t t = i >> 11, c = i & 2047; out[i] = c < 512 ? __uint_as_float(((unsigned)OC[t * 512 + c] << 16)) : 0.f; } return; }
#endif
#if DBG == 5
    { DECL_PTRS; for (size_t i = (size_t)blk * 512 + tid; i < (size_t)T * DM; i += (size_t)G * 512) { const size_t t = i >> 11, c = i & 2047; out[i] = c < 512 ? __uint_as_float(((unsigned)OC[t * 512 + c] << 16)) : (c < 1024 ? __uint_as_float(((unsigned)QC[t * 512 + c - 512] << 16)) : 0.f); } return; }
#endif
    for (int rep_ = 0; rep_ < (IN(10) ? 1 + ((REP_MASK >> 10) & 1) : 0); ++rep_) { DECL_PTRS;
        pg8::Gemm g{OC, WO_T, T, DM, XW}; pg8::StaticOrder So; So.init(T, DM, G, blk);
        pg8::EpiResBf16Ssq<1> E{NBUF, NBUF, DM, SSQ2, nullptr};
        pg8::gemm_phase<pg8::EpiResBf16Ssq<1>, pg8::StaticOrder, true, true>(lds, g, So, E, tid);
    }
    SEAM2(10, 12);
#if DBG == 4
    return;
#endif
    for (int rep_ = 0; rep_ < (IN(12) ? 1 + ((REP_MASK >> 12) & 1) : 0); ++rep_) { DECL_PTRS;
        pg8::Gemm g{NBUF, W1_T, T, FF, DM}; pg8::StaticOrder So; So.init(T, FF, G, blk);
        pg8::EpiBf16X<2, 0> E{FB, FF, 0, 0, -1, nullptr, 1, 1, nullptr};
        pg8::gemm_phase<pg8::EpiBf16X<2, 0>, pg8::StaticOrder, true, true>(lds, g, So, E, tid);
    }
    SEAM(12);
    for (int rep_ = 0; rep_ < (IN(13) ? 1 + ((REP_MASK >> 13) & 1) : 0); ++rep_) { DECL_PTRS;
        pg8::Gemm g{FB, W2_T, T, DM, FF}; pg8::StaticOrder So; So.init(T, DM, G, blk);
        pg8::EpiResBf16Ssq<1, 1> E{NBUF, NBUF, DM, SSQ3, SSQ2};
        pg8::gemm_phase<pg8::EpiResBf16Ssq<1, 1>, pg8::StaticOrder, true, true>(lds, g, So, E, tid);
    }
    SEAM(13);
    for (int rep_ = 0; rep_ < (IN(14) ? 1 : 0); ++rep_) { DECL_PTRS;
        const int gw = blk * 8 + wave, NGW = G * 8;
        f32x4 gv[8];
#pragma unroll
        for (int jj = 0; jj < 8; ++jj) gv[jj] = ((const f32x4*)g_final)[lane + 64 * jj];
        for (int mrow = gw; mrow < T; mrow += NGW) {
            const float rstd = 1.0f / sqrtf(SSQ3[mrow] * (1.0f / DM) + EPS);
            const v2u* hr = (const v2u*)(NBUF + (size_t)mrow * DM) + lane; f32x4* o = (f32x4*)(out + (size_t)mrow * DM) + lane;
            v2u hv[8];
#pragma unroll
            for (int jj = 0; jj < 8; ++jj) hv[jj] = hr[64 * jj];
#pragma unroll
            for (int jj = 0; jj < 8; ++jj) o[64 * jj] = (f32x4){bf_lo(hv[jj].x) * rstd * gv[jj].x, bf_hi(hv[jj].x) * rstd * gv[jj].y, bf_lo(hv[jj].y) * rstd * gv[jj].z, bf_hi(hv[jj].y) * rstd * gv[jj].w};
        }
    }
#undef IN
#undef SEAM
}

extern "C" void kernel_launch(void* const* d_in, const int* in_sizes, int n_in, void* d_out, int out_size, void* d_ws, size_t ws_size, hipStream_t stream) {
    static int grid = 0;
    if (grid == 0) {
        if (n_in != 20 || out_size != T * DM || ws_size < WS_END) { fprintf(stderr, "kernel_launch: unexpected sizes n_in %d out %d ws %zu\n", n_in, out_size, ws_size); grid = -1; return; }
        int dev = 0, cus = 0, per_cu = 0;
        (void)hipGetDevice(&dev); (void)hipDeviceGetAttribute(&cus, hipDeviceAttributeMultiprocessorCount, dev);
        (void)hipFuncSetAttribute((const void*)fwd, hipFuncAttributeMaxDynamicSharedMemorySize, LDS_BYTES);
        (void)hipOccupancyMaxActiveBlocksPerMultiprocessor(&per_cu, (const void*)fwd, 512, LDS_BYTES);
        if (per_cu < 1) { fprintf(stderr, "kernel_launch: occupancy query says %d blocks per CU\n", per_cu); per_cu = 1; }
        grid = cus;
        (void)hipGetLastError();
    }
    if (grid < 0) return;
    if (hipMemsetAsync((char*)d_ws + WS_CTL, 0, 1048576, stream) != hipSuccess) { fprintf(stderr, "kernel_launch: memset failed\n"); return; }
    Args a{};
    for (int i = 0; i < 20; ++i) a.in[i] = (const float*)d_in[i];
    a.out = (float*)d_out; a.ws = (unsigned char*)d_ws;
#if MK_PER_PHASE
    for (int p = 0; p < NPHASE; ++p) { if (p == 7 || p == 11) continue; a.ph_lo = p; a.ph_hi = p + 1; hipLaunchKernelGGL(fwd, dim3(grid), dim3(512), LDS_BYTES, stream, a); }
#else
    a.ph_lo = 0; a.ph_hi = NPHASE;
    void* args[] = {&a};
    hipError_t e = hipLaunchCooperativeKernel((const void*)fwd, dim3(grid), dim3(512), args, LDS_BYTES, stream);
    if (e != hipSuccess) fprintf(stderr, "kernel_launch: cooperative launch failed: %s (grid %d)\n", hipGetErrorString(e), grid);
#endif
}
```

```cpp
#include <hip/hip_runtime.h>
#include <cstdio>
#include <cstdint>
namespace pg8 {
#define PG8_LAS __attribute__((address_space(3)))
typedef unsigned short bf16_t;
typedef short bf16x8 __attribute__((ext_vector_type(8)));
typedef float f32x4 __attribute__((ext_vector_type(4)));
typedef unsigned u32x4 __attribute__((ext_vector_type(4)));
constexpr int BM = 256, BK = 64, HALF = 128, HTB = HALF * BK * 2  , STAGE_BYTES = 8 * HTB, NXCD = 8, WGM = 8;

__host__ __device__ __forceinline__ int lds_byte(int r, int c) { const int st = (r >> 4) * 2 + (c >> 5), rr = r & 15, cc = c & 31, ob = rr * 64 + cc * 2; return st * 1024 + (ob ^ (((ob >> 9) & 1) << 5)); }
__host__ __device__ __forceinline__ void stage_rc(int b, int& R, int& C) { const int st = b / 1024, sb = b % 1024, swz = sb ^ (((sb >> 9) & 1) << 5); R = (st >> 1) * 16 + swz / 64; C = (st & 1) * 32 + (swz % 64) / 2; }
__host__ __device__ __forceinline__ int perm32(int rho) { const int n = rho >> 4, i = rho & 15; return 8 * (i >> 2) + 4 * n + (i & 3); }

struct Unit { int pm, pn; };
struct Gemm { const bf16_t* A; const bf16_t* Bt; int M, N, K; };

struct StaticOrder {
    int nM, nN, nwg, G, c;
    __host__ __device__ void init(int M, int N, int G_, int c_) { nM = M / BM; nN = N / BM; nwg = nM * nN; G = G_; c = c_; }
    __host__ __device__ bool next(int i, Unit& u) const {
        const long L = (long)i * G + c; if (L >= nwg) return false;
        int wgid = (int)L; { const int q = nwg / NXCD, r = nwg % NXCD, xcd = wgid % NXCD, off = wgid / NXCD; wgid = (xcd < r ? xcd * (q + 1) : r * (q + 1) + (xcd - r) * q) + off; }
        const int nig = WGM * nN, gid = wgid / nig, fm = gid * WGM, gsz = (nM - fm) < WGM ? (nM - fm) : WGM;
        u.pm = fm + ((wgid % nig) % gsz); u.pn = (wgid % nig) / gsz; return true;
    }
    __device__ __forceinline__ void a_ready(const Unit&) const {}
    __device__ __forceinline__ void done(const Unit&) const {}
};

__device__ __forceinline__ unsigned cvt_pk_bf16(float lo, float hi) { unsigned r; asm volatile("v_cvt_pk_bf16_f32 %0, %1, %2" : "=v"(r) : "v"(lo), "v"(hi)); return r; }
typedef float f32x2 __attribute__((ext_vector_type(2)));
__device__ __forceinline__ f32x2 gelu_pk(f32x2 v) {
    const f32x2 av = __builtin_elementwise_abs(v), d = av * 0.2316418882f + 1.0f;
    f32x2 t; t.x = __builtin_amdgcn_rcpf(d.x); t.y = __builtin_amdgcn_rcpf(d.y);
    f32x2 q = t * 0.5307027145f + (-0.7265760135f); q = q * t + 0.7107068705f; q = q * t + (-0.142248368f); q = q * t + 0.127414796f; q = q * t;
    const f32x2 s = (v * v) * (-0.72134752044f);
    f32x2 e; e.x = __builtin_amdgcn_exp2f(s.x); e.y = __builtin_amdgcn_exp2f(s.y);
    const f32x2 m = v * (q * e), r = v - m;
    f32x2 o; o.x = v.x < 0.f ? m.x : r.x; o.y = v.y < 0.f ? m.y : r.y; return o;
}


__device__ __forceinline__ unsigned short bf16_1(float v) { return (unsigned short)(cvt_pk_bf16(v, v) & 0xffffu); }
template <int ACT  , int RS = 0  > struct EpiBf16X {
    static constexpr bool PERM = true, AFTER_DRAIN = false;
    bf16_t* O; int ldc; int split_cols; size_t split_stride; int tr_tile; bf16_t* OT; int seqlen; int nheads; const float* ssq;
    __device__ __forceinline__ void operator()(const f32x4 (&acc)[2][2][4][2], const Unit& u, int wr, int wc, int fr, int fq) const {
        const int row0 = u.pm * BM + wr * 64 + fr; int colt = u.pn * BM; bf16_t* base = O; int t = 0;
        if (split_cols) { t = colt / split_cols; base += (size_t)t * split_stride; colt -= t * split_cols; }
        const int col0 = colt + wc * 32 + 8 * fq;
        if (RS == 0 && t == tr_tile) {
#pragma unroll
            for (int ai = 0; ai < 2; ++ai)
#pragma unroll
                for (int m = 0; m < 4; ++m) { const int row = row0 + ai * HALF + m * 16; const int b = row / seqlen, s = row - b * seqlen;
#pragma unroll
                    for (int bj = 0; bj < 2; ++bj)
#pragma unroll
                        for (int n = 0; n < 2; ++n)
#pragma unroll
                            for (int j = 0; j < 4; ++j) { const int col = col0 + bj * HALF + 4 * n + j; const int hh = col >> 7, d = col & 127;
                                OT[((size_t)(b * nheads + hh) * 128 + d) * (size_t)seqlen + s] = bf16_1(acc[ai][bj][m][n][j]); } }
        } else {
#pragma unroll
            for (int ai = 0; ai < 2; ++ai)
#pragma unroll
                for (int m = 0; m < 4; ++m) { bf16_t* rowp = base + (size_t)(row0 + ai * HALF + m * 16) * ldc + col0;
                    float rsc = 1.f;
                    if (RS) { const float r = 1.0f / sqrtf(ssq[row0 + ai * HALF + m * 16] * (1.0f / 2048.0f) + 1e-6f); rsc = (ACT == 2) ? r * r : r; }
#pragma unroll
                    for (int bj = 0; bj < 2; ++bj) { f32x4 v0 = acc[ai][bj][m][0], v1 = acc[ai][bj][m][1];
                        if (RS && ACT != 2) { v0 = v0 * rsc; v1 = v1 * rsc; }
                        if (ACT == 2) {
#pragma unroll
                            for (int j = 0; j < 4; ++j) { float a = v0[j] > 0.f ? v0[j] : 0.f; v0[j] = a * a * rsc; float b = v1[j] > 0.f ? v1[j] : 0.f; v1[j] = b * b * rsc; } }
                        u32x4 w; w.x = cvt_pk_bf16(v0[0], v0[1]); w.y = cvt_pk_bf16(v0[2], v0[3]); w.z = cvt_pk_bf16(v1[0], v1[1]); w.w = cvt_pk_bf16(v1[2], v1[3]);
                        *(u32x4*)(rowp + bj * HALF) = w; } }
        }
    }
};
struct EpiResNorm {
    static constexpr bool PERM = false, AFTER_DRAIN = false;
    const float* base; float* out; int ldc; const float* gain; bf16_t* HG; float* ssq;
    __device__ __forceinline__ void operator()(const f32x4 (&acc)[2][2][4][2], const Unit& u, int wr, int wc, int fr, int fq) const {
        const int row0 = u.pm * BM + wr * 64 + fr, col0 = u.pn * BM + wc * 32 + 4 * fq;
        f32x4 gv[2][2];
#pragma unroll
        for (int bj = 0; bj < 2; ++bj)
#pragma unroll
            for (int n = 0; n < 2; ++n) gv[bj][n] = *(const f32x4*)(gain + col0 + bj * HALF + n * 16);
#pragma unroll
        for (int ai = 0; ai < 2; ++ai)
#pragma unroll
            for (int m = 0; m < 4; ++m) { const int row = row0 + ai * HALF + m * 16; const size_t off = (size_t)row * ldc + col0; float sq = 0.f;
#pragma unroll
                for (int bj = 0; bj < 2; ++bj)
#pragma unroll
                    for (int n = 0; n < 2; ++n) { const f32x4 h = *(const f32x4*)(base + off + bj * HALF + n * 16) + acc[ai][bj][m][n]; *(f32x4*)(out + off + bj * HALF + n * 16) = h;
                        sq += (h[0] * h[0] + h[1] * h[1]) + (h[2] * h[2] + h[3] * h[3]);
                        const f32x4 hg = h * gv[bj][n]; unsigned w0 = cvt_pk_bf16(hg[0], hg[1]), w1 = cvt_pk_bf16(hg[2], hg[3]);
                        typedef unsigned u32x2v __attribute__((ext_vector_type(2))); u32x2v w; w.x = w0; w.y = w1; *(u32x2v*)(HG + off + bj * HALF + n * 16) = w; }
                sq += __shfl_xor(sq, 16); sq += __shfl_xor(sq, 32);
                if (fq == 0) unsafeAtomicAdd(ssq + row, sq); }
    }
};
template <int B16  , int RS2 = 0  > struct EpiResBf16Ssq {
    static constexpr bool PERM = true, AFTER_DRAIN = false;
    const void* base; bf16_t* HB; int ldc; float* ssq; const float* ssq_in;
    __device__ __forceinline__ void operator()(const f32x4 (&acc)[2][2][4][2], const Unit& u, int wr, int wc, int fr, int fq) const {
        const int row0 = u.pm * BM + wr * 64 + fr, col0 = u.pn * BM + wc * 32 + 8 * fq;
        float rq[2][4], sqv[2][4];
#pragma unroll
        for (int ai = 0; ai < 2; ++ai)
#pragma unroll
            for (int m = 0; m < 4; ++m) rq[ai][m] = RS2 ? ssq_in[row0 + ai * HALF + m * 16] : 0.f;
#pragma unroll
        for (int ai = 0; ai < 2; ++ai)
#pragma unroll
            for (int m = 0; m < 4; ++m) { const int row = row0 + ai * HALF + m * 16; const size_t off = (size_t)row * ldc + col0; float sq = 0.f;
                float rs2 = 1.f; if (RS2) rs2 = 1.0f / (rq[ai][m] * (1.0f / 2048.0f) + 1e-6f);
#pragma unroll
                for (int bj = 0; bj < 2; ++bj) { f32x4 b0, b1;
                    if (B16) { const u32x4 bw = *(const u32x4*)((const bf16_t*)base + off + bj * HALF);
                        b0 = (f32x4){__uint_as_float(bw.x << 16), __uint_as_float(bw.x & 0xffff0000u), __uint_as_float(bw.y << 16), __uint_as_float(bw.y & 0xffff0000u)};
                        b1 = (f32x4){__uint_as_float(bw.z << 16), __uint_as_float(bw.z & 0xffff0000u), __uint_as_float(bw.w << 16), __uint_as_float(bw.w & 0xffff0000u)}; }
                    else { b0 = *(const f32x4*)((const float*)base + off + bj * HALF); b1 = *(const f32x4*)((const float*)base + off + bj * HALF + 4); }
                    const f32x4 h0 = RS2 ? b0 + acc[ai][bj][m][0] * rs2 : b0 + acc[ai][bj][m][0], h1 = RS2 ? b1 + acc[ai][bj][m][1] * rs2 : b1 + acc[ai][bj][m][1];
                    sq += ((h0[0] * h0[0] + h0[1] * h0[1]) + (h0[2] * h0[2] + h0[3] * h0[3])) + ((h1[0] * h1[0] + h1[1] * h1[1]) + (h1[2] * h1[2] + h1[3] * h1[3]));
                    u32x4 w; w.x = cvt_pk_bf16(h0[0], h0[1]); w.y = cvt_pk_bf16(h0[2], h0[3]); w.z = cvt_pk_bf16(h1[0], h1[1]); w.w = cvt_pk_bf16(h1[2], h1[3]);
                    *(u32x4*)(HB + off + bj * HALF) = w; }
                sqv[ai][m] = sq; }
#pragma unroll
        for (int ai = 0; ai < 2; ++ai)
#pragma unroll
            for (int m = 0; m < 4; ++m) { float sq = sqv[ai][m]; sq += __shfl_xor(sq, 16); sq += __shfl_xor(sq, 32); if (fq == 0) unsafeAtomicAdd(ssq + row0 + ai * HALF + m * 16, sq); }
    }
};
struct EpiResF32 {
    static constexpr bool PERM = false, AFTER_DRAIN = false;
    const float* base; float* out; int ldc;
    __device__ __forceinline__ void operator()(const f32x4 (&acc)[2][2][4][2], const Unit& u, int wr, int wc, int fr, int fq) const {
        const int row0 = u.pm * BM + wr * 64 + fr, col0 = u.pn * BM + wc * 32 + 4 * fq;
#pragma unroll
        for (int ai = 0; ai < 2; ++ai)
#pragma unroll
            for (int m = 0; m < 4; ++m) { const size_t off = (size_t)(row0 + ai * HALF + m * 16) * ldc + col0;
#pragma unroll
                for (int bj = 0; bj < 2; ++bj)
#pragma unroll
                    for (int n = 0; n < 2; ++n) { const f32x4 bs = *(const f32x4*)(base + off + bj * HALF + n * 16); *(f32x4*)(out + off + bj * HALF + n * 16) = bs + acc[ai][bj][m][n]; } }
    }
};

template <class Epi, class Sched, bool ALIGN_EPI = false, bool SP2 = false>
__device__ __forceinline__ void gemm_phase(PG8_LAS unsigned char* lds, const Gemm g, const Sched& S, const Epi& E, const int tid) {
    const int wid = __builtin_amdgcn_readfirstlane(tid >> 6), lane = tid & 63, wr = wid >> 2, wc = wid & 3, fr = lane & 15, fq = lane >> 4;
    const int K = g.K, nt = K / BK;
    unsigned voffA[2], voffB[2];
#pragma unroll
    for (int i = 0; i < 2; ++i) { int R, C; stage_rc(tid * 16 + i * 8192, R, C); const int Rb = Epi::PERM ? ((R & ~31) + perm32(R & 31)) : R;
        voffA[i] = (unsigned)(R * K + C) * 2u; voffB[i] = (unsigned)(Rb * K + C) * 2u; }
    const size_t kstep = (size_t)(BK * 2);
    const size_t hstep = (size_t)HALF * K * 2;
    const size_t tstep = 2 * hstep;
    const unsigned ldsw = (unsigned)wid * 1024u;
    const int aoff = lds_byte(wr * 64 + fr, fq * 8), boff = lds_byte(wc * 32 + fr, fq * 8);
#define PG8_SA(b, h) (((b) * 2 + (h)) * HTB)
#define PG8_SB(b, h) ((4 + (b) * 2 + (h)) * HTB)
#define PG8_STAGE(bufoff, gbase, voff) do { _Pragma("unroll") for (int _i = 0; _i < 2; ++_i) \
        __builtin_amdgcn_global_load_lds((const unsigned*)((const char*)(gbase) + (voff)[_i]), (PG8_LAS unsigned*)(lds + (bufoff) + ldsw + _i * 8192), 16, 0, 0); } while (0)
#define PG8_LDA(dst, b, h) do { _Pragma("unroll") for (int m = 0; m < 4; ++m) _Pragma("unroll") for (int k = 0; k < 2; ++k) dst[m][k] = *(const PG8_LAS bf16x8*)(lds + PG8_SA(b, h) + aoff + m * 2048 + k * 1024); } while (0)
#define PG8_LDB(dst, b, h) do { _Pragma("unroll") for (int n = 0; n < 2; ++n) _Pragma("unroll") for (int k = 0; k < 2; ++k) dst[n][k] = *(const PG8_LAS bf16x8*)(lds + PG8_SB(b, h) + boff + n * 2048 + k * 1024); } while (0)
#define PG8_MMA(ai, bj, At, Bt) do { __builtin_amdgcn_s_setprio(1); _Pragma("unroll") for (int m = 0; m < 4; ++m) _Pragma("unroll") for (int n = 0; n < 2; ++n) _Pragma("unroll") for (int k = 0; k < 2; ++k) \
        acc[ai][bj][m][n] = __builtin_amdgcn_mfma_f32_16x16x32_bf16(Bt[n][k], At[m][k], acc[ai][bj][m][n], 0, 0, 0); __builtin_amdgcn_s_setprio(0); } while (0)
#define PG8_WAIT_V(n) asm volatile("s_waitcnt vmcnt(" #n ")" ::: "memory")
#define PG8_WAIT_L(n) asm volatile("s_waitcnt lgkmcnt(" #n ")" ::: "memory")
#define PG8_BAR __builtin_amdgcn_s_barrier()
#define PG8_SCHED __builtin_amdgcn_sched_barrier(0)
    Unit cur, nxt; int ui = 0;
    if (!S.next(0, cur)) return;
    f32x4 acc[2][2][4][2];
#pragma unroll
    for (int a = 0; a < 2; ++a)
#pragma unroll
        for (int b = 0; b < 2; ++b)
#pragma unroll
            for (int m = 0; m < 4; ++m)
#pragma unroll
                for (int n = 0; n < 2; ++n) acc[a][b][m][n] = (f32x4){0.f, 0.f, 0.f, 0.f};
    bf16x8 At[4][2], B0[2][2], B1[2][2];
    const char* cA = (const char*)g.A + (size_t)cur.pm * tstep; const char* cB = (const char*)g.Bt + (size_t)cur.pn * tstep;
    S.a_ready(cur);
    if constexpr (SP2) {
        PG8_STAGE(PG8_SB(0, 0), cB, voffB); PG8_STAGE(PG8_SB(0, 1), cB + hstep, voffB); PG8_STAGE(PG8_SA(0, 0), cA, voffA); PG8_STAGE(PG8_SA(0, 1), cA + hstep, voffA);
        if (wr == 1) PG8_BAR;
        PG8_WAIT_V(2); PG8_BAR;
        PG8_STAGE(PG8_SB(1, 0), cB + kstep, voffB); PG8_STAGE(PG8_SA(1, 0), cA + kstep, voffA); PG8_STAGE(PG8_SB(1, 1), cB + hstep + kstep, voffB);
        PG8_WAIT_V(6); PG8_BAR;
    } else {
        PG8_STAGE(PG8_SB(0, 0), cB, voffB); PG8_STAGE(PG8_SA(0, 0), cA, voffA); PG8_STAGE(PG8_SB(0, 1), cB + hstep, voffB); PG8_STAGE(PG8_SA(0, 1), cA + hstep, voffA);
        if (wr == 1) PG8_BAR;
        PG8_WAIT_V(4); PG8_BAR;
        PG8_STAGE(PG8_SB(1, 0), cB + kstep, voffB); PG8_STAGE(PG8_SA(1, 0), cA + kstep, voffA); PG8_STAGE(PG8_SB(1, 1), cB + hstep + kstep, voffB);
        PG8_WAIT_V(6); PG8_BAR;
    }
    for (;;) {
        const bool has_next = S.next(ui + 1, nxt);
        const char* nA = has_next ? (const char*)g.A + (size_t)nxt.pm * tstep : cA; const char* nB = has_next ? (const char*)g.Bt + (size_t)nxt.pn * tstep : cB;
        for (int t = 0; t < nt; t += 2) {
            const bool last = (t == nt - 2);
            const char* a1 = cA + (size_t)(t + 1) * kstep;
            const char* a2 = last ? nA : cA + (size_t)(t + 2) * kstep; const char* b2 = last ? nB : cB + (size_t)(t + 2) * kstep;
            const char* a3 = a2 + kstep; const char* b3 = b2 + kstep;
            if (last && has_next) S.a_ready(nxt);
            if constexpr (SP2) {
            PG8_LDB(B0, 0, 0); PG8_LDB(B1, 0, 1); PG8_SCHED; PG8_LDA(At, 0, 0); PG8_STAGE(PG8_SA(1, 1), a1 + hstep, voffA);
            PG8_WAIT_V(8); PG8_WAIT_L(0); PG8_BAR; PG8_MMA(0, 0, At, B0); PG8_MMA(0, 1, At, B1); PG8_BAR; PG8_SCHED;
            PG8_LDA(At, 0, 1); PG8_STAGE(PG8_SB(0, 0), b2, voffB); PG8_STAGE(PG8_SB(0, 1), b2 + hstep, voffB); PG8_STAGE(PG8_SA(0, 0), a2, voffA);
            PG8_WAIT_V(8); PG8_WAIT_L(0); PG8_BAR; PG8_MMA(1, 0, At, B0); PG8_MMA(1, 1, At, B1); PG8_BAR; PG8_SCHED;
            PG8_LDB(B0, 1, 0); PG8_LDB(B1, 1, 1); PG8_SCHED; PG8_LDA(At, 1, 0); PG8_STAGE(PG8_SA(0, 1), a2 + hstep, voffA);
            PG8_WAIT_V(8); PG8_WAIT_L(0); PG8_BAR; PG8_MMA(0, 0, At, B0); PG8_MMA(0, 1, At, B1); PG8_BAR; PG8_SCHED;
            PG8_LDA(At, 1, 1); PG8_STAGE(PG8_SB(1, 0), b3, voffB); PG8_STAGE(PG8_SB(1, 1), b3 + hstep, voffB); PG8_STAGE(PG8_SA(1, 0), a3, voffA);
            PG8_WAIT_V(8); PG8_WAIT_L(0); PG8_BAR; PG8_MMA(1, 0, At, B0); PG8_MMA(1, 1, At, B1); PG8_BAR; PG8_SCHED;
            } else {
            PG8_LDB(B0, 0, 0); PG8_SCHED; PG8_LDA(At, 0, 0); PG8_STAGE(PG8_SA(1, 1), a1 + hstep, voffA);
            PG8_WAIT_L(8); PG8_BAR; PG8_WAIT_L(0); PG8_MMA(0, 0, At, B0); PG8_BAR; PG8_SCHED;
            PG8_LDB(B1, 0, 1); PG8_STAGE(PG8_SB(0, 0), b2, voffB);
            PG8_BAR; PG8_WAIT_L(0); PG8_MMA(0, 1, At, B1); PG8_BAR;
            PG8_LDA(At, 0, 1); PG8_STAGE(PG8_SA(0, 0), a2, voffA);
            PG8_BAR; PG8_WAIT_L(0); PG8_MMA(1, 0, At, B0); PG8_BAR; PG8_SCHED;
            PG8_STAGE(PG8_SB(0, 1), b2 + hstep, voffB);
            PG8_WAIT_V(6); PG8_BAR; PG8_MMA(1, 1, At, B1); PG8_BAR;
            PG8_LDB(B0, 1, 0); PG8_SCHED; PG8_LDA(At, 1, 0); PG8_STAGE(PG8_SA(0, 1), a2 + hstep, voffA);
            PG8_WAIT_L(8); PG8_BAR; PG8_WAIT_L(0); PG8_MMA(0, 0, At, B0); PG8_BAR; PG8_SCHED;
            PG8_LDB(B1, 1, 1); PG8_STAGE(PG8_SB(1, 0), b3, voffB);
            PG8_BAR; PG8_WAIT_L(0); PG8_MMA(0, 1, At, B1); PG8_BAR;
            PG8_LDA(At, 1, 1); PG8_STAGE(PG8_SA(1, 0), a3, voffA);
            PG8_BAR; PG8_WAIT_L(0); PG8_MMA(1, 0, At, B0); PG8_BAR; PG8_SCHED;
            PG8_STAGE(PG8_SB(1, 1), b3 + hstep, voffB);
            PG8_WAIT_V(6); PG8_BAR; PG8_MMA(1, 1, At, B1); PG8_BAR;
            }
        }
        if constexpr (ALIGN_EPI) { if (wr == 0) PG8_BAR; }
        if constexpr (!Epi::AFTER_DRAIN) { E(acc, cur, wr, wc, fr, fq); S.done(cur); }
        if (!has_next) break;
#pragma unroll
        for (int a = 0; a < 2; ++a)
#pragma unroll
            for (int b = 0; b < 2; ++b)
#pragma unroll
                for (int m = 0; m < 4; ++m)
#pragma unroll
                    for (int n = 0; n < 2; ++n) acc[a][b][m][n] = (f32x4){0.f, 0.f, 0.f, 0.f};
        cur = nxt; cA = nA; cB = nB; ++ui;
        if constexpr (ALIGN_EPI) { if (wr == 1) PG8_BAR; }
    }
    PG8_WAIT_V(0);
    if constexpr (!ALIGN_EPI) { if (wr == 0) PG8_BAR; }
    PG8_BAR;
    if constexpr (Epi::AFTER_DRAIN) { E.fused(acc, cur, wr, wc, fr, fq, lds, wid, lane); S.done(cur); }
#undef PG8_SA
#undef PG8_SB
#undef PG8_STAGE
#undef PG8_LDA
#undef PG8_LDB
#undef PG8_MMA
#undef PG8_WAIT_V
#undef PG8_WAIT_L
#undef PG8_BAR
#undef PG8_SCHED
}
}

#include <hip/hip_cooperative_groups.h>
namespace cg = cooperative_groups;
#define LAS __attribute__((address_space(3)))
typedef unsigned short bf16;
typedef unsigned v4u __attribute__((ext_vector_type(4)));
typedef unsigned v2u __attribute__((ext_vector_type(2)));
typedef float f32x4 __attribute__((ext_vector_type(4)));
typedef float f32x2 __attribute__((ext_vector_type(2)));
typedef float f32x16 __attribute__((ext_vector_type(16)));
typedef short bf16x8 __attribute__((ext_vector_type(8)));

#ifndef MK_PER_PHASE
#define MK_PER_PHASE 0
#endif
constexpr int NB = 2, S = 16384, DM = 2048, T = NB * S, NH = 8, HD = 128, AW = 1024, CC = 1024, INW = 5120, FF = 8192, NMEM = 256, XH = 4, XW = 512, CONVK = 31, NBLK = 64;
constexpr float EPS = 1e-6f, LOG2E = 1.4426950408889634f;
constexpr int NPHASE = 15;
constexpr size_t MiB = 1u << 20;
constexpr size_t WS_CTL = 0; constexpr int CW_BAR = 4096;
constexpr size_t WS_WIN = 2 * MiB, WS_WOUT = 22 * MiB, WS_WQ = 30 * MiB, WS_WKV = 32 * MiB, WS_WO = 36 * MiB, WS_W1 = 38 * MiB, WS_W2 = 70 * MiB;
constexpr size_t WS_KBAR = 102 * MiB, WS_TB = 103 * MiB, WS_MN = 104 * MiB, WS_KC = 106 * MiB, WS_VCT = 107 * MiB;
constexpr size_t WS_NB = 112 * MiB;
constexpr size_t WS_Q = 240 * MiB, WS_K = 304 * MiB, WS_VT = 368 * MiB, WS_UV = 432 * MiB, WS_UG = 496 * MiB;
constexpr size_t WS_AC = 560 * MiB;
constexpr size_t WS_F = 240 * MiB;
constexpr size_t WS_QC = 240 * MiB, WS_OC = 272 * MiB;
constexpr size_t WS_PO = 752 * MiB;
constexpr size_t WS_PML = 944 * MiB;
constexpr size_t WS_LIST = 952 * MiB;
constexpr size_t WS_END = 1016 * MiB;
constexpr int LDS_BYTES = 152064;
constexpr int KS_OFF = 0, KROW = 272, VS_OFF = 256 * 272, VROW = 528, TB_OFF = VS_OFF + 128 * 528, RED_OFF = TB_OFF + 8192, CNT_OFF = RED_OFF + 2048, PT_OFF = CNT_OFF + 4096, ST_OFF = PT_OFF + 192;
static_assert(PT_OFF + 256 <= LDS_BYTES, "LDS map");

__device__ __forceinline__ float bf_lo(unsigned w) { return __uint_as_float(w << 16); }
__device__ __forceinline__ float bf_hi(unsigned w) { return __uint_as_float(w & 0xffff0000u); }
typedef __bf16 bf16x2_t __attribute__((ext_vector_type(2)));
__device__ __forceinline__ unsigned pk2(float lo, float hi) { return pg8::cvt_pk_bf16(lo, hi); }
__device__ __forceinline__ unsigned pk2s(float lo, float hi) { f32x2 v = {lo, hi}; bf16x2_t b = __builtin_convertvector(v, bf16x2_t); return __builtin_bit_cast(unsigned, b); }
__device__ __forceinline__ float ex2(float x) { return __builtin_amdgcn_exp2f(x); }
__device__ __forceinline__ float wave_sum(float v) {
#pragma unroll
    for (int o = 1; o < 64; o <<= 1) v += __shfl_xor(v, o);
    return v;
}
__device__ __forceinline__ float sigmoidf_(float x) { return 1.0f / (1.0f + __expf(-x)); }

__device__ __forceinline__ void p0_transpose_item(const float* W, int K, int N, bf16* WT, int row_off, LAS float* scr, int item, int lane, const float* gk = nullptr) {
    const int nblk = N / 32, kb = item / nblk, nb = item % nblk, k0 = 64 * kb, n0 = 32 * nb;
    float wv[32];
#pragma unroll
    for (int i = 0; i < 32; ++i) { const int kk = 2 * i + (lane >> 5); wv[i] = W[(size_t)(k0 + kk) * N + n0 + (lane & 31)]; }
    if (gk) {
#pragma unroll
        for (int i = 0; i < 32; ++i) wv[i] *= gk[k0 + 2 * i + (lane >> 5)];
    }
#pragma unroll
    for (int i = 0; i < 32; ++i) { const int kk = 2 * i + (lane >> 5); scr[kk * 33 + (lane & 31)] = wv[i]; }
    asm volatile("s_waitcnt lgkmcnt(0)" ::: "memory");
    const int c = lane & 7;
#pragma unroll
    for (int j = 0; j < 4; ++j) { const int n = (lane >> 3) + 8 * j; const LAS float* s = scr + (8 * c) * 33 + n;
        v4u o; o.x = pk2(s[0 * 33], s[1 * 33]); o.y = pk2(s[2 * 33], s[3 * 33]); o.z = pk2(s[4 * 33], s[5 * 33]); o.w = pk2(s[6 * 33], s[7 * 33]);
        *(v4u*)(WT + (size_t)(row_off + n0 + n) * K + k0 + 8 * c) = o; }
    asm volatile("s_waitcnt lgkmcnt(0)" ::: "memory");
}
__device__ __forceinline__ void rms_row_bf16(const float* xrow, const float* g, bf16* orow, int lane) {
    const f32x4* xr = (const f32x4*)xrow + lane; f32x4 v[8]; float s = 0.f;
#pragma unroll
    for (int j = 0; j < 8; ++j) { v[j] = xr[64 * j]; s += (v[j].x * v[j].x + v[j].y * v[j].y) + (v[j].z * v[j].z + v[j].w * v[j].w); }
    const float rstd = 1.0f / sqrtf(wave_sum(s) * (1.0f / DM) + EPS);
    const f32x4* gr = (const f32x4*)g + lane; v2u* o8 = (v2u*)orow + lane;
#pragma unroll
    for (int j = 0; j < 8; ++j) { const f32x4 gv = gr[64 * j]; v2u w; w.x = pk2(v[j].x * rstd * gv.x, v[j].y * rstd * gv.y); w.y = pk2(v[j].z * rstd * gv.z, v[j].w * rstd * gv.w); o8[64 * j] = w; }
}
__device__ __forceinline__ void rms_row_f32(const float* xrow, const float* g, float* orow, int lane) {
    const f32x4* xr = (const f32x4*)xrow + lane; f32x4 v[8]; float s = 0.f;
#pragma unroll
    for (int j = 0; j < 8; ++j) { v[j] = xr[64 * j]; s += (v[j].x * v[j].x + v[j].y * v[j].y) + (v[j].z * v[j].z + v[j].w * v[j].w); }
    const float rstd = 1.0f / sqrtf(wave_sum(s) * (1.0f / DM) + EPS);
    const f32x4* gr = (const f32x4*)g + lane; f32x4* o = (f32x4*)orow + lane;
#pragma unroll
    for (int j = 0; j < 8; ++j) { const f32x4 gv = gr[64 * j]; o[64 * j] = v[j] * rstd * gv; }
}

__device__ __forceinline__ int crow(int r, int hi) { return (r & 3) + 8 * (r >> 2) + 4 * hi; }
__device__ __forceinline__ void attn_stage(LAS unsigned char* lds, const bf16* Kg, unsigned kstride, const bf16* VTg, unsigned vstride, const float* tbg, int tid) {
    const unsigned ko = (unsigned)(tid >> 4) * (kstride * 2u) + (unsigned)(tid & 15) * 16u, vo = (unsigned)(tid >> 5) * (vstride * 2u) + (unsigned)(tid & 31) * 16u;
    const unsigned kl = (unsigned)(tid >> 4) * KROW + (unsigned)(tid & 15) * 16u, vl = (unsigned)(tid >> 5) * VROW + (unsigned)(tid & 31) * 16u;
    v4u kx[8], vx[8];
#pragma unroll
    for (int p = 0; p < 8; ++p) kx[p] = *(const v4u*)((const unsigned char*)Kg + (size_t)p * 32 * kstride * 2 + ko);
#pragma unroll
    for (int p = 0; p < 8; ++p) vx[p] = *(const v4u*)((const unsigned char*)VTg + (size_t)p * 16 * vstride * 2 + vo);
#pragma unroll
    for (int p = 0; p < 8; ++p) *(LAS v4u*)(lds + KS_OFF + p * 32 * KROW + kl) = kx[p];
#pragma unroll
    for (int p = 0; p < 8; ++p) *(LAS v4u*)(lds + VS_OFF + p * 16 * VROW + vl) = vx[p];
    if (tbg) { const f32x4 x = ((const f32x4*)tbg)[tid]; ((LAS f32x4*)(lds + TB_OFF))[tid] = x; }
}
__device__ __forceinline__ void load_q(bf16x8 (&qf)[8], const bf16* qp, int hi) {
#pragma unroll
    for (int ks = 0; ks < 8; ++ks) qf[ks] = *(const bf16x8*)(qp + 16 * ks + 8 * hi);
}
__device__ __forceinline__ void store_o16(bf16* rowbase, const f32x16 (&O)[4], float scale, int hi, bool doit) {
#pragma unroll
    for (int dt = 0; dt < 4; ++dt)
#pragma unroll
        for (int gp = 0; gp < 2; ++gp) {
            const int ga = 2 * gp, gb = 2 * gp + 1;
            const unsigned ax = pk2(O[dt][4 * ga] * scale, O[dt][4 * ga + 1] * scale), ay = pk2(O[dt][4 * ga + 2] * scale, O[dt][4 * ga + 3] * scale);
            const unsigned bx = pk2(O[dt][4 * gb] * scale, O[dt][4 * gb + 1] * scale), by = pk2(O[dt][4 * gb + 2] * scale, O[dt][4 * gb + 3] * scale);
            const v2u r1 = __builtin_amdgcn_permlane32_swap(ax, bx, false, false), r2 = __builtin_amdgcn_permlane32_swap(ay, by, false, false);
            v4u w; w.x = r1.x; w.y = r2.x; w.z = r1.y; w.w = r2.y;
            if (doit) *(v4u*)(rowbase + 32 * dt + 8 * (hi ? gb : ga)) = w;
        }
}
template <int MODE>
__device__ __forceinline__ void attn_core(LAS unsigned char* lds, const bf16x8 (&qf)[8], int qrel, float sc, int nchunks, bool fast, float cbias, f32x16 (&O)[4], float& m, float& l, int lane) {
    const int l31 = lane & 31, hi = lane >> 5;
#pragma unroll
    for (int dt = 0; dt < 4; ++dt)
#pragma unroll
        for (int r = 0; r < 16; ++r) O[dt][r] = 0.f;
    m = -1e30f; l = 0.f;
    const LAS float* tb = (const LAS float*)(lds + TB_OFF);
#pragma unroll 1
    for (int c = 0; c < nchunks; ++c) {
        f32x16 s0, s1;
#pragma unroll
        for (int r = 0; r < 16; ++r) { s0[r] = 0.f; s1[r] = 0.f; }
        const LAS unsigned char* kp = lds + KS_OFF + (64 * c + l31) * KROW + 16 * hi;
#pragma unroll
        for (int h2 = 0; h2 < 2; ++h2) {
            bf16x8 ka[4], kb[4];
#pragma unroll
            for (int ks = 0; ks < 4; ++ks) { ka[ks] = *(const LAS bf16x8*)(kp + 32 * (4 * h2 + ks)); kb[ks] = *(const LAS bf16x8*)(kp + 32 * KROW + 32 * (4 * h2 + ks)); }
#pragma unroll
            for (int ks = 0; ks < 4; ++ks) {
                s0 = __builtin_amdgcn_mfma_f32_32x32x16_bf16(ka[ks], qf[4 * h2 + ks], s0, 0, 0, 0);
                s1 = __builtin_amdgcn_mfma_f32_32x32x16_bf16(kb[ks], qf[4 * h2 + ks], s1, 0, 0, 0);
            }
        }
        float mx = -INFINITY;
#pragma unroll
        for (int r = 0; r < 16; ++r) {
            const int d0 = qrel - (64 * c + crow(r, hi)), d1 = d0 - 32;
            float t0 = s0[r] * sc, t1 = s1[r] * sc;
            if (MODE == 0) { if (fast) { t0 += cbias; t1 += cbias; } else { t0 += tb[d0 < 2047 ? d0 : 2047]; t1 += tb[d1 < 2047 ? d1 : 2047]; } }
            if (MODE == 1) { t0 = d0 >= 0 ? t0 + tb[d0 > 0 ? d0 : 0] : -INFINITY; t1 = d1 >= 0 ? t1 + tb[d1 > 0 ? d1 : 0] : -INFINITY; }
            s0[r] = t0; s1[r] = t1; mx = fmaxf(mx, fmaxf(t0, t1));
        }
        mx = fmaxf(mx, __shfl_xor(mx, 32));
        const float mn = fmaxf(m, mx), alpha = ex2(m - mn); m = mn;
        float ls = 0.f;
#pragma unroll
        for (int r = 0; r < 16; ++r) { s0[r] = ex2(s0[r] - mn); s1[r] = ex2(s1[r] - mn); ls += s0[r] + s1[r]; }
        l = l * alpha + ls;
#pragma unroll
        for (int dt = 0; dt < 4; ++dt)
#pragma unroll
            for (int r = 0; r < 16; ++r) O[dt][r] *= alpha;
#pragma unroll
        for (int kt2 = 0; kt2 < 2; ++kt2) {
            bf16x8 pb[2];
#pragma unroll
            for (int sp = 0; sp < 2; ++sp) {
                v4u pw;
                if (kt2 == 0) { pw.x = pk2s(s0[8 * sp + 0], s0[8 * sp + 1]); pw.y = pk2s(s0[8 * sp + 2], s0[8 * sp + 3]); pw.z = pk2s(s0[8 * sp + 4], s0[8 * sp + 5]); pw.w = pk2s(s0[8 * sp + 6], s0[8 * sp + 7]); }
                else          { pw.x = pk2s(s1[8 * sp + 0], s1[8 * sp + 1]); pw.y = pk2s(s1[8 * sp + 2], s1[8 * sp + 3]); pw.z = pk2s(s1[8 * sp + 4], s1[8 * sp + 5]); pw.w = pk2s(s1[8 * sp + 6], s1[8 * sp + 7]); }
                pb[sp] = __builtin_bit_cast(bf16x8, pw);
            }
            const LAS unsigned char* vp = lds + VS_OFF + l31 * VROW + (64 * c + 32 * kt2 + 4 * hi) * 2;
            v2u va[2][4][2];
#pragma unroll
            for (int sp = 0; sp < 2; ++sp)
#pragma unroll
                for (int dt = 0; dt < 4; ++dt) { va[sp][dt][0] = *(const LAS v2u*)(vp + sp * 32 + dt * 32 * VROW); va[sp][dt][1] = *(const LAS v2u*)(vp + sp * 32 + dt * 32 * VROW + 16); }
#pragma unroll
            for (int sp = 0; sp < 2; ++sp)
#pragma unroll
                for (int dt = 0; dt < 4; ++dt) {
                    v4u aw; aw.x = va[sp][dt][0].x; aw.y = va[sp][dt][0].y; aw.z = va[sp][dt][1].x; aw.w = va[sp][dt][1].y;
                    O[dt] = __builtin_amdgcn_mfma_f32_32x32x16_bf16(__builtin_bit_cast(bf16x8, aw), pb[sp], O[dt], 0, 0, 0);
                }
        }
    }
    l += __shfl_xor(l, 32);
}

#define XB_TMO      128
#define XB_XCNT(j)  (256  + 64 * (j))
#define XB_XSUB(j)  (1280 + 64 * (j))
#define XB_XGEN(j)  (2304 + 64 * (j))
#define XB_TOP      3328
#define XB_TOPGEN   3392
#define XCD_BAR_WORDS 3456
#define XB_SPIN_CAP (1u << 18)

__device__ __forceinline__ unsigned xb_ld(unsigned* p)              { return __hip_atomic_load(p, __ATOMIC_RELAXED, __HIP_MEMORY_SCOPE_AGENT); }
__device__ __forceinline__ unsigned xb_add(unsigned* p, unsigned v) { return __hip_atomic_fetch_add(p, v, __ATOMIC_RELAXED, __HIP_MEMORY_SCOPE_AGENT); }
__device__ __forceinline__ unsigned xb_xcc_id() { return (unsigned)__builtin_amdgcn_s_getreg((3 << 11) | 20) & 0xFu; }
#define XB_SPIN(cond, bar) do { unsigned _sp = 0; while (cond) { __builtin_amdgcn_s_sleep(1); \
    if ((++_sp & 255u) == 0u) { if (xb_ld(&(bar)[XB_TMO])) break; if (_sp > XB_SPIN_CAP) { atomicAdd(&(bar)[XB_TMO], 1u); break; } } } } while (0)

struct XcdBarrier {
    unsigned* bar; unsigned x;
    volatile LAS unsigned* st;
};

__device__ __forceinline__ XcdBarrier xcd_barrier_post(unsigned* bar, volatile LAS unsigned* st, int tid) {
    XcdBarrier b; b.bar = bar; b.x = xb_xcc_id(); b.st = st;
    if (tid == 0) (void)xb_add(&bar[XB_XCNT(b.x)], 1u);
    return b;
}
__device__ __forceinline__ void xcd_barrier_complete(unsigned* bar, unsigned x, unsigned& nloc, unsigned& nx) {
    const unsigned G = gridDim.x * gridDim.y * gridDim.z;
    unsigned sum, cnt, mine, sp = 0u;
    for (;;) {
        sum = 0u; cnt = 0u; mine = 0u;
#pragma unroll
        for (unsigned j = 0; j < 16; ++j) { const unsigned c = xb_ld(&bar[XB_XCNT(j)]); sum += c; cnt += (c > 0u) ? 1u : 0u; mine = (j == x) ? c : mine; }
        if (sum == G) break;
        __builtin_amdgcn_s_sleep(1);
        if ((++sp & 255u) == 0u) { if (xb_ld(&bar[XB_TMO])) break; if (sp > XB_SPIN_CAP) { atomicAdd(&bar[XB_TMO], 1u); break; } }
    }
    nloc = mine > 0u ? mine : 1u; nx = cnt > 0u ? cnt : 1u;
}

__device__ __forceinline__ void xcd_barrier(const XcdBarrier& b, int tid) {
    asm volatile("s_waitcnt vmcnt(0)" ::: "memory");
    __syncthreads();
    if (tid == 0) {
        unsigned* bar = b.bar;
        __builtin_amdgcn_s_waitcnt(0);
        unsigned nloc = b.st[0], nx = b.st[1];
        if (nloc == 0u) { xcd_barrier_complete(bar, b.x, nloc, nx); b.st[0] = nloc; b.st[1] = nx; }
        const unsigned old = xb_add(&bar[XB_XSUB(b.x)], 1u);
        const unsigned gen = old / nloc;
        if (old + 1u == (gen + 1u) * nloc) {
            __builtin_amdgcn_fence(__ATOMIC_RELEASE, "agent");
            asm volatile("s_waitcnt vmcnt(0)" ::: "memory");
            const unsigned og = xb_add(&bar[XB_TOP], 1u);
            const unsigned tg = og / nx;
            if (og + 1u == (tg + 1u) * nx) xb_add(&bar[XB_TOPGEN], 1u);
            else XB_SPIN(xb_ld(&bar[XB_TOPGEN]) == tg, bar);
            __builtin_amdgcn_fence(__ATOMIC_ACQUIRE, "agent");
            xb_add(&bar[XB_XGEN(b.x)], 1u);
            asm volatile("s_waitcnt vmcnt(0)" ::: "memory");
        } else {
            XB_SPIN(xb_ld(&bar[XB_XGEN(b.x)]) == gen, bar);
            __builtin_amdgcn_fence(__ATOMIC_ACQUIRE, "agent");
            asm volatile("s_waitcnt vmcnt(0)" ::: "memory");
        }
    }
    __syncthreads();
}

struct Args { const float* in[20]; float* out; unsigned char* ws; int ph_lo, ph_hi; };

__global__ void __launch_bounds__(512, 2) fwd(Args a) {
    extern __shared__ __attribute__((aligned(16))) unsigned char lds_raw[];
    LAS unsigned char* lds = (LAS unsigned char*)lds_raw;
    const int wave = __builtin_amdgcn_readfirstlane((int)threadIdx.x >> 6);
    const int G = gridDim.x, blk = blockIdx.x;
    const int lo = a.ph_lo, hiP = a.ph_hi;
    LAS unsigned long long* ptab = (LAS unsigned long long*)(lds + PT_OFF);
    if (threadIdx.x == 0) {
#pragma unroll
        for (int i = 0; i < 20; ++i) ptab[i] = (unsigned long long)a.in[i];
        ptab[20] = (unsigned long long)a.out; ptab[21] = (unsigned long long)a.ws;
        ((LAS unsigned*)(lds + ST_OFF))[0] = 0u; ((LAS unsigned*)(lds + ST_OFF))[1] = 0u;
    }
    __syncthreads();
    if (a.ph_hi - a.ph_lo > 1) {
        cg::this_grid().sync();
        const int lane_ = (int)__builtin_amdgcn_mbcnt_hi(~0u, __builtin_amdgcn_mbcnt_lo(~0u, 0u));
        (void)xcd_barrier_post((unsigned*)(a.ws + WS_CTL) + CW_BAR, (volatile LAS unsigned*)(lds + ST_OFF), wave * 64 + lane_);
    }
#define LDP(i) ((unsigned char*)(__attribute__((address_space(1))) unsigned char*)(((unsigned long long)(unsigned)__builtin_amdgcn_readfirstlane((int)(unsigned)(ptab[i] >> 32)) << 32) | (unsigned long long)(unsigned)__builtin_amdgcn_readfirstlane((int)(unsigned)ptab[i])))
#define DECL_PTRS \
    const int lane = (int)__builtin_amdgcn_mbcnt_hi(~0u, __builtin_amdgcn_mbcnt_lo(~0u, 0u)), tid = wave * 64 + lane, l31 = lane & 31, hi = lane >> 5; (void)tid; (void)l31; (void)hi; \
    const float* const x = (const float*)LDP(0); (void)x; \
    const float* const mem = (const float*)LDP(1); (void)mem; \
    const float* const g_mix = (const float*)LDP(2); (void)g_mix; \
    const float* const w_in = (const float*)LDP(3); (void)w_in; \
    const float* const conv_w = (const float*)LDP(4); (void)conv_w; \
    const float* const conv_b = (const float*)LDP(5); (void)conv_b; \
    const float* const ln_g = (const float*)LDP(6); (void)ln_g; \
    const float* const ln_b = (const float*)LDP(7); (void)ln_b; \
    const float* const w_out = (const float*)LDP(8); (void)w_out; \
    const float* const rel_bias = (const float*)LDP(9); (void)rel_bias; \
    const float* const g_cross = (const float*)LDP(10); (void)g_cross; \
    const float* const g_mem = (const float*)LDP(11); (void)g_mem; \
    const float* const wq_c = (const float*)LDP(12); (void)wq_c; \
    const float* const wk_c = (const float*)LDP(13); (void)wk_c; \
    const float* const wv_c = (const float*)LDP(14); (void)wv_c; \
    const float* const wo_c = (const float*)LDP(15); (void)wo_c; \
    const float* const g_mlp = (const float*)LDP(16); (void)g_mlp; \
    const float* const w1 = (const float*)LDP(17); (void)w1; \
    const float* const w2 = (const float*)LDP(18); (void)w2; \
    const float* const g_final = (const float*)LDP(19); (void)g_final; \
    float* const out = (float*)LDP(20); (void)out; unsigned char* const ws = LDP(21); (void)ws; \
    unsigned* const CNT = (unsigned*)(ws + WS_CTL); (void)CNT; float* const SSQ1 = (float*)(ws + WS_CTL + 262144); (void)SSQ1; float* const SSQ2 = (float*)(ws + WS_CTL + 524288); (void)SSQ2; float* const SSQ3 = (float*)(ws + WS_CTL + 786432); (void)SSQ3; \
    bf16* const WIN_T = (bf16*)(ws + WS_WIN); (void)WIN_T; \
    bf16* const WOUT_T = (bf16*)(ws + WS_WOUT); (void)WOUT_T; \
    bf16* const WQ_T = (bf16*)(ws + WS_WQ); (void)WQ_T; \
    bf16* const WKV_T = (bf16*)(ws + WS_WKV); (void)WKV_T; \
    bf16* const WO_T = (bf16*)(ws + WS_WO); (void)WO_T; \
    bf16* const W1_T = (bf16*)(ws + WS_W1); (void)W1_T; \
    bf16* const W2_T = (bf16*)(ws + WS_W2); (void)W2_T; \
    float* const KBAR = (float*)(ws + WS_KBAR); (void)KBAR; \
    float* const TB = (float*)(ws + WS_TB); (void)TB; \
    bf16* const MN = (bf16*)(ws + WS_MN); (void)MN; \
    bf16* const KC = (bf16*)(ws + WS_KC); (void)KC; \
    bf16* const VCT = (bf16*)(ws + WS_VCT); (void)VCT; \
    bf16* const NBUF = (bf16*)(ws + WS_NB); (void)NBUF; \
    bf16* const Q = (bf16*)(ws + WS_Q); (void)Q; \
    bf16* const K = (bf16*)(ws + WS_K); (void)K; \
    bf16* const VT = (bf16*)(ws + WS_VT); (void)VT; \
    bf16* const UV = (bf16*)(ws + WS_UV); (void)UV; \
    bf16* const UG = (bf16*)(ws + WS_UG); (void)UG; \
    bf16* const AC = (bf16*)(ws + WS_AC); (void)AC; \
    bf16* const FB = (bf16*)(ws + WS_F); (void)FB; \
    bf16* const QC = (bf16*)(ws + WS_QC); (void)QC; \
    bf16* const OC = (bf16*)(ws + WS_OC); (void)OC; \
    bf16* const PO = (bf16*)(ws + WS_PO); (void)PO; \
    float* const PML = (float*)(ws + WS_PML); (void)PML; \
    unsigned* const LIST = (unsigned*)(ws + WS_LIST); (void)LIST; \
    do {} while (0)
    const float SC = 0.08838834764831845f * LOG2E;
#ifndef DBG
#define DBG 0
#endif
#ifndef REP_MASK
#define REP_MASK 0
#endif
#ifndef PH_MASK
#define PH_MASK 0x7fff
#endif
#define IN(k) (((PH_MASK >> (k)) & 1) && lo <= (k) && (k) < hiP)
#define SEAM2(k, kn) do { if (IN(k) && IN(kn)) { const int lane_ = (int)__builtin_amdgcn_mbcnt_hi(~0u, __builtin_amdgcn_mbcnt_lo(~0u, 0u)); \
        XcdBarrier b_; b_.bar = (unsigned*)(LDP(21) + WS_CTL) + CW_BAR; b_.x = xb_xcc_id(); b_.st = (volatile LAS unsigned*)(lds + ST_OFF); xcd_barrier(b_, wave * 64 + lane_); } } while (0)
#define SEAM(k) SEAM2(k, (k) + 1)
#define GRID_BAR() do { const int lane_ = (int)__builtin_amdgcn_mbcnt_hi(~0u, __builtin_amdgcn_mbcnt_lo(~0u, 0u)); \
        XcdBarrier b_; b_.bar = (unsigned*)(LDP(21) + WS_CTL) + CW_BAR; b_.x = xb_xcc_id(); b_.st = (volatile LAS unsigned*)(lds + ST_OFF); xcd_barrier(b_, wave * 64 + lane_); } while (0)

    for (int rep_ = 0; rep_ < (IN(0) ? 1 + ((REP_MASK >> 0) & 1) : 0); ++rep_) { DECL_PTRS;
        LAS float* scr = (LAS float*)(lds + wave * 16384);
        const int gw = blk * 8 + wave, NGW = G * 8;
        constexpr int I_IN = (DM / 64) * (INW / 32), I_OUT = (DM / 64) * (DM / 32), I_X = (DM / 64) * (XW / 32), I_O = (XW / 64) * (DM / 32), I_1 = (DM / 64) * (FF / 32), I_2 = (FF / 64) * (DM / 32);
        constexpr int NITEMS = I_IN + I_OUT + 3 * I_X + I_O + I_1 + I_2;
        const bool early = (G > 16) && (hiP - lo > 1);
        for (int it = gw; it < 2 * I_X; it += NGW) { if (it < I_X) p0_transpose_item(wk_c, DM, XW, WKV_T, 0, scr, it, lane); else p0_transpose_item(wv_c, DM, XW, WKV_T, XW, scr, it - I_X, lane); }
        for (int mrow = gw; mrow < NB * NMEM; mrow += NGW) rms_row_bf16(mem + (size_t)mrow * DM, g_mem, MN + (size_t)mrow * DM, lane);
        for (int i = blk * 512 + tid; i < NH * 2048; i += G * 512) {
            const int hh = i >> 11, d = i & 2047; int bucket = d;
            if (d >= 16) { const int lg = 16 + (int)(logf((float)d / 16.0f) / 4.852030263919617f * 16.0f); bucket = lg < 31 ? lg : 31; }
            TB[i] = rel_bias[bucket * NH + hh] * LOG2E;
        }
        if (early) { GRID_BAR(); }
        if (early && blk < 8) {
            pg8::Gemm g{MN, WKV_T, NB * NMEM, 2 * XW, DM}; pg8::StaticOrder So; So.init(NB * NMEM, 2 * XW, 8, blk);
            pg8::EpiBf16X<0> E{KC, XW, XW, (size_t)NB * NMEM * XW, 1, VCT, NMEM, XH, nullptr};
            pg8::gemm_phase<pg8::EpiBf16X<0>, pg8::StaticOrder, true, true>(lds, g, So, E, tid);
        } else {
        const int nb0 = early ? 8 : 0, gwb = (blk - nb0) * 8 + wave, NGWB = (G - nb0) * 8;
        constexpr int NREST = I_IN + I_OUT + I_X + I_O + I_1 + I_2;
        for (int it = gwb; it < NREST; it += NGWB) {
            int r = it;
            if (r < I_IN) { p0_transpose_item(w_in, DM, INW, WIN_T, 0, scr, r, lane); continue; } r -= I_IN;
            if (r < I_OUT) { p0_transpose_item(w_out, DM, DM, WOUT_T, 0, scr, r, lane); continue; } r -= I_OUT;
            if (r < I_X) { p0_transpose_item(wq_c, DM, XW, WQ_T, 0, scr, r, lane, g_cross); continue; } r -= I_X;
            if (r < I_O) { p0_transpose_item(wo_c, XW, DM, WO_T, 0, scr, r, lane); continue; } r -= I_O;
            if (r < I_1) { p0_transpose_item(w1, DM, FF, W1_T, 0, scr, r, lane, g_mlp); continue; } r -= I_1;
            p0_transpose_item(w2, FF, DM, W2_T, 0, scr, r, lane);
        }
        for (int mrow = gwb; mrow < T; mrow += 2 * NGWB) {
            const int r2 = mrow + NGWB;
            const f32x4* xa = (const f32x4*)(x + (size_t)mrow * DM) + lane; const f32x4* xb = (const f32x4*)(x + (size_t)(r2 < T ? r2 : mrow) * DM) + lane;
            f32x4 va[8], vb[8]; float sa = 0.f, sb = 0.f;
#pragma unroll
            for (int jj = 0; jj < 8; ++jj) { va[jj] = xa[64 * jj]; vb[jj] = xb[64 * jj]; }
#pragma unroll
            for (int jj = 0; jj < 8; ++jj) { sa += (va[jj].x * va[jj].x + va[jj].y * va[jj].y) + (va[jj].z * va[jj].z + va[jj].w * va[jj].w); sb += (vb[jj].x * vb[jj].x + vb[jj].y * vb[jj].y) + (vb[jj].z * vb[jj].z + vb[jj].w * vb[jj].w); }
            const float ra = 1.0f / sqrtf(wave_sum(sa) * (1.0f / DM) + EPS), rb = 1.0f / sqrtf(wave_sum(sb) * (1.0f / DM) + EPS);
            const f32x4* gr = (const f32x4*)g_mix + lane; v2u* oa = (v2u*)(NBUF + (size_t)mrow * DM) + lane; v2u* ob = (v2u*)(NBUF + (size_t)(r2 < T ? r2 : mrow) * DM) + lane;
#pragma unroll
            for (int jj = 0; jj < 8; ++jj) { const f32x4 gv = gr[64 * jj]; v2u w; w.x = pk2(va[jj].x * ra * gv.x, va[jj].y * ra * gv.y); w.y = pk2(va[jj].z * ra * gv.z, va[jj].w * ra * gv.w); oa[64 * jj] = w;
                if (r2 < T) { v2u w2; w2.x = pk2(vb[jj].x * rb * gv.x, vb[jj].y * rb * gv.y); w2.y = pk2(vb[jj].z * rb * gv.z, vb[jj].w * rb * gv.w); ob[64 * jj] = w2; } }
        }
        }
        __syncthreads();
    }
    SEAM(0);

    for (int rep_ = 0; rep_ < (IN(1) ? 1 + ((REP_MASK >> 1) & 1) : 0); ++rep_) { DECL_PTRS;
        { pg8::Gemm g{NBUF, WIN_T, T, INW, DM}; pg8::StaticOrder So; So.init(T, INW, G, blk);
          pg8::EpiBf16X<0> E{Q, AW, AW, (size_t)T * AW, 2, VT, S, NH, nullptr};
          pg8::gemm_phase<pg8::EpiBf16X<0>, pg8::StaticOrder, true, true>(lds, g, So, E, tid); }
        if (!((G > 16) && (hiP - lo > 1)))
        { pg8::Gemm g{MN, WKV_T, NB * NMEM, 2 * XW, DM}; pg8::StaticOrder So; So.init(NB * NMEM, 2 * XW, G, blk);
          pg8::EpiBf16X<0> E{KC, XW, XW, (size_t)NB * NMEM * XW, 1, VCT, NMEM, XH, nullptr};
          pg8::gemm_phase<pg8::EpiBf16X<0>, pg8::StaticOrder, true, true>(lds, g, So, E, tid); }
    }
    SEAM(1);

#if DBG == 9
    { DECL_PTRS; for (size_t i = (size_t)blk * 512 + tid; i < (size_t)T * DM; i += (size_t)G * 512) { out[i] = i < 262144 ? __uint_as_float(((unsigned)KC[i] << 16)) : (i < 524288 ? __uint_as_float(((unsigned)VCT[i - 262144] << 16)) : 0.f); } return; }
#endif
#if DBG == 1
    { DECL_PTRS; for (size_t i = (size_t)blk * 512 + tid; i < (size_t)T * DM; i += (size_t)G * 512) { const size_t t = i >> 11, c = i & 2047, e = t * 1024 + (c & 1023);
        const unsigned short v = c < 1024 ? (unsigned short)(Q[e] ^ UV[e]) : (unsigned short)(K[e] ^ UG[e] ^ VT[e]); out[i] = __uint_as_float(((unsigned)v << 16)) ; } return; }
#endif
    for (int rep_ = 0; rep_ < (IN(2) ? 1 + ((REP_MASK >> 2) & 1) : 0); ++rep_) { DECL_PTRS;
        for (int it = blk; it < 256; it += G) {
            const int b = it >> 7, j = (it >> 1) & 63, chh = it & 1, cp = tid & 255, rh = tid >> 8;
            const bf16* kp = K + (size_t)(b * S + j * 256 + rh * 128) * AW + chh * 512 + 2 * cp;
            float s0 = 0.f, s1 = 0.f;
#pragma unroll 8
            for (int r = 0; r < 128; ++r) { const unsigned w = *(const unsigned*)(kp + (size_t)r * AW); s0 += bf_lo(w); s1 += bf_hi(w); }
            LAS f32x2* red = (LAS f32x2*)lds;
            if (rh == 1) red[cp] = (f32x2){s0, s1};
            __syncthreads();
            if (rh == 0) { const f32x2 o = red[cp]; const int col = chh * 512 + 2 * cp, hh = col >> 7, d = col & 127;
                *(f32x2*)(KBAR + ((size_t)((b * NH + hh) * NBLK + j)) * HD + d) = (f32x2){(s0 + o.x) * (1.0f / 256.0f), (s1 + o.y) * (1.0f / 256.0f)}; }
            __syncthreads();
        }
        for (int seg = blk; seg < T / 128; seg += G) {
            const int t0 = seg * 128, c0 = 2 * tid;
            float w0[CONVK], w1r[CONVK];
#pragma unroll
            for (int k = 0; k < CONVK; ++k) { const f32x2 wv = *(const f32x2*)(conv_w + k * CC + c0); w0[k] = wv.x; w1r[k] = wv.y; }
            const f32x2 cb = *(const f32x2*)(conv_b + c0), lg = *(const f32x2*)(ln_g + c0), lb = *(const f32x2*)(ln_b + c0);
            float r0[32], r1[32];
#pragma unroll
            for (int i = 0; i < 32; ++i) { r0[i] = 0.f; r1[i] = 0.f; }
            LAS f32x2* red = (LAS f32x2*)(lds + RED_OFF);
#pragma unroll 1
            for (int ch = -1; ch < 4; ++ch) {
                const int tb0 = t0 + ch * 32;
                const bool zero = (ch < 0) && ((t0 & (S - 1)) == 0);
#pragma unroll
                for (int hf = 0; hf < 2; ++hf) {
                    float y0[16], y1[16];
#pragma unroll
                    for (int ii = 0; ii < 16; ++ii) {
                        const int i = hf * 16 + ii;
                        float h0 = 0.f, h1 = 0.f;
                        if (!zero) { const size_t off = (size_t)(tb0 + i) * CC + c0; const unsigned vv = *(const unsigned*)(UV + off), gg = *(const unsigned*)(UG + off);
                            h0 = bf_lo(vv) * sigmoidf_(bf_lo(gg)); h1 = bf_hi(vv) * sigmoidf_(bf_hi(gg)); }
                        r0[i] = h0; r1[i] = h1;
                        float a0 = cb.x, a1 = cb.y;
                        if (ch >= 0) {
#pragma unroll
                            for (int k = 0; k < CONVK; ++k) { a0 += r0[(i - 30 + k) & 31] * w0[k]; a1 += r1[(i - 30 + k) & 31] * w1r[k]; }
                        }
                        y0[ii] = a0; y1[ii] = a1;
                    }
                    if (ch >= 0) {
#pragma unroll
                        for (int ii = 0; ii < 16; ++ii) { const float s1 = wave_sum(y0[ii] + y1[ii]), s2 = wave_sum(y0[ii] * y0[ii] + y1[ii] * y1[ii]); if (lane == 0) red[ii * 8 + wave] = (f32x2){s1, s2}; }
                        __syncthreads();
#pragma unroll
                        for (int ii = 0; ii < 16; ++ii) {
                            float s1 = 0.f, s2 = 0.f;
#pragma unroll
                            for (int w = 0; w < 8; ++w) { const f32x2 p = red[ii * 8 + w]; s1 += p.x; s2 += p.y; }
                            const float mean = s1 * (1.0f / CC), var = fmaxf(s2 * (1.0f / CC) - mean * mean, 0.f), rstd = 1.0f / sqrtf(var + EPS);
                            float o0 = (y0[ii] - mean) * rstd * lg.x + lb.x, o1 = (y1[ii] - mean) * rstd * lg.y + lb.y;
                            o0 = o0 * sigmoidf_(o0); o1 = o1 * sigmoidf_(o1);
                            *(unsigned*)(AC + (size_t)(tb0 + hf * 16 + ii) * DM + AW + c0) = pk2(o0, o1);
                        }
                        __syncthreads();
                    }
                }
            }
        }
    }
    SEAM(2);

    for (int rep_ = 0; rep_ < (IN(3) ? 1 : 0); ++rep_) { DECL_PTRS;
        constexpr int KH_OFF = 0, KL_OFF = 64 * KROW;
        for (int it = blk; it < NB * NH * NBLK; it += G) {
            const int bh = it >> 6, own = it & 63, b = bh >> 3, hh = bh & 7;
            if (own == 0) continue;
            f32x2 kvv[8];
#pragma unroll
            for (int i = 0; i < 8; ++i) { const int p2 = tid + 512 * i; kvv[i] = *(const f32x2*)(KBAR + (size_t)bh * NBLK * HD + 2 * p2); }
#pragma unroll
            for (int i = 0; i < 8; ++i) { const int p2 = tid + 512 * i, jr = p2 >> 6, d = (p2 & 63) * 2; const f32x2 kv = kvv[i];
                const unsigned hw = pk2s(kv.x, kv.y); const unsigned lw = pk2s(kv.x - bf_lo(hw), kv.y - bf_hi(hw));
                *(LAS unsigned*)(lds + KH_OFF + jr * KROW + d * 2) = hw; *(LAS unsigned*)(lds + KL_OFF + jr * KROW + d * 2) = lw; }
            const int ql = own * 256 + wave * 32 + l31;
            bf16x8 qf[8]; load_q(qf, Q + (size_t)(b * S + ql) * AW + hh * HD, hi);
            __syncthreads();
            f32x16 g0, g1;
#pragma unroll
            for (int r = 0; r < 16; ++r) { g0[r] = 0.f; g1[r] = 0.f; }
            const LAS unsigned char* kp = lds + l31 * KROW + 16 * hi;
#pragma unroll
            for (int ks = 0; ks < 8; ++ks) {
                g0 = __builtin_amdgcn_mfma_f32_32x32x16_bf16(*(const LAS bf16x8*)(kp + KH_OFF + 32 * ks), qf[ks], g0, 0, 0, 0);
                g0 = __builtin_amdgcn_mfma_f32_32x32x16_bf16(*(const LAS bf16x8*)(kp + KL_OFF + 32 * ks), qf[ks], g0, 0, 0, 0);
            }
            if (own > 32) {
#pragma unroll
                for (int ks = 0; ks < 8; ++ks) {
                    g1 = __builtin_amdgcn_mfma_f32_32x32x16_bf16(*(const LAS bf16x8*)(kp + KH_OFF + 32 * KROW + 32 * ks), qf[ks], g1, 0, 0, 0);
                    g1 = __builtin_amdgcn_mfma_f32_32x32x16_bf16(*(const LAS bf16x8*)(kp + KL_OFF + 32 * KROW + 32 * ks), qf[ks], g1, 0, 0, 0);
                }
            }
            float v0 = -INFINITY, v1 = -INFINITY, v2 = -INFINITY; int i0 = 64, i1 = 64, i2 = 64;
#define TOP3_INS(val, idx) do { const float dv_ = (val); const int di_ = (idx); if (di_ < own && dv_ > v2) { if (dv_ > v1) { v2 = v1; i2 = i1; if (dv_ > v0) { v1 = v0; i1 = i0; v0 = dv_; i0 = di_; } else { v1 = dv_; i1 = di_; } } else { v2 = dv_; i2 = di_; } } } while (0)
#pragma unroll
            for (int r = 0; r < 16; ++r) TOP3_INS(g0[r], crow(r, hi));
            if (own > 32) {
#pragma unroll
                for (int r = 0; r < 16; ++r) TOP3_INS(g1[r], 32 + crow(r, hi));
            }
            const float pv0 = __shfl_xor(v0, 32), pv1 = __shfl_xor(v1, 32), pv2 = __shfl_xor(v2, 32); const int pi0 = __shfl_xor(i0, 32), pi1 = __shfl_xor(i1, 32), pi2 = __shfl_xor(i2, 32);
#define TOP3_MRG(val, idx) do { const float dv_ = (val); const int di_ = (idx); if (di_ < own) { \
                if (dv_ > v2 || (dv_ == v2 && di_ < i2)) { if (dv_ > v1 || (dv_ == v1 && di_ < i1)) { v2 = v1; i2 = i1; if (dv_ > v0 || (dv_ == v0 && di_ < i0)) { v1 = v0; i1 = i0; v0 = dv_; i0 = di_; } else { v1 = dv_; i1 = di_; } } else { v2 = dv_; i2 = di_; } } } } while (0)
            TOP3_MRG(pv0, pi0); TOP3_MRG(pv1, pi1); TOP3_MRG(pv2, pi2);
            const int nsel = own < 3 ? own : 3;
            LAS unsigned char* sel = lds + 2 * 64 * KROW;
            if (hi == 0) { const int qi = wave * 32 + l31; sel[qi] = (unsigned char)(nsel > 0 ? i0 : 255); sel[256 + qi] = (unsigned char)(nsel > 1 ? i1 : 255); sel[512 + qi] = (unsigned char)(nsel > 2 ? i2 : 255); }
            __syncthreads();
            for (int jl = wave; jl < own; jl += 8) {
                unsigned long long bm[12]; bool mt[12]; unsigned total = 0u;
#pragma unroll
                for (int sk = 0; sk < 12; ++sk) { mt[sk] = sel[(sk >> 2) * 256 + lane + 64 * (sk & 3)] == (unsigned char)jl; bm[sk] = __ballot(mt[sk]); total += (unsigned)__popcll(bm[sk]); }
                if (total == 0u) continue;
                unsigned basep = 0u; if (lane == 0) basep = atomicAdd(&CNT[bh * NBLK + jl], total);
                unsigned run = (unsigned)__builtin_amdgcn_readfirstlane((int)basep);
                const unsigned long long lt = (1ull << lane) - 1ull;
#pragma unroll
                for (int sk = 0; sk < 12; ++sk) {
                    if (mt[sk]) __hip_atomic_store(&LIST[(size_t)(bh * NBLK + jl) * S + run + (unsigned)__popcll(bm[sk] & lt)], (unsigned)((own * 256 + lane + 64 * (sk & 3)) | ((sk >> 2) << 14)), __ATOMIC_RELAXED, __HIP_MEMORY_SCOPE_AGENT);
                    run += (unsigned)__popcll(bm[sk]);
                }
            }
            __syncthreads();
        }
    }
    SEAM(3);

    for (int rep_ = 0; rep_ < (IN(4) ? 1 + ((REP_MASK >> 4) & 1) : 0); ++rep_) { DECL_PTRS;
        LAS unsigned* pf = (LAS unsigned*)(lds + CNT_OFF);
        LAS unsigned* wtot = (LAS unsigned*)(lds + RED_OFF);
        {
            const unsigned c0 = __hip_atomic_load(&CNT[2 * tid], __ATOMIC_RELAXED, __HIP_MEMORY_SCOPE_AGENT), c1 = __hip_atomic_load(&CNT[2 * tid + 1], __ATOMIC_RELAXED, __HIP_MEMORY_SCOPE_AGENT);
            const unsigned ua = (c0 + 31u) >> 5, ub = (c1 + 31u) >> 5, us = ua + ub;
            unsigned v = us;
#pragma unroll
            for (int o = 1; o < 64; o <<= 1) { const unsigned u = __shfl_up(v, o); if (lane >= o) v += u; }
            if (lane == 63) wtot[wave] = v;
            __syncthreads();
            unsigned off = 0u;
            for (int w = 0; w < wave; ++w) off += wtot[w];
            const unsigned excl = off + v - us;
            pf[2 * tid] = excl + ua; pf[2 * tid + 1] = excl + us;
            __syncthreads();
        }
        const unsigned total = pf[NB * NH * NBLK - 1];
        const unsigned glo = (unsigned)(((unsigned long long)total * (unsigned)blk) / (unsigned)G), ghi = (unsigned)(((unsigned long long)total * (unsigned)(blk + 1)) / (unsigned)G);
        int lo_ = 0, hi_ = NB * NH * NBLK - 1;
        while (lo_ < hi_) { const int mid = (lo_ + hi_) >> 1; if (pf[mid] > glo) hi_ = mid; else lo_ = mid + 1; }
        int bhj = __builtin_amdgcn_readfirstlane(lo_); unsigned g = glo;
        while (g < ghi) {
            const unsigned base = (unsigned)__builtin_amdgcn_readfirstlane((int)(bhj ? pf[bhj - 1] : 0u)), lend = (unsigned)__builtin_amdgcn_readfirstlane((int)pf[bhj]);
            const unsigned end = lend < ghi ? lend : ghi;
            const int cnt = __builtin_amdgcn_readfirstlane((int)__hip_atomic_load(&CNT[bhj], __ATOMIC_RELAXED, __HIP_MEMORY_SCOPE_AGENT));
            const int bh = bhj >> 6, j = bhj & 63, b = bh >> 3, hh = bh & 7;
            attn_stage(lds, K + (size_t)(b * S + j * 256) * AW + hh * HD, AW, VT + (size_t)(bh * HD) * S + j * 256, S, TB + hh * 2048, tid);
            __syncthreads();
            const float cbias = ((const LAS float*)(lds + TB_OFF))[2047];
            unsigned gg = g + (unsigned)wave;
            unsigned e1 = (unsigned)(S - 1), e2 = (unsigned)(S - 1); bool v1 = false, v2 = false;
            bf16x8 qn[8];
            if (gg < end) { const int ix = (int)(gg - base) * 32 + l31; v1 = ix < cnt; if (v1) e1 = __hip_atomic_load(&LIST[(size_t)bhj * S + ix], __ATOMIC_RELAXED, __HIP_MEMORY_SCOPE_AGENT); }
            if (gg + 8u < end) { const int ix = (int)(gg + 8u - base) * 32 + l31; v2 = ix < cnt; if (v2) e2 = __hip_atomic_load(&LIST[(size_t)bhj * S + ix], __ATOMIC_RELAXED, __HIP_MEMORY_SCOPE_AGENT); }
            if (gg < end) load_q(qn, Q + (size_t)(b * S + (int)(e1 & 0x3fff)) * AW + hh * HD, hi);
            for (; gg < end; gg += 8u) {
                const unsigned e = e1; const bool valid = v1;
                bf16x8 qf[8];
#pragma unroll
                for (int ks = 0; ks < 8; ++ks) qf[ks] = qn[ks];
                e1 = e2; v1 = v2; e2 = (unsigned)(S - 1); v2 = false;
                if (gg + 16u < end) { const int ix = (int)(gg + 16u - base) * 32 + l31; v2 = ix < cnt; if (v2) e2 = __hip_atomic_load(&LIST[(size_t)bhj * S + ix], __ATOMIC_RELAXED, __HIP_MEMORY_SCOPE_AGENT); }
                if (gg + 8u < end) load_q(qn, Q + (size_t)(b * S + (int)(e1 & 0x3fff)) * AW + hh * HD, hi);
                const int ql = e & 0x3fff, slot = e >> 14, qrow = b * S + ql, qrel = ql - j * 256;
                const bool fast = __all(qrel - 255 >= 1512);
                f32x16 O[4]; float m, l;
                attn_core<0>(lds, qf, qrel, SC, 4, fast, cbias, O, m, l, lane);
                store_o16(PO + ((size_t)slot * T + qrow) * AW + hh * HD, O, 1.0f / l, hi, valid);
                if (valid) {
                    if (hi == 0) __hip_atomic_store((unsigned long long*)PML + ((size_t)(qrow * NH + hh) * 3 + slot), ((unsigned long long)__float_as_uint(l) << 32) | (unsigned long long)__float_as_uint(m), __ATOMIC_RELAXED, __HIP_MEMORY_SCOPE_AGENT);
                }
            }
            __syncthreads();
            g = end; ++bhj;
            while (bhj < NB * NH * NBLK && (unsigned)__builtin_amdgcn_readfirstlane((int)pf[bhj]) == lend) ++bhj;
        }
    }
    SEAM(4);

    for (int rep_ = 0; rep_ < (IN(5) ? 1 + ((REP_MASK >> 5) & 1) : 0); ++rep_) { DECL_PTRS;
        for (int it = blk; it < NB * NH * NBLK; it += G) {
            const int bh = it >> 6, j = it & 63, b = bh >> 3, hh = bh & 7;
            attn_stage(lds, K + (size_t)(b * S + j * 256) * AW + hh * HD, AW, VT + (size_t)(bh * HD) * S + j * 256, S, TB + hh * 2048, tid);
            __syncthreads();
            const int qrel = wave * 32 + l31, qrow = b * S + j * 256 + qrel;
            f32x16 O[4]; float m, l;
            bf16x8 qf[8]; load_q(qf, Q + (size_t)qrow * AW + hh * HD, hi);
            unsigned long long pw[3];
#pragma unroll
            for (int s = 0; s < 3; ++s) { pw[s] = 0ull; if (s < (j < 3 ? j : 3)) pw[s] = __hip_atomic_load((unsigned long long*)PML + ((size_t)(qrow * NH + hh) * 3 + s), __ATOMIC_RELAXED, __HIP_MEMORY_SCOPE_AGENT); }
            attn_core<1>(lds, qf, qrel, SC, (wave >> 1) + 1, false, 0.f, O, m, l, lane);
            const int nsel = j < 3 ? j : 3;
            float M = m, ms[3], lsv[3];
#pragma unroll
            for (int s = 0; s < 3; ++s) { ms[s] = -1e30f; lsv[s] = 0.f; if (s < nsel) { ms[s] = __uint_as_float((unsigned)pw[s]); lsv[s] = __uint_as_float((unsigned)(pw[s] >> 32)); M = fmaxf(M, ms[s]); } }
            const float wown = ex2(m - M); float den = l * wown, wsl[3];
#pragma unroll
            for (int s = 0; s < 3; ++s) { wsl[s] = lsv[s] * ex2(ms[s] - M); den += wsl[s]; }
            const float inv = 1.0f / den;
            bf16* op = AC + (size_t)qrow * DM + hh * HD + 4 * hi;
#pragma unroll
            for (int hf = 0; hf < 2; ++hf) {
                v2u pp[3][2][4];
#pragma unroll
                for (int s = 0; s < 3; ++s) if (s < nsel) {
#pragma unroll
                    for (int d2 = 0; d2 < 2; ++d2)
#pragma unroll
                        for (int g4 = 0; g4 < 4; ++g4) pp[s][d2][g4] = *(const v2u*)(PO + ((size_t)s * T + qrow) * AW + hh * HD + 4 * hi + 32 * (2 * hf + d2) + 8 * g4);
                }
#pragma unroll
                for (int d2 = 0; d2 < 2; ++d2)
#pragma unroll
                    for (int g4 = 0; g4 < 4; ++g4) { const int dt = 2 * hf + d2;
                        float o0 = O[dt][4 * g4] * wown, o1 = O[dt][4 * g4 + 1] * wown, o2 = O[dt][4 * g4 + 2] * wown, o3 = O[dt][4 * g4 + 3] * wown;
#pragma unroll
                        for (int s = 0; s < 3; ++s) if (s < nsel) { const v2u p = pp[s][d2][g4];
                            o0 += wsl[s] * bf_lo(p.x); o1 += wsl[s] * bf_hi(p.x); o2 += wsl[s] * bf_lo(p.y); o3 += wsl[s] * bf_hi(p.y); }
                        v2u w; w.x = pk2(o0 * inv, o1 * inv); w.y = pk2(o2 * inv, o3 * inv); *(v2u*)(op + 32 * dt + 8 * g4) = w;
                    }
            }
            __syncthreads();
        }
    }
    SEAM(5);

#if DBG == 2
    { DECL_PTRS; for (size_t i = (size_t)blk * 512 + tid; i < (size_t)T * DM; i += (size_t)G * 512) out[i] = __uint_as_float(((unsigned)AC[i] << 16)); return; }
#endif
    for (int rep_ = 0; rep_ < (IN(6) ? 1 + ((REP_MASK >> 6) & 1) : 0); ++rep_) { DECL_PTRS;
        pg8::Gemm g{AC, WOUT_T, T, DM, DM}; pg8::StaticOrder So; So.init(T, DM, G, blk);
        pg8::EpiResBf16Ssq<0> E{x, NBUF, DM, SSQ1, nullptr};
        pg8::gemm_phase<pg8::EpiResBf16Ssq<0>, pg8::StaticOrder, true, true>(lds, g, So, E, tid);
    }
    SEAM2(6, 8);
#if DBG == 3
    return;
#endif
    for (int rep_ = 0; rep_ < (IN(8) ? 1 + ((REP_MASK >> 8) & 1) : 0); ++rep_) { DECL_PTRS;
        pg8::Gemm g{NBUF, WQ_T, T, XW, DM}; pg8::StaticOrder So; So.init(T, XW, G, blk);
        pg8::EpiBf16X<0, 1> E{QC, XW, 0, 0, -1, nullptr, 1, 1, SSQ1};
        pg8::gemm_phase<pg8::EpiBf16X<0, 1>, pg8::StaticOrder, true, true>(lds, g, So, E, tid);
    }
    for (int rep_ = 0; rep_ < (IN(9) ? 1 + ((REP_MASK >> 9) & 1) : 0); ++rep_) { DECL_PTRS;
        asm volatile("s_waitcnt vmcnt(0)" ::: "memory"); __syncthreads();
        pg8::StaticOrder So8; So8.init(T, XW, G, blk); pg8::Unit u8;
        for (int ui = 0; So8.next(ui >> 1, u8); ++ui) {
            const int tl = u8.pm, hc = 2 * u8.pn + (ui & 1), b = tl / (S / 256);
            attn_stage(lds, KC + (size_t)(b * NMEM) * XW + hc * HD, XW, VCT + (size_t)((b * XH + hc) * HD) * NMEM, NMEM, nullptr, tid);
            __syncthreads();
            const int qrow = tl * 256 + wave * 32 + l31;
            f32x16 O[4]; float m, l;
            bf16x8 qf[8]; load_q(qf, QC + (size_t)qrow * XW + hc * HD, hi);
            attn_core<2>(lds, qf, 0, SC, 4, false, 0.f, O, m, l, lane);
            store_o16(OC + (size_t)qrow * XW + hc * HD, O, 1.0f / l, hi, true);
            __syncthreads();
        }
    }
    SEAM(9);
#if DBG == 10
    return;
#endif
#if DBG == 7
    { DECL_PTRS; for (size_t i = (size_t)blk * 512 + tid; i < (size_t)T * DM; i += (size_t)G * 512) { const size_t t = i >> 11, c = i & 2047; out[i] = c < 512 ? __uint_as_float(((unsigned)QC[t * 512 + c] << 16)) : 0.f; } return; }
#endif
#if DBG == 8
    { DECL_PTRS; for (size_t i = (size_t)blk * 512 + tid; i < (size_t)T * DM; i += (size_t)G * 512) { const size_t t = i >> 11, c = i & 2047; out[i] = c < 512 ? __uint_as_float(((unsigned)OC[t * 512 + c] << 16)) : 0.f; } return; }
#endif
#if DBG == 5
    { DECL_PTRS; for (size_t i = (size_t)blk * 512 + tid; i < (size_t)T * DM; i += (size_t)G * 512) { const size_t t = i >> 11, c = i & 2047; out[i] = c < 512 ? __uint_as_float(((unsigned)OC[t * 512 + c] << 16)) : (c < 1024 ? __uint_as_float(((unsigned)QC[t * 512 + c - 512] << 16)) : 0.f); } return; }
#endif
    for (int rep_ = 0; rep_ < (IN(10) ? 1 + ((REP_MASK >> 10) & 1) : 0); ++rep_) { DECL_PTRS;
        pg8::Gemm g{OC, WO_T, T, DM, XW}; pg8::StaticOrder So; So.init(T, DM, G, blk);
        pg8::EpiResBf16Ssq<1> E{NBUF, NBUF, DM, SSQ2, nullptr};
        pg8::gemm_phase<pg8::EpiResBf16Ssq<1>, pg8::StaticOrder, true, true>(lds, g, So, E, tid);
    }
    SEAM2(10, 12);
#if DBG == 4
    return;
#endif
    for (int rep_ = 0; rep_ < (IN(12) ? 1 + ((REP_MASK >> 12) & 1) : 0); ++rep_) { DECL_PTRS;
        pg8::Gemm g{NBUF, W1_T, T, FF, DM}; pg8::StaticOrder So; So.init(T, FF, G, blk);
        pg8::EpiBf16X<2, 0> E{FB, FF, 0, 0, -1, nullptr, 1, 1, nullptr};
        pg8::gemm_phase<pg8::EpiBf16X<2, 0>, pg8::StaticOrder, true, true>(lds, g, So, E, tid);
    }
    SEAM(12);
    for (int rep_ = 0; rep_ < (IN(13) ? 1 + ((REP_MASK >> 13) & 1) : 0); ++rep_) { DECL_PTRS;
        pg8::Gemm g{FB, W2_T, T, DM, FF}; pg8::StaticOrder So; So.init(T, DM, G, blk);
        pg8::EpiResBf16Ssq<1, 1> E{NBUF, NBUF, DM, SSQ3, SSQ2};
        pg8::gemm_phase<pg8::EpiResBf16Ssq<1, 1>, pg8::StaticOrder, true, true>(lds, g, So, E, tid);
    }
    SEAM(13);
    for (int rep_ = 0; rep_ < (IN(14) ? 1 : 0); ++rep_) { DECL_PTRS;
        const int gw = blk * 8 + wave, NGW = G * 8;
        f32x4 gv[8];
#pragma unroll
        for (int jj = 0; jj < 8; ++jj) gv[jj] = ((const f32x4*)g_final)[lane + 64 * jj];
        for (int mrow = gw; mrow < T; mrow += NGW) {
            const float rstd = 1.0f / sqrtf(SSQ3[mrow] * (1.0f / DM) + EPS);
            const v2u* hr = (const v2u*)(NBUF + (size_t)mrow * DM) + lane; f32x4* o = (f32x4*)(out + (size_t)mrow * DM) + lane;
            v2u hv[8];
#pragma unroll
            for (int jj = 0; jj < 8; ++jj) hv[jj] = hr[64 * jj];
#pragma unroll
            for (int jj = 0; jj < 8; ++jj) o[64 * jj] = (f32x4){bf_lo(hv[jj].x) * rstd * gv[jj].x, bf_hi(hv[jj].x) * rstd * gv[jj].y, bf_lo(hv[jj].y) * rstd * gv[jj].z, bf_hi(hv[jj].y) * rstd * gv[jj].w};
        }
    }
#undef IN
#undef SEAM
}

extern "C" void kernel_launch(void* const* d_in, const int* in_sizes, int n_in, void* d_out, int out_size, void* d_ws, size_t ws_size, hipStream_t stream) {
    static int grid = 0;
    if (grid == 0) {
        if (n_in != 20 || out_size != T * DM || ws_size < WS_END) { fprintf(stderr, "kernel_launch: unexpected sizes n_in %d out %d ws %zu\n", n_in, out_size, ws_size); grid = -1; return; }
        int dev = 0, cus = 0, per_cu = 0;
        (void)hipGetDevice(&dev); (void)hipDeviceGetAttribute(&cus, hipDeviceAttributeMultiprocessorCount, dev);
        (void)hipFuncSetAttribute((const void*)fwd, hipFuncAttributeMaxDynamicSharedMemorySize, LDS_BYTES);
        (void)hipOccupancyMaxActiveBlocksPerMultiprocessor(&per_cu, (const void*)fwd, 512, LDS_BYTES);
        if (per_cu < 1) { fprintf(stderr, "kernel_launch: occupancy query says %d blocks per CU\n", per_cu); per_cu = 1; }
        grid = cus;
        (void)hipGetLastError();
    }
    if (grid < 0) return;
    if (hipMemsetAsync((char*)d_ws + WS_CTL, 0, 1048576, stream) != hipSuccess) { fprintf(stderr, "kernel_launch: memset failed\n"); return; }
    Args a{};
    for (int i = 0; i < 20; ++i) a.in[i] = (const float*)d_in[i];
    a.out = (float*)d_out; a.ws = (unsigned char*)d_ws;
#if MK_PER_PHASE
    for (int p = 0; p < NPHASE; ++p) { if (p == 7 || p == 11) continue; a.ph_lo = p; a.ph_hi = p + 1; hipLaunchKernelGGL(fwd, dim3(grid), dim3(512), LDS_BYTES, stream, a); }
#else
    a.ph_lo = 0; a.ph_hi = NPHASE;
    void* args[] = {&a};
    hipError_t e = hipLaunchCooperativeKernel((const void*)fwd, dim3(grid), dim3(512), args, LDS_BYTES, stream);
    if (e != hipSuccess) fprintf(stderr, "kernel_launch: cooperative launch failed: %s (grid %d)\n", hipGetErrorString(e), grid);
#endif
}
```

```cpp
#include <hip/hip_runtime.h>
#include <cstdio>
#include <cstdint>
namespace pg8 {
#define PG8_LAS __attribute__((address_space(3)))
typedef unsigned short bf16_t;
typedef short bf16x8 __attribute__((ext_vector_type(8)));
typedef float f32x4 __attribute__((ext_vector_type(4)));
typedef unsigned u32x4 __attribute__((ext_vector_type(4)));
constexpr int BM = 256, BK = 64, HALF = 128, HTB = HALF * BK * 2  , STAGE_BYTES = 8 * HTB, NXCD = 8, WGM = 8;

__host__ __device__ __forceinline__ int lds_byte(int r, int c) { const int st = (r >> 4) * 2 + (c >> 5), rr = r & 15, cc = c & 31, ob = rr * 64 + cc * 2; return st * 1024 + (ob ^ (((ob >> 9) & 1) << 5)); }
__host__ __device__ __forceinline__ void stage_rc(int b, int& R, int& C) { const int st = b / 1024, sb = b % 1024, swz = sb ^ (((sb >> 9) & 1) << 5); R = (st >> 1) * 16 + swz / 64; C = (st & 1) * 32 + (swz % 64) / 2; }
__host__ __device__ __forceinline__ int perm32(int rho) { const int n = rho >> 4, i = rho & 15; return 8 * (i >> 2) + 4 * n + (i & 3); }

struct Unit { int pm, pn; };
struct Gemm { const bf16_t* A; const bf16_t* Bt; int M, N, K; };

struct StaticOrder {
    int nM, nN, nwg, G, c;
    __host__ __device__ void init(int M, int N, int G_, int c_) { nM = M / BM; nN = N / BM; nwg = nM * nN; G = G_; c = c_; }
    __host__ __device__ bool next(int i, Unit& u) const {
        const long L = (long)i * G + c; if (L >= nwg) return false;
        int wgid = (int)L; { const int q = nwg / NXCD, r = nwg % NXCD, xcd = wgid % NXCD, off = wgid / NXCD; wgid = (xcd < r ? xcd * (q + 1) : r * (q + 1) + (xcd - r) * q) + off; }
        const int nig = WGM * nN, gid = wgid / nig, fm = gid * WGM, gsz = (nM - fm) < WGM ? (nM - fm) : WGM;
        u.pm = fm + ((wgid % nig) % gsz); u.pn = (wgid % nig) / gsz; return true;
    }
    __device__ __forceinline__ void a_ready(const Unit&) const {}
    __device__ __forceinline__ void done(const Unit&) const {}
};

__device__ __forceinline__ unsigned cvt_pk_bf16(float lo, float hi) { unsigned r; asm volatile("v_cvt_pk_bf16_f32 %0, %1, %2" : "=v"(r) : "v"(lo), "v"(hi)); return r; }
typedef float f32x2 __attribute__((ext_vector_type(2)));
__device__ __forceinline__ f32x2 gelu_pk(f32x2 v) {
    const f32x2 av = __builtin_elementwise_abs(v), d = av * 0.2316418882f + 1.0f;
    f32x2 t; t.x = __builtin_amdgcn_rcpf(d.x); t.y = __builtin_amdgcn_rcpf(d.y);
    f32x2 q = t * 0.5307027145f + (-0.7265760135f); q = q * t + 0.7107068705f; q = q * t + (-0.142248368f); q = q * t + 0.127414796f; q = q * t;
    const f32x2 s = (v * v) * (-0.72134752044f);
    f32x2 e; e.x = __builtin_amdgcn_exp2f(s.x); e.y = __builtin_amdgcn_exp2f(s.y);
    const f32x2 m = v * (q * e), r = v - m;
    f32x2 o; o.x = v.x < 0.f ? m.x : r.x; o.y = v.y < 0.f ? m.y : r.y; return o;
}


__device__ __forceinline__ unsigned short bf16_1(float v) { return (unsigned short)(cvt_pk_bf16(v, v) & 0xffffu); }
template <int ACT  , int RS = 0  > struct EpiBf16X {
    static constexpr bool PERM = true, AFTER_DRAIN = false;
    bf16_t* O; int ldc; int split_cols; size_t split_stride; int tr_tile; bf16_t* OT; int seqlen; int nheads; const float* ssq;
    __device__ __forceinline__ void operator()(const f32x4 (&acc)[2][2][4][2], const Unit& u, int wr, int wc, int fr, int fq) const {
        const int row0 = u.pm * BM + wr * 64 + fr; int colt = u.pn * BM; bf16_t* base = O; int t = 0;
        if (split_cols) { t = colt / split_cols; base += (size_t)t * split_stride; colt -= t * split_cols; }
        const int col0 = colt + wc * 32 + 8 * fq;
        if (RS == 0 && t == tr_tile) {
#pragma unroll
            for (int ai = 0; ai < 2; ++ai)
#pragma unroll
                for (int m = 0; m < 4; ++m) { const int row = row0 + ai * HALF + m * 16; const int b = row / seqlen, s = row - b * seqlen;
#pragma unroll
                    for (int bj = 0; bj < 2; ++bj)
#pragma unroll
                        for (int n = 0; n < 2; ++n)
#pragma unroll
                            for (int j = 0; j < 4; ++j) { const int col = col0 + bj * HALF + 4 * n + j; const int hh = col >> 7, d = col & 127;
                                OT[((size_t)(b * nheads + hh) * 128 + d) * (size_t)seqlen + s] = bf16_1(acc[ai][bj][m][n][j]); } }
        } else {
#pragma unroll
            for (int ai = 0; ai < 2; ++ai)
#pragma unroll
                for (int m = 0; m < 4; ++m) { bf16_t* rowp = base + (size_t)(row0 + ai * HALF + m * 16) * ldc + col0;
                    float rsc = 1.f;
                    if (RS) { const float r = 1.0f / sqrtf(ssq[row0 + ai * HALF + m * 16] * (1.0f / 2048.0f) + 1e-6f); rsc = (ACT == 2) ? r * r : r; }
#pragma unroll
                    for (int bj = 0; bj < 2; ++bj) { f32x4 v0 = acc[ai][bj][m][0], v1 = acc[ai][bj][m][1];
                        if (RS && ACT != 2) { v0 = v0 * rsc; v1 = v1 * rsc; }
                        if (ACT == 2) {
#pragma unroll
                            for (int j = 0; j < 4; ++j) { float a = v0[j] > 0.f ? v0[j] : 0.f; v0[j] = a * a * rsc; float b = v1[j] > 0.f ? v1[j] : 0.f; v1[j] = b * b * rsc; } }
                        u32x4 w; w.x = cvt_pk_bf16(v0[0], v0[1]); w.y = cvt_pk_bf16(v0[2], v0[3]); w.z = cvt_pk_bf16(v1[0], v1[1]); w.w = cvt_pk_bf16(v1[2], v1[3]);
                        *(u32x4*)(rowp + bj * HALF) = w; } }
        }
    }
};
struct EpiResNorm {
    static constexpr bool PERM = false, AFTER_DRAIN = false;
    const float* base; float* out; int ldc; const float* gain; bf16_t* HG; float* ssq;
    __device__ __forceinline__ void operator()(const f32x4 (&acc)[2][2][4][2], const Unit& u, int wr, int wc, int fr, int fq) const {
        const int row0 = u.pm * BM + wr * 64 + fr, col0 = u.pn * BM + wc * 32 + 4 * fq;
        f32x4 gv[2][2];
#pragma unroll
        for (int bj = 0; bj < 2; ++bj)
#pragma unroll
            for (int n = 0; n < 2; ++n) gv[bj][n] = *(const f32x4*)(gain + col0 + bj * HALF + n * 16);
#pragma unroll
        for (int ai = 0; ai < 2; ++ai)
#pragma unroll
            for (int m = 0; m < 4; ++m) { const int row = row0 + ai * HALF + m * 16; const size_t off = (size_t)row * ldc + col0; float sq = 0.f;
#pragma unroll
                for (int bj = 0; bj < 2; ++bj)
#pragma unroll
                    for (int n = 0; n < 2; ++n) { const f32x4 h = *(const f32x4*)(base + off + bj * HALF + n * 16) + acc[ai][bj][m][n]; *(f32x4*)(out + off + bj * HALF + n * 16) = h;
                        sq += (h[0] * h[0] + h[1] * h[1]) + (h[2] * h[2] + h[3] * h[3]);
                        const f32x4 hg = h * gv[bj][n]; unsigned w0 = cvt_pk_bf16(hg[0], hg[1]), w1 = cvt_pk_bf16(hg[2], hg[3]);
                        typedef unsigned u32x2v __attribute__((ext_vector_type(2))); u32x2v w; w.x = w0; w.y = w1; *(u32x2v*)(HG + off + bj * HALF + n * 16) = w; }
                sq += __shfl_xor(sq, 16); sq += __shfl_xor(sq, 32);
                if (fq == 0) unsafeAtomicAdd(ssq + row, sq); }
    }
};
template <int B16  , int RS2 = 0  > struct EpiResBf16Ssq {
    static constexpr bool PERM = true, AFTER_DRAIN = false;
    const void* base; bf16_t* HB; int ldc; float* ssq; const float* ssq_in;
    __device__ __forceinline__ void operator()(const f32x4 (&acc)[2][2][4][2], const Unit& u, int wr, int wc, int fr, int fq) const {
        const int row0 = u.pm * BM + wr * 64 + fr, col0 = u.pn * BM + wc * 32 + 8 * fq;
        float rq[2][4], sqv[2][4];
#pragma unroll
        for (int ai = 0; ai < 2; ++ai)
#pragma unroll
            for (int m = 0; m < 4; ++m) rq[ai][m] = RS2 ? ssq_in[row0 + ai * HALF + m * 16] : 0.f;
#pragma unroll
        for (int ai = 0; ai < 2; ++ai)
#pragma unroll
            for (int m = 0; m < 4; ++m) { const int row = row0 + ai * HALF + m * 16; const size_t off = (size_t)row * ldc + col0; float sq = 0.f;
                float rs2 = 1.f; if (RS2) rs2 = 1.0f / (rq[ai][m] * (1.0f / 2048.0f) + 1e-6f);
#pragma unroll
                for (int bj = 0; bj < 2; ++bj) { f32x4 b0, b1;
                    if (B16) { const u32x4 bw = *(const u32x4*)((const bf16_t*)base + off + bj * HALF);
                        b0 = (f32x4){__uint_as_float(bw.x << 16), __uint_as_float(bw.x & 0xffff0000u), __uint_as_float(bw.y << 16), __uint_as_float(bw.y & 0xffff0000u)};
                        b1 = (f32x4){__uint_as_float(bw.z << 16), __uint_as_float(bw.z & 0xffff0000u), __uint_as_float(bw.w << 16), __uint_as_float(bw.w & 0xffff0000u)}; }
                    else { b0 = *(const f32x4*)((const float*)base + off + bj * HALF); b1 = *(const f32x4*)((const float*)base + off + bj * HALF + 4); }
                    const f32x4 h0 = RS2 ? b0 + acc[ai][bj][m][0] * rs2 : b0 + acc[ai][bj][m][0], h1 = RS2 ? b1 + acc[ai][bj][m][1] * rs2 : b1 + acc[ai][bj][m][1];
                    sq += ((h0[0] * h0[0] + h0[1] * h0[1]) + (h0[2] * h0[2] + h0[3] * h0[3])) + ((h1[0] * h1[0] + h1[1] * h1[1]) + (h1[2] * h1[2] + h1[3] * h1[3]));
                    u32x4 w; w.x = cvt_pk_bf16(h0[0], h0[1]); w.y = cvt_pk_bf16(h0[2], h0[3]); w.z = cvt_pk_bf16(h1[0], h1[1]); w.w = cvt_pk_bf16(h1[2], h1[3]);
                    *(u32x4*)(HB + off + bj * HALF) = w; }
                sqv[ai][m] = sq; }
#pragma unroll
        for (int ai = 0; ai < 2; ++ai)
#pragma unroll
            for (int m = 0; m < 4; ++m) { float sq = sqv[ai][m]; sq += __shfl_xor(sq, 16); sq += __shfl_xor(sq, 32); if (fq == 0) unsafeAtomicAdd(ssq + row0 + ai * HALF + m * 16, sq); }
    }
};
struct EpiResF32 {
    static constexpr bool PERM = false, AFTER_DRAIN = false;
    const float* base; float* out; int ldc;
    __device__ __forceinline__ void operator()(const f32x4 (&acc)[2][2][4][2], const Unit& u, int wr, int wc, int fr, int fq) const {
        const int row0 = u.pm * BM + wr * 64 + fr, col0 = u.pn * BM + wc * 32 + 4 * fq;
#pragma unroll
        for (int ai = 0; ai < 2; ++ai)
#pragma unroll
            for (int m = 0; m < 4; ++m) { const size_t off = (size_t)(row0 + ai * HALF + m * 16) * ldc + col0;
#pragma unroll
                for (int bj = 0; bj < 2; ++bj)
#pragma unroll
                    for (int n = 0; n < 2; ++n) { const f32x4 bs = *(const f32x4*)(base + off + bj * HALF + n * 16); *(f32x4*)(out + off + bj * HALF + n * 16) = bs + acc[ai][bj][m][n]; } }
    }
};

template <class Epi, class Sched, bool ALIGN_EPI = false, bool SP2 = false>
__device__ __forceinline__ void gemm_phase(PG8_LAS unsigned char* lds, const Gemm g, const Sched& S, const Epi& E, const int tid) {
    const int wid = __builtin_amdgcn_readfirstlane(tid >> 6), lane = tid & 63, wr = wid >> 2, wc = wid & 3, fr = lane & 15, fq = lane >> 4;
    const int K = g.K, nt = K / BK;
    unsigned voffA[2], voffB[2];
#pragma unroll
    for (int i = 0; i < 2; ++i) { int R, C; stage_rc(tid * 16 + i * 8192, R, C); const int Rb = Epi::PERM ? ((R & ~31) + perm32(R & 31)) : R;
        voffA[i] = (unsigned)(R * K + C) * 2u; voffB[i] = (unsigned)(Rb * K + C) * 2u; }
    const size_t kstep = (size_t)(BK * 2);
    const size_t hstep = (size_t)HALF * K * 2;
    const size_t tstep = 2 * hstep;
    const unsigned ldsw = (unsigned)wid * 1024u;
    const int aoff = lds_byte(wr * 64 + fr, fq * 8), boff = lds_byte(wc * 32 + fr, fq * 8);
#define PG8_SA(b, h) (((b) * 2 + (h)) * HTB)
#define PG8_SB(b, h) ((4 + (b) * 2 + (h)) * HTB)
#define PG8_STAGE(bufoff, gbase, voff) do { _Pragma("unroll") for (int _i = 0; _i < 2; ++_i) \
        __builtin_amdgcn_global_load_lds((const unsigned*)((const char*)(gbase) + (voff)[_i]), (PG8_LAS unsigned*)(lds + (bufoff) + ldsw + _i * 8192), 16, 0, 0); } while (0)
#define PG8_LDA(dst, b, h) do { _Pragma("unroll") for (int m = 0; m < 4; ++m) _Pragma("unroll") for (int k = 0; k < 2; ++k) dst[m][k] = *(const PG8_LAS bf16x8*)(lds + PG8_SA(b, h) + aoff + m * 2048 + k * 1024); } while (0)
#define PG8_LDB(dst, b, h) do { _Pragma("unroll") for (int n = 0; n < 2; ++n) _Pragma("unroll") for (int k = 0; k < 2; ++k) dst[n][k] = *(const PG8_LAS bf16x8*)(lds + PG8_SB(b, h) + boff + n * 2048 + k * 1024); } while (0)
#define PG8_MMA(ai, bj, At, Bt) do { __builtin_amdgcn_s_setprio(1); _Pragma("unroll") for (int m = 0; m < 4; ++m) _Pragma("unroll") for (int n = 0; n < 2; ++n) _Pragma("unroll") for (int k = 0; k < 2; ++k) \
        acc[ai][bj][m][n] = __builtin_amdgcn_mfma_f32_16x16x32_bf16(Bt[n][k], At[m][k], acc[ai][bj][m][n], 0, 0, 0); __builtin_amdgcn_s_setprio(0); } while (0)
#define PG8_WAIT_V(n) asm volatile("s_waitcnt vmcnt(" #n ")" ::: "memory")
#define PG8_WAIT_L(n) asm volatile("s_waitcnt lgkmcnt(" #n ")" ::: "memory")
#define PG8_BAR __builtin_amdgcn_s_barrier()
#define PG8_SCHED __builtin_amdgcn_sched_barrier(0)
    Unit cur, nxt; int ui = 0;
    if (!S.next(0, cur)) return;
    f32x4 acc[2][2][4][2];
#pragma unroll
    for (int a = 0; a < 2; ++a)
#pragma unroll
        for (int b = 0; b < 2; ++b)
#pragma unroll
            for (int m = 0; m < 4; ++m)
#pragma unroll
                for (int n = 0; n < 2; ++n) acc[a][b][m][n] = (f32x4){0.f, 0.f, 0.f, 0.f};
    bf16x8 At[4][2], B0[2][2], B1[2][2];
    const char* cA = (const char*)g.A + (size_t)cur.pm * tstep; const char* cB = (const char*)g.Bt + (size_t)cur.pn * tstep;
    S.a_ready(cur);
    if constexpr (SP2) {
        PG8_STAGE(PG8_SB(0, 0), cB, voffB); PG8_STAGE(PG8_SB(0, 1), cB + hstep, voffB); PG8_STAGE(PG8_SA(0, 0), cA, voffA); PG8_STAGE(PG8_SA(0, 1), cA + hstep, voffA);
        if (wr == 1) PG8_BAR;
        PG8_WAIT_V(2); PG8_BAR;
        PG8_STAGE(PG8_SB(1, 0), cB + kstep, voffB); PG8_STAGE(PG8_SA(1, 0), cA + kstep, voffA); PG8_STAGE(PG8_SB(1, 1), cB + hstep + kstep, voffB);
        PG8_WAIT_V(6); PG8_BAR;
    } else {
        PG8_STAGE(PG8_SB(0, 0), cB, voffB); PG8_STAGE(PG8_SA(0, 0), cA, voffA); PG8_STAGE(PG8_SB(0, 1), cB + hstep, voffB); PG8_STAGE(PG8_SA(0, 1), cA + hstep, voffA);
        if (wr == 1) PG8_BAR;
        PG8_WAIT_V(4); PG8_BAR;
        PG8_STAGE(PG8_SB(1, 0), cB + kstep, voffB); PG8_STAGE(PG8_SA(1, 0), cA + kstep, voffA); PG8_STAGE(PG8_SB(1, 1), cB + hstep + kstep, voffB);
        PG8_WAIT_V(6); PG8_BAR;
    }
    for (;;) {
        const bool has_next = S.next(ui + 1, nxt);
        const char* nA = has_next ? (const char*)g.A + (size_t)nxt.pm * tstep : cA; const char* nB = has_next ? (const char*)g.Bt + (size_t)nxt.pn * tstep : cB;
        for (int t = 0; t < nt; t += 2) {
            const bool last = (t == nt - 2);
            const char* a1 = cA + (size_t)(t + 1) * kstep;
            const char* a2 = last ? nA : cA + (size_t)(t + 2) * kstep; const char* b2 = last ? nB : cB + (size_t)(t + 2) * kstep;
            const char* a3 = a2 + kstep; const char* b3 = b2 + kstep;
            if (last && has_next) S.a_ready(nxt);
            if constexpr (SP2) {
            PG8_LDB(B0, 0, 0); PG8_LDB(B1, 0, 1); PG8_SCHED; PG8_LDA(At, 0, 0); PG8_STAGE(PG8_SA(1, 1), a1 + hstep, voffA);
            PG8_WAIT_V(8); PG8_WAIT_L(0); PG8_BAR; PG8_MMA(0, 0, At, B0); PG8_MMA(0, 1, At, B1); PG8_BAR; PG8_SCHED;
            PG8_LDA(At, 0, 1); PG8_STAGE(PG8_SB(0, 0), b2, voffB); PG8_STAGE(PG8_SB(0, 1), b2 + hstep, voffB); PG8_STAGE(PG8_SA(0, 0), a2, voffA);
            PG8_WAIT_V(8); PG8_WAIT_L(0); PG8_BAR; PG8_MMA(1, 0, At, B0); PG8_MMA(1, 1, At, B1); PG8_BAR; PG8_SCHED;
            PG8_LDB(B0, 1, 0); PG8_LDB(B1, 1, 1); PG8_SCHED; PG8_LDA(At, 1, 0); PG8_STAGE(PG8_SA(0, 1), a2 + hstep, voffA);
            PG8_WAIT_V(8); PG8_WAIT_L(0); PG8_BAR; PG8_MMA(0, 0, At, B0); PG8_MMA(0, 1, At, B1); PG8_BAR; PG8_SCHED;
            PG8_LDA(At, 1, 1); PG8_STAGE(PG8_SB(1, 0), b3, voffB); PG8_STAGE(PG8_SB(1, 1), b3 + hstep, voffB); PG8_STAGE(PG8_SA(1, 0), a3, voffA);
            PG8_WAIT_V(8); PG8_WAIT_L(0); PG8_BAR; PG8_MMA(1, 0, At, B0); PG8_MMA(1, 1, At, B1); PG8_BAR; PG8_SCHED;
            } else {
            PG8_LDB(B0, 0, 0); PG8_SCHED; PG8_LDA(At, 0, 0); PG8_STAGE(PG8_SA(1, 1), a1 + hstep, voffA);
            PG8_WAIT_L(8); PG8_BAR; PG8_WAIT_L(0); PG8_MMA(0, 0, At, B0); PG8_BAR; PG8_SCHED;
            PG8_LDB(B1, 0, 1); PG8_STAGE(PG8_SB(0, 0), b2, voffB);
            PG8_BAR; PG8_WAIT_L(0); PG8_MMA(0, 1, At, B1); PG8_BAR;
            PG8_LDA(At, 0, 1); PG8_STAGE(PG8_SA(0, 0), a2, voffA);
            PG8_BAR; PG8_WAIT_L(0); PG8_MMA(1, 0, At, B0); PG8_BAR; PG8_SCHED;
            PG8_STAGE(PG8_SB(0, 1), b2 + hstep, voffB);
            PG8_WAIT_V(6); PG8_BAR; PG8_MMA(1, 1, At, B1); PG8_BAR;
            PG8_LDB(B0, 1, 0); PG8_SCHED; PG8_LDA(At, 1, 0); PG8_STAGE(PG8_SA(0, 1), a2 + hstep, voffA);
            PG8_WAIT_L(8); PG8_BAR; PG8_WAIT_L(0); PG8_MMA(0, 0, At, B0); PG8_BAR; PG8_SCHED;
            PG8_LDB(B1, 1, 1); PG8_STAGE(PG8_SB(1, 0), b3, voffB);
            PG8_BAR; PG8_WAIT_L(0); PG8_MMA(0, 1, At, B1); PG8_BAR;
            PG8_LDA(At, 1, 1); PG8_STAGE(PG8_SA(1, 0), a3, voffA);
            PG8_BAR; PG8_WAIT_L(0); PG8_MMA(1, 0, At, B0); PG8_BAR; PG8_SCHED;
            PG8_STAGE(PG8_SB(1, 1), b3 + hstep, voffB);
            PG8_WAIT_V(6); PG8_BAR; PG8_MMA(1, 1, At, B1); PG8_BAR;
            }
        }
        if constexpr (ALIGN_EPI) { if (wr == 0) PG8_BAR; }
        if constexpr (!Epi::AFTER_DRAIN) { E(acc, cur, wr, wc, fr, fq); S.done(cur); }
        if (!has_next) break;
#pragma unroll
        for (int a = 0; a < 2; ++a)
#pragma unroll
            for (int b = 0; b < 2; ++b)
#pragma unroll
                for (int m = 0; m < 4; ++m)
#pragma unroll
                    for (int n = 0; n < 2; ++n) acc[a][b][m][n] = (f32x4){0.f, 0.f, 0.f, 0.f};
        cur = nxt; cA = nA; cB = nB; ++ui;
        if constexpr (ALIGN_EPI) { if (wr == 1) PG8_BAR; }
    }
    PG8_WAIT_V(0);
    if constexpr (!ALIGN_EPI) { if (wr == 0) PG8_BAR; }
    PG8_BAR;
    if constexpr (Epi::AFTER_DRAIN) { E.fused(acc, cur, wr, wc, fr, fq, lds, wid, lane); S.done(cur); }
#undef PG8_SA
#undef PG8_SB
#undef PG8_STAGE
#undef PG8_LDA
#undef PG8_LDB
#undef PG8_MMA
#undef PG8_WAIT_V
#undef PG8_WAIT_L
#undef PG8_BAR
#undef PG8_SCHED
}
}

#include <hip/hip_cooperative_groups.h>
namespace cg = cooperative_groups;
#define LAS __attribute__((address_space(3)))
typedef unsigned short bf16;
typedef unsigned v4u __attribute__((ext_vector_type(4)));
typedef unsigned v2u __attribute__((ext_vector_type(2)));
typedef float f32x4 __attribute__((ext_vector_type(4)));
typedef float f32x2 __attribute__((ext_vector_type(2)));
typedef float f32x16 __attribute__((ext_vector_type(16)));
typedef short bf16x8 __attribute__((ext_vector_type(8)));

#ifndef MK_PER_PHASE
#define MK_PER_PHASE 0
#endif
constexpr int NB = 2, S = 16384, DM = 2048, T = NB * S, NH = 8, HD = 128, AW = 1024, CC = 1024, INW = 5120, FF = 8192, NMEM = 256, XH = 4, XW = 512, CONVK = 31, NBLK = 64;
constexpr float EPS = 1e-6f, LOG2E = 1.4426950408889634f;
constexpr int NPHASE = 15;
constexpr size_t MiB = 1u << 20;
constexpr size_t WS_CTL = 0; constexpr int CW_BAR = 4096;
constexpr size_t WS_WIN = 2 * MiB, WS_WOUT = 22 * MiB, WS_WQ = 30 * MiB, WS_WKV = 32 * MiB, WS_WO = 36 * MiB, WS_W1 = 38 * MiB, WS_W2 = 70 * MiB;
constexpr size_t WS_KBAR = 102 * MiB, WS_TB = 103 * MiB, WS_MN = 104 * MiB, WS_KC = 106 * MiB, WS_VCT = 107 * MiB;
constexpr size_t WS_NB = 112 * MiB;
constexpr size_t WS_Q = 240 * MiB, WS_K = 304 * MiB, WS_VT = 368 * MiB, WS_UV = 432 * MiB, WS_UG = 496 * MiB;
constexpr size_t WS_AC = 560 * MiB;
constexpr size_t WS_F = 240 * MiB;
constexpr size_t WS_QC = 240 * MiB, WS_OC = 272 * MiB;
constexpr size_t WS_PO = 752 * MiB;
constexpr size_t WS_PML = 944 * MiB;
constexpr size_t WS_LIST = 952 * MiB;
constexpr size_t WS_END = 1016 * MiB;
constexpr int LDS_BYTES = 152064;
constexpr int KS_OFF = 0, KROW = 272, VS_OFF = 256 * 272, VROW = 520  , TB_OFF = VS_OFF + 128 * 528, RED_OFF = TB_OFF + 8192, CNT_OFF = RED_OFF + 2048, PT_OFF = CNT_OFF + 4096, ST_OFF = PT_OFF + 192;
static_assert(PT_OFF + 256 <= LDS_BYTES, "LDS map");

__device__ __forceinline__ float bf_lo(unsigned w) { return __uint_as_float(w << 16); }
__device__ __forceinline__ float bf_hi(unsigned w) { return __uint_as_float(w & 0xffff0000u); }
typedef __bf16 bf16x2_t __attribute__((ext_vector_type(2)));
__device__ __forceinline__ unsigned pk2(float lo, float hi) { return pg8::cvt_pk_bf16(lo, hi); }
__device__ __forceinline__ unsigned pk2s(float lo, float hi) { f32x2 v = {lo, hi}; bf16x2_t b = __builtin_convertvector(v, bf16x2_t); return __builtin_bit_cast(unsigned, b); }
__device__ __forceinline__ float ex2(float x) { return __builtin_amdgcn_exp2f(x); }
__device__ __forceinline__ float wave_sum(float v) {
#pragma unroll
    for (int o = 1; o < 64; o <<= 1) v += __shfl_xor(v, o);
    return v;
}
__device__ __forceinline__ float sigmoidf_(float x) { return 1.0f / (1.0f + __expf(-x)); }

__device__ __forceinline__ void p0_transpose_item(const float* W, int K, int N, bf16* WT, int row_off, LAS float* scr, int item, int lane, const float* gk = nullptr) {
    const int nblk = N / 32, kb = item / nblk, nb = item % nblk, k0 = 64 * kb, n0 = 32 * nb;
    float wv[32];
#pragma unroll
    for (int i = 0; i < 32; ++i) { const int kk = 2 * i + (lane >> 5); wv[i] = W[(size_t)(k0 + kk) * N + n0 + (lane & 31)]; }
    if (gk) {
#pragma unroll
        for (int i = 0; i < 32; ++i) wv[i] *= gk[k0 + 2 * i + (lane >> 5)];
    }
#pragma unroll
    for (int i = 0; i < 32; ++i) { const int kk = 2 * i + (lane >> 5); scr[kk * 33 + (lane & 31)] = wv[i]; }
    asm volatile("s_waitcnt lgkmcnt(0)" ::: "memory");
    const int c = lane & 7;
#pragma unroll
    for (int j = 0; j < 4; ++j) { const int n = (lane >> 3) + 8 * j; const LAS float* s = scr + (8 * c) * 33 + n;
        v4u o; o.x = pk2(s[0 * 33], s[1 * 33]); o.y = pk2(s[2 * 33], s[3 * 33]); o.z = pk2(s[4 * 33], s[5 * 33]); o.w = pk2(s[6 * 33], s[7 * 33]);
        *(v4u*)(WT + (size_t)(row_off + n0 + n) * K + k0 + 8 * c) = o; }
    asm volatile("s_waitcnt lgkmcnt(0)" ::: "memory");
}
__device__ __forceinline__ void rms_row_bf16(const float* xrow, const float* g, bf16* orow, int lane) {
    const f32x4* xr = (const f32x4*)xrow + lane; f32x4 v[8]; float s = 0.f;
#pragma unroll
    for (int j = 0; j < 8; ++j) { v[j] = xr[64 * j]; s += (v[j].x * v[j].x + v[j].y * v[j].y) + (v[j].z * v[j].z + v[j].w * v[j].w); }
    const float rstd = 1.0f / sqrtf(wave_sum(s) * (1.0f / DM) + EPS);
    const f32x4* gr = (const f32x4*)g + lane; v2u* o8 = (v2u*)orow + lane;
#pragma unroll
    for (int j = 0; j < 8; ++j) { const f32x4 gv = gr[64 * j]; v2u w; w.x = pk2(v[j].x * rstd * gv.x, v[j].y * rstd * gv.y); w.y = pk2(v[j].z * rstd * gv.z, v[j].w * rstd * gv.w); o8[64 * j] = w; }
}
__device__ __forceinline__ void rms_row_f32(const float* xrow, const float* g, float* orow, int lane) {
    const f32x4* xr = (const f32x4*)xrow + lane; f32x4 v[8]; float s = 0.f;
#pragma unroll
    for (int j = 0; j < 8; ++j) { v[j] = xr[64 * j]; s += (v[j].x * v[j].x + v[j].y * v[j].y) + (v[j].z * v[j].z + v[j].w * v[j].w); }
    const float rstd = 1.0f / sqrtf(wave_sum(s) * (1.0f / DM) + EPS);
    const f32x4* gr = (const f32x4*)g + lane; f32x4* o = (f32x4*)orow + lane;
#pragma unroll
    for (int j = 0; j < 8; ++j) { const f32x4 gv = gr[64 * j]; o[64 * j] = v[j] * rstd * gv; }
}

__device__ __forceinline__ int crow(int r, int hi) { return (r & 3) + 8 * (r >> 2) + 4 * hi; }
__device__ __forceinline__ void attn_stage(LAS unsigned char* lds, const bf16* Kg, unsigned kstride, const bf16* VTg, unsigned vstride, const float* tbg, int tid) {
    const unsigned ko = (unsigned)(tid >> 4) * (kstride * 2u) + (unsigned)(tid & 15) * 16u, vo = (unsigned)(tid >> 5) * (vstride * 2u) + (unsigned)(tid & 31) * 16u;
    const unsigned kl = (unsigned)(tid >> 4) * KROW + (unsigned)(tid & 15) * 16u, vl = (unsigned)(tid >> 5) * VROW + (unsigned)(tid & 31) * 16u;
    v4u kx[8], vx[8];
#pragma unroll
    for (int p = 0; p < 8; ++p) kx[p] = *(const v4u*)((const unsigned char*)Kg + (size_t)p * 32 * kstride * 2 + ko);
#pragma unroll
    for (int p = 0; p < 8; ++p) vx[p] = *(const v4u*)((const unsigned char*)VTg + (size_t)p * 16 * vstride * 2 + vo);
#pragma unroll
    for (int p = 0; p < 8; ++p) *(LAS v4u*)(lds + KS_OFF + p * 32 * KROW + kl) = kx[p];
#pragma unroll
    for (int p = 0; p < 8; ++p) { v2u a2, b2; a2.x = vx[p].x; a2.y = vx[p].y; b2.x = vx[p].z; b2.y = vx[p].w;
        *(LAS v2u*)(lds + VS_OFF + p * 16 * VROW + vl) = a2; *(LAS v2u*)(lds + VS_OFF + p * 16 * VROW + vl + 8) = b2; }
    if (tbg) { const f32x4 x = ((const f32x4*)tbg)[tid]; ((LAS f32x4*)(lds + TB_OFF))[tid] = x; }
}
__device__ __forceinline__ void load_q(bf16x8 (&qf)[8], const bf16* qp, int hi) {
#pragma unroll
    for (int ks = 0; ks < 8; ++ks) qf[ks] = *(const bf16x8*)(qp + 16 * ks + 8 * hi);
}
__device__ __forceinline__ void store_o16(bf16* rowbase, const f32x16 (&O)[4], float scale, int hi, bool doit) {
#pragma unroll
    for (int dt = 0; dt < 4; ++dt)
#pragma unroll
        for (int gp = 0; gp < 2; ++gp) {
            const int ga = 2 * gp, gb = 2 * gp + 1;
            const unsigned ax = pk2(O[dt][4 * ga] * scale, O[dt][4 * ga + 1] * scale), ay = pk2(O[dt][4 * ga + 2] * scale, O[dt][4 * ga + 3] * scale);
            const unsigned bx = pk2(O[dt][4 * gb] * scale, O[dt][4 * gb + 1] * scale), by = pk2(O[dt][4 * gb + 2] * scale, O[dt][4 * gb + 3] * scale);
            const v2u r1 = __builtin_amdgcn_permlane32_swap(ax, bx, false, false), r2 = __builtin_amdgcn_permlane32_swap(ay, by, false, false);
            v4u w; w.x = r1.x; w.y = r2.x; w.z = r1.y; w.w = r2.y;
            if (doit) *(v4u*)(rowbase + 32 * dt + 8 * (hi ? gb : ga)) = w;
        }
}
template <int MODE>
__device__ __forceinline__ void attn_core(LAS unsigned char* lds, const bf16x8 (&qf)[8], int qrel, float sc, int nchunks, bool fast, float cbias, f32x16 (&O)[4], float& m, float& l, int lane) {
    const int l31 = lane & 31, hi = lane >> 5;
#pragma unroll
    for (int dt = 0; dt < 4; ++dt)
#pragma unroll
        for (int r = 0; r < 16; ++r) O[dt][r] = 0.f;
    m = -1e30f; l = 0.f;
    const LAS float* tb = (const LAS float*)(lds + TB_OFF);
#pragma unroll 1
    for (int c = 0; c < nchunks; ++c) {
        f32x16 s0, s1;
#pragma unroll
        for (int r = 0; r < 16; ++r) { s0[r] = 0.f; s1[r] = 0.f; }
        const LAS unsigned char* kp = lds + KS_OFF + (64 * c + l31) * KROW + 16 * hi;
#pragma unroll
        for (int h2 = 0; h2 < 2; ++h2) {
            bf16x8 ka[4], kb[4];
#pragma unroll
            for (int ks = 0; ks < 4; ++ks) { ka[ks] = *(const LAS bf16x8*)(kp + 32 * (4 * h2 + ks)); kb[ks] = *(const LAS bf16x8*)(kp + 32 * KROW + 32 * (4 * h2 + ks)); }
#pragma unroll
            for (int ks = 0; ks < 4; ++ks) {
                s0 = __builtin_amdgcn_mfma_f32_32x32x16_bf16(ka[ks], qf[4 * h2 + ks], s0, 0, 0, 0);
                s1 = __builtin_amdgcn_mfma_f32_32x32x16_bf16(kb[ks], qf[4 * h2 + ks], s1, 0, 0, 0);
            }
        }
        float mx = -INFINITY;
#pragma unroll
        for (int r = 0; r < 16; ++r) {
            const int d0 = qrel - (64 * c + crow(r, hi)), d1 = d0 - 32;
            float t0 = s0[r] * sc, t1 = s1[r] * sc;
            if (MODE == 0) { if (fast) { t0 += cbias; t1 += cbias; } else { t0 += tb[d0 < 2047 ? d0 : 2047]; t1 += tb[d1 < 2047 ? d1 : 2047]; } }
            if (MODE == 1) { t0 = d0 >= 0 ? t0 + tb[d0 > 0 ? d0 : 0] : -INFINITY; t1 = d1 >= 0 ? t1 + tb[d1 > 0 ? d1 : 0] : -INFINITY; }
            s0[r] = t0; s1[r] = t1; mx = fmaxf(mx, fmaxf(t0, t1));
        }
        mx = fmaxf(mx, __shfl_xor(mx, 32));
        const float mn = fmaxf(m, mx), alpha = ex2(m - mn); m = mn;
        float ls = 0.f;
#pragma unroll
        for (int r = 0; r < 16; ++r) { s0[r] = ex2(s0[r] - mn); s1[r] = ex2(s1[r] - mn); ls += s0[r] + s1[r]; }
        l = l * alpha + ls;
#pragma unroll
        for (int dt = 0; dt < 4; ++dt)
#pragma unroll
            for (int r = 0; r < 16; ++r) O[dt][r] *= alpha;
#pragma unroll
        for (int kt2 = 0; kt2 < 2; ++kt2) {
            bf16x8 pb[2];
#pragma unroll
            for (int sp = 0; sp < 2; ++sp) {
                v4u pw;
                if (kt2 == 0) { pw.x = pk2s(s0[8 * sp + 0], s0[8 * sp + 1]); pw.y = pk2s(s0[8 * sp + 2], s0[8 * sp + 3]); pw.z = pk2s(s0[8 * sp + 4], s0[8 * sp + 5]); pw.w = pk2s(s0[8 * sp + 6], s0[8 * sp + 7]); }
                else          { pw.x = pk2s(s1[8 * sp + 0], s1[8 * sp + 1]); pw.y = pk2s(s1[8 * sp + 2], s1[8 * sp + 3]); pw.z = pk2s(s1[8 * sp + 4], s1[8 * sp + 5]); pw.w = pk2s(s1[8 * sp + 6], s1[8 * sp + 7]); }
                pb[sp] = __builtin_bit_cast(bf16x8, pw);
            }
            const LAS unsigned char* vp = lds + VS_OFF + l31 * VROW + (64 * c + 32 * kt2 + 4 * hi) * 2;
            v2u va[2][4][2];
#pragma unroll
            for (int sp = 0; sp < 2; ++sp)
#pragma unroll
                for (int dt = 0; dt < 4; ++dt) { va[sp][dt][0] = *(const LAS v2u*)(vp + sp * 32 + dt * 32 * VROW); va[sp][dt][1] = *(const LAS v2u*)(vp + sp * 32 + dt * 32 * VROW + 16); }
#pragma unroll
            for (int sp = 0; sp < 2; ++sp)
#pragma unroll
                for (int dt = 0; dt < 4; ++dt) {
                    v4u aw; aw.x = va[sp][dt][0].x; aw.y = va[sp][dt][0].y; aw.z = va[sp][dt][1].x; aw.w = va[sp][dt][1].y;
                    O[dt] = __builtin_amdgcn_mfma_f32_32x32x16_bf16(__builtin_bit_cast(bf16x8, aw), pb[sp], O[dt], 0, 0, 0);
                }
        }
    }
    l += __shfl_xor(l, 32);
}

#define XB_TMO      128
#define XB_XCNT(j)  (256  + 64 * (j))
#define XB_XSUB(j)  (1280 + 64 * (j))
#define XB_XGEN(j)  (2304 + 64 * (j))
#define XB_TOP      3328
#define XB_TOPGEN   3392
#define XCD_BAR_WORDS 3456
#define XB_SPIN_CAP (1u << 18)

__device__ __forceinline__ unsigned xb_ld(unsigned* p)              { return __hip_atomic_load(p, __ATOMIC_RELAXED, __HIP_MEMORY_SCOPE_AGENT); }
__device__ __forceinline__ unsigned xb_add(unsigned* p, unsigned v) { return __hip_atomic_fetch_add(p, v, __ATOMIC_RELAXED, __HIP_MEMORY_SCOPE_AGENT); }
__device__ __forceinline__ unsigned xb_xcc_id() { return (unsigned)__builtin_amdgcn_s_getreg((3 << 11) | 20) & 0xFu; }
#define XB_SPIN(cond, bar) do { unsigned _sp = 0; while (cond) { __builtin_amdgcn_s_sleep(1); \
    if ((++_sp & 255u) == 0u) { if (xb_ld(&(bar)[XB_TMO])) break; if (_sp > XB_SPIN_CAP) { atomicAdd(&(bar)[XB_TMO], 1u); break; } } } } while (0)

struct XcdBarrier {
    unsigned* bar; unsigned x;
    volatile LAS unsigned* st;
};

__device__ __forceinline__ XcdBarrier xcd_barrier_post(unsigned* bar, volatile LAS unsigned* st, int tid) {
    XcdBarrier b; b.bar = bar; b.x = xb_xcc_id(); b.st = st;
    if (tid == 0) (void)xb_add(&bar[XB_XCNT(b.x)], 1u);
    return b;
}
__device__ __forceinline__ void xcd_barrier_complete(unsigned* bar, unsigned x, unsigned& nloc, unsigned& nx) {
    const unsigned G = gridDim.x * gridDim.y * gridDim.z;
    unsigned sum, cnt, mine, sp = 0u;
    for (;;) {
        sum = 0u; cnt = 0u; mine = 0u;
#pragma unroll
        for (unsigned j = 0; j < 16; ++j) { const unsigned c = xb_ld(&bar[XB_XCNT(j)]); sum += c; cnt += (c > 0u) ? 1u : 0u; mine = (j == x) ? c : mine; }
        if (sum == G) break;
        __builtin_amdgcn_s_sleep(1);
        if ((++sp & 255u) == 0u) { if (xb_ld(&bar[XB_TMO])) break; if (sp > XB_SPIN_CAP) { atomicAdd(&bar[XB_TMO], 1u); break; } }
    }
    nloc = mine > 0u ? mine : 1u; nx = cnt > 0u ? cnt : 1u;
}

__device__ __forceinline__ void xcd_barrier(const XcdBarrier& b, int tid) {
    asm volatile("s_waitcnt vmcnt(0)" ::: "memory");
    __syncthreads();
    if (tid == 0) {
        unsigned* bar = b.bar;
        __builtin_amdgcn_s_waitcnt(0);
        unsigned nloc = b.st[0], nx = b.st[1];
        if (nloc == 0u) { xcd_barrier_complete(bar, b.x, nloc, nx); b.st[0] = nloc; b.st[1] = nx; }
        const unsigned old = xb_add(&bar[XB_XSUB(b.x)], 1u);
        const unsigned gen = old / nloc;
        if (old + 1u == (gen + 1u) * nloc) {
            __builtin_amdgcn_fence(__ATOMIC_RELEASE, "agent");
            asm volatile("s_waitcnt vmcnt(0)" ::: "memory");
            const unsigned og = xb_add(&bar[XB_TOP], 1u);
            const unsigned tg = og / nx;
            if (og + 1u == (tg + 1u) * nx) xb_add(&bar[XB_TOPGEN], 1u);
            else XB_SPIN(xb_ld(&bar[XB_TOPGEN]) == tg, bar);
            __builtin_amdgcn_fence(__ATOMIC_ACQUIRE, "agent");
            xb_add(&bar[XB_XGEN(b.x)], 1u);
            asm volatile("s_waitcnt vmcnt(0)" ::: "memory");
        } else {
            XB_SPIN(xb_ld(&bar[XB_XGEN(b.x)]) == gen, bar);
            __builtin_amdgcn_fence(__ATOMIC_ACQUIRE, "agent");
            asm volatile("s_waitcnt vmcnt(0)" ::: "memory");
        }
    }
    __syncthreads();
}

struct Args { const float* in[20]; float* out; unsigned char* ws; int ph_lo, ph_hi; };

__global__ void __launch_bounds__(512, 2) fwd(Args a) {
    extern __shared__ __attribute__((aligned(16))) unsigned char lds_raw[];
    LAS unsigned char* lds = (LAS unsigned char*)lds_raw;
    const int wave = __builtin_amdgcn_readfirstlane((int)threadIdx.x >> 6);
    const int G = gridDim.x, blk = blockIdx.x;
    const int lo = a.ph_lo, hiP = a.ph_hi;
    LAS unsigned long long* ptab = (LAS unsigned long long*)(lds + PT_OFF);
    if (threadIdx.x == 0) {
#pragma unroll
        for (int i = 0; i < 20; ++i) ptab[i] = (unsigned long long)a.in[i];
        ptab[20] = (unsigned long long)a.out; ptab[21] = (unsigned long long)a.ws;
        ((LAS unsigned*)(lds + ST_OFF))[0] = 0u; ((LAS unsigned*)(lds + ST_OFF))[1] = 0u;
    }
    __syncthreads();
    if (a.ph_hi - a.ph_lo > 1) {
        cg::this_grid().sync();
        const int lane_ = (int)__builtin_amdgcn_mbcnt_hi(~0u, __builtin_amdgcn_mbcnt_lo(~0u, 0u));
        (void)xcd_barrier_post((unsigned*)(a.ws + WS_CTL) + CW_BAR, (volatile LAS unsigned*)(lds + ST_OFF), wave * 64 + lane_);
    }
#define LDP(i) ((unsigned char*)(__attribute__((address_space(1))) unsigned char*)(((unsigned long long)(unsigned)__builtin_amdgcn_readfirstlane((int)(unsigned)(ptab[i] >> 32)) << 32) | (unsigned long long)(unsigned)__builtin_amdgcn_readfirstlane((int)(unsigned)ptab[i])))
#define DECL_PTRS \
    const int lane = (int)__builtin_amdgcn_mbcnt_hi(~0u, __builtin_amdgcn_mbcnt_lo(~0u, 0u)), tid = wave * 64 + lane, l31 = lane & 31, hi = lane >> 5; (void)tid; (void)l31; (void)hi; \
    const float* const x = (const float*)LDP(0); (void)x; \
    const float* const mem = (const float*)LDP(1); (void)mem; \
    const float* const g_mix = (const float*)LDP(2); (void)g_mix; \
    const float* const w_in = (const float*)LDP(3); (void)w_in; \
    const float* const conv_w = (const float*)LDP(4); (void)conv_w; \
    const float* const conv_b = (const float*)LDP(5); (void)conv_b; \
    const float* const ln_g = (const float*)LDP(6); (void)ln_g; \
    const float* const ln_b = (const float*)LDP(7); (void)ln_b; \
    const float* const w_out = (const float*)LDP(8); (void)w_out; \
    const float* const rel_bias = (const float*)LDP(9); (void)rel_bias; \
    const float* const g_cross = (const float*)LDP(10); (void)g_cross; \
    const float* const g_mem = (const float*)LDP(11); (void)g_mem; \
    const float* const wq_c = (const float*)LDP(12); (void)wq_c; \
    const float* const wk_c = (const float*)LDP(13); (void)wk_c; \
    const float* const wv_c = (const float*)LDP(14); (void)wv_c; \
    const float* const wo_c = (const float*)LDP(15); (void)wo_c; \
    const float* const g_mlp = (const float*)LDP(16); (void)g_mlp; \
    const float* const w1 = (const float*)LDP(17); (void)w1; \
    const float* const w2 = (const float*)LDP(18); (void)w2; \
    const float* const g_final = (const float*)LDP(19); (void)g_final; \
    float* const out = (float*)LDP(20); (void)out; unsigned char* const ws = LDP(21); (void)ws; \
    unsigned* const CNT = (unsigned*)(ws + WS_CTL); (void)CNT; float* const SSQ1 = (float*)(ws + WS_CTL + 262144); (void)SSQ1; float* const SSQ2 = (float*)(ws + WS_CTL + 524288); (void)SSQ2; float* const SSQ3 = (float*)(ws + WS_CTL + 786432); (void)SSQ3; \
    bf16* const WIN_T = (bf16*)(ws + WS_WIN); (void)WIN_T; \
    bf16* const WOUT_T = (bf16*)(ws + WS_WOUT); (void)WOUT_T; \
    bf16* const WQ_T = (bf16*)(ws + WS_WQ); (void)WQ_T; \
    bf16* const WKV_T = (bf16*)(ws + WS_WKV); (void)WKV_T; \
    bf16* const WO_T = (bf16*)(ws + WS_WO); (void)WO_T; \
    bf16* const W1_T = (bf16*)(ws + WS_W1); (void)W1_T; \
    bf16* const W2_T = (bf16*)(ws + WS_W2); (void)W2_T; \
    float* const KBAR = (float*)(ws + WS_KBAR); (void)KBAR; \
    float* const TB = (float*)(ws + WS_TB); (void)TB; \
    bf16* const MN = (bf16*)(ws + WS_MN); (void)MN; \
    bf16* const KC = (bf16*)(ws + WS_KC); (void)KC; \
    bf16* const VCT = (bf16*)(ws + WS_VCT); (void)VCT; \
    bf16* const NBUF = (bf16*)(ws + WS_NB); (void)NBUF; \
    bf16* const Q = (bf16*)(ws + WS_Q); (void)Q; \
    bf16* const K = (bf16*)(ws + WS_K); (void)K; \
    bf16* const VT = (bf16*)(ws + WS_VT); (void)VT; \
    bf16* const UV = (bf16*)(ws + WS_UV); (void)UV; \
    bf16* const UG = (bf16*)(ws + WS_UG); (void)UG; \
    bf16* const AC = (bf16*)(ws + WS_AC); (void)AC; \
    bf16* const FB = (bf16*)(ws + WS_F); (void)FB; \
    bf16* const QC = (bf16*)(ws + WS_QC); (void)QC; \
    bf16* const OC = (bf16*)(ws + WS_OC); (void)OC; \
    bf16* const PO = (bf16*)(ws + WS_PO); (void)PO; \
    float* const PML = (float*)(ws + WS_PML); (void)PML; \
    unsigned* const LIST = (unsigned*)(ws + WS_LIST); (void)LIST; \
    do {} while (0)
    const float SC = 0.08838834764831845f * LOG2E;
#ifndef DBG
#define DBG 0
#endif
#ifndef REP_MASK
#define REP_MASK 0
#endif
#ifndef PH_MASK
#define PH_MASK 0x7fff
#endif
#define IN(k) (((PH_MASK >> (k)) & 1) && lo <= (k) && (k) < hiP)
#define SEAM2(k, kn) do { if (IN(k) && IN(kn)) { const int lane_ = (int)__builtin_amdgcn_mbcnt_hi(~0u, __builtin_amdgcn_mbcnt_lo(~0u, 0u)); \
        XcdBarrier b_; b_.bar = (unsigned*)(LDP(21) + WS_CTL) + CW_BAR; b_.x = xb_xcc_id(); b_.st = (volatile LAS unsigned*)(lds + ST_OFF); xcd_barrier(b_, wave * 64 + lane_); } } while (0)
#define SEAM(k) SEAM2(k, (k) + 1)
#define GRID_BAR() do { const int lane_ = (int)__builtin_amdgcn_mbcnt_hi(~0u, __builtin_amdgcn_mbcnt_lo(~0u, 0u)); \
        XcdBarrier b_; b_.bar = (unsigned*)(LDP(21) + WS_CTL) + CW_BAR; b_.x = xb_xcc_id(); b_.st = (volatile LAS unsigned*)(lds + ST_OFF); xcd_barrier(b_, wave * 64 + lane_); } while (0)

    for (int rep_ = 0; rep_ < (IN(0) ? 1 + ((REP_MASK >> 0) & 1) : 0); ++rep_) { DECL_PTRS;
        LAS float* scr = (LAS float*)(lds + wave * 16384);
        const int gw = blk * 8 + wave, NGW = G * 8;
        constexpr int I_IN = (DM / 64) * (INW / 32), I_OUT = (DM / 64) * (DM / 32), I_X = (DM / 64) * (XW / 32), I_O = (XW / 64) * (DM / 32), I_1 = (DM / 64) * (FF / 32), I_2 = (FF / 64) * (DM / 32);
        constexpr int NITEMS = I_IN + I_OUT + 3 * I_X + I_O + I_1 + I_2;
        const bool early = (G > 16) && (hiP - lo > 1);
        for (int it = gw; it < 2 * I_X; it += NGW) { if (it < I_X) p0_transpose_item(wk_c, DM, XW, WKV_T, 0, scr, it, lane); else p0_transpose_item(wv_c, DM, XW, WKV_T, XW, scr, it - I_X, lane); }
        for (int mrow = gw; mrow < NB * NMEM; mrow += NGW) rms_row_bf16(mem + (size_t)mrow * DM, g_mem, MN + (size_t)mrow * DM, lane);
        for (int i = blk * 512 + tid; i < NH * 2048; i += G * 512) {
            const int hh = i >> 11, d = i & 2047; int bucket = d;
            if (d >= 16) { const int lg = 16 + (int)(logf((float)d / 16.0f) / 4.852030263919617f * 16.0f); bucket = lg < 31 ? lg : 31; }
            TB[i] = rel_bias[bucket * NH + hh] * LOG2E;
        }
        if (early) { GRID_BAR(); }
        if (early && blk < 8) {
            pg8::Gemm g{MN, WKV_T, NB * NMEM, 2 * XW, DM}; pg8::StaticOrder So; So.init(NB * NMEM, 2 * XW, 8, blk);
            pg8::EpiBf16X<0> E{KC, XW, XW, (size_t)NB * NMEM * XW, 1, VCT, NMEM, XH, nullptr};
            pg8::gemm_phase<pg8::EpiBf16X<0>, pg8::StaticOrder, true, true>(lds, g, So, E, tid);
        } else {
        const int nb0 = early ? 8 : 0, gwb = (blk - nb0) * 8 + wave, NGWB = (G - nb0) * 8;
        constexpr int NREST = I_IN + I_OUT + I_X + I_O + I_1 + I_2;
        for (int it = gwb; it < NREST; it += NGWB) {
            int r = it;
            if (r < I_IN) { p0_transpose_item(w_in, DM, INW, WIN_T, 0, scr, r, lane); continue; } r -= I_IN;
            if (r < I_OUT) { p0_transpose_item(w_out, DM, DM, WOUT_T, 0, scr, r, lane); continue; } r -= I_OUT;
            if (r < I_X) { p0_transpose_item(wq_c, DM, XW, WQ_T, 0, scr, r, lane, g_cross); continue; } r -= I_X;
            if (r < I_O) { p0_transpose_item(wo_c, XW, DM, WO_T, 0, scr, r, lane); continue; } r -= I_O;
            if (r < I_1) { p0_transpose_item(w1, DM, FF, W1_T, 0, scr, r, lane, g_mlp); continue; } r -= I_1;
            p0_transpose_item(w2, FF, DM, W2_T, 0, scr, r, lane);
        }
        for (int mrow = gwb; mrow < T; mrow += 2 * NGWB) {
            const int r2 = mrow + NGWB;
            const f32x4* xa = (const f32x4*)(x + (size_t)mrow * DM) + lane; const f32x4* xb = (const f32x4*)(x + (size_t)(r2 < T ? r2 : mrow) * DM) + lane;
            f32x4 va[8], vb[8]; float sa = 0.f, sb = 0.f;
#pragma unroll
            for (int jj = 0; jj < 8; ++jj) { va[jj] = xa[64 * jj]; vb[jj] = xb[64 * jj]; }
#pragma unroll
            for (int jj = 0; jj < 8; ++jj) { sa += (va[jj].x * va[jj].x + va[jj].y * va[jj].y) + (va[jj].z * va[jj].z + va[jj].w * va[jj].w); sb += (vb[jj].x * vb[jj].x + vb[jj].y * vb[jj].y) + (vb[jj].z * vb[jj].z + vb[jj].w * vb[jj].w); }
            const float ra = 1.0f / sqrtf(wave_sum(sa) * (1.0f / DM) + EPS), rb = 1.0f / sqrtf(wave_sum(sb) * (1.0f / DM) + EPS);
            const f32x4* gr = (const f32x4*)g_mix + lane; v2u* oa = (v2u*)(NBUF + (size_t)mrow * DM) + lane; v2u* ob = (v2u*)(NBUF + (size_t)(r2 < T ? r2 : mrow) * DM) + lane;
#pragma unroll
            for (int jj = 0; jj < 8; ++jj) { const f32x4 gv = gr[64 * jj]; v2u w; w.x = pk2(va[jj].x * ra * gv.x, va[jj].y * ra * gv.y); w.y = pk2(va[jj].z * ra * gv.z, va[jj].w * ra * gv.w); oa[64 * jj] = w;
                if (r2 < T) { v2u w2; w2.x = pk2(vb[jj].x * rb * gv.x, vb[jj].y * rb * gv.y); w2.y = pk2(vb[jj].z * rb * gv.z, vb[jj].w * rb * gv.w); ob[64 * jj] = w2; } }
        }
        }
        __syncthreads();
    }
    SEAM(0);

    for (int rep_ = 0; rep_ < (IN(1) ? 1 + ((REP_MASK >> 1) & 1) : 0); ++rep_) { DECL_PTRS;
        { pg8::Gemm g{NBUF, WIN_T, T, INW, DM}; pg8::StaticOrder So; So.init(T, INW, G, blk);
          pg8::EpiBf16X<0> E{Q, AW, AW, (size_t)T * AW, 2, VT, S, NH, nullptr};
          pg8::gemm_phase<pg8::EpiBf16X<0>, pg8::StaticOrder, true, true>(lds, g, So, E, tid); }
        if (!((G > 16) && (hiP - lo > 1)))
        { pg8::Gemm g{MN, WKV_T, NB * NMEM, 2 * XW, DM}; pg8::StaticOrder So; So.init(NB * NMEM, 2 * XW, G, blk);
          pg8::EpiBf16X<0> E{KC, XW, XW, (size_t)NB * NMEM * XW, 1, VCT, NMEM, XH, nullptr};
          pg8::gemm_phase<pg8::EpiBf16X<0>, pg8::StaticOrder, true, true>(lds, g, So, E, tid); }
    }
    SEAM(1);

#if DBG == 9
    { DECL_PTRS; for (size_t i = (size_t)blk * 512 + tid; i < (size_t)T * DM; i += (size_t)G * 512) { out[i] = i < 262144 ? __uint_as_float(((unsigned)KC[i] << 16)) : (i < 524288 ? __uint_as_float(((unsigned)VCT[i - 262144] << 16)) : 0.f); } return; }
#endif
#if DBG == 1
    { DECL_PTRS; for (size_t i = (size_t)blk * 512 + tid; i < (size_t)T * DM; i += (size_t)G * 512) { const size_t t = i >> 11, c = i & 2047, e = t * 1024 + (c & 1023);
        const unsigned short v = c < 1024 ? (unsigned short)(Q[e] ^ UV[e]) : (unsigned short)(K[e] ^ UG[e] ^ VT[e]); out[i] = __uint_as_float(((unsigned)v << 16)) ; } return; }
#endif
    for (int rep_ = 0; rep_ < (IN(2) ? 1 + ((REP_MASK >> 2) & 1) : 0); ++rep_) { DECL_PTRS;
        for (int it = blk; it < 256; it += G) {
            const int b = it >> 7, j = (it >> 1) & 63, chh = it & 1, cp = tid & 255, rh = tid >> 8;
            const bf16* kp = K + (size_t)(b * S + j * 256 + rh * 128) * AW + chh * 512 + 2 * cp;
            float s0 = 0.f, s1 = 0.f;
#pragma unroll 8
            for (int r = 0; r < 128; ++r) { const unsigned w = *(const unsigned*)(kp + (size_t)r * AW); s0 += bf_lo(w); s1 += bf_hi(w); }
            LAS f32x2* red = (LAS f32x2*)lds;
            if (rh == 1) red[cp] = (f32x2){s0, s1};
            __syncthreads();
            if (rh == 0) { const f32x2 o = red[cp]; const int col = chh * 512 + 2 * cp, hh = col >> 7, d = col & 127;
                *(f32x2*)(KBAR + ((size_t)((b * NH + hh) * NBLK + j)) * HD + d) = (f32x2){(s0 + o.x) * (1.0f / 256.0f), (s1 + o.y) * (1.0f / 256.0f)}; }
            __syncthreads();
        }
        for (int seg = blk; seg < T / 128; seg += G) {
            const int t0 = seg * 128, c0 = 2 * tid;
            float w0[CONVK], w1r[CONVK];
#pragma unroll
            for (int k = 0; k < CONVK; ++k) { const f32x2 wv = *(const f32x2*)(conv_w + k * CC + c0); w0[k] = wv.x; w1r[k] = wv.y; }
            const f32x2 cb = *(const f32x2*)(conv_b + c0), lg = *(const f32x2*)(ln_g + c0), lb = *(const f32x2*)(ln_b + c0);
            float r0[32], r1[32];
#pragma unroll
            for (int i = 0; i < 32; ++i) { r0[i] = 0.f; r1[i] = 0.f; }
            LAS f32x2* red = (LAS f32x2*)(lds + RED_OFF);
#pragma unroll 1
            for (int ch = -1; ch < 4; ++ch) {
                const int tb0 = t0 + ch * 32;
                const bool zero = (ch < 0) && ((t0 & (S - 1)) == 0);
#pragma unroll
                for (int hf = 0; hf < 2; ++hf) {
                    float y0[16], y1[16];
#pragma unroll
                    for (int ii = 0; ii < 16; ++ii) {
                        const int i = hf * 16 + ii;
                        float h0 = 0.f, h1 = 0.f;
                        if (!zero) { const size_t off = (size_t)(tb0 + i) * CC + c0; const unsigned vv = *(const unsigned*)(UV + off), gg = *(const unsigned*)(UG + off);
                            h0 = bf_lo(vv) * sigmoidf_(bf_lo(gg)); h1 = bf_hi(vv) * sigmoidf_(bf_hi(gg)); }
                        r0[i] = h0; r1[i] = h1;
                        float a0 = cb.x, a1 = cb.y;
                        if (ch >= 0) {
#pragma unroll
                            for (int k = 0; k < CONVK; ++k) { a0 += r0[(i - 30 + k) & 31] * w0[k]; a1 += r1[(i - 30 + k) & 31] * w1r[k]; }
                        }
                        y0[ii] = a0; y1[ii] = a1;
                    }
                    if (ch >= 0) {
#pragma unroll
                        for (int ii = 0; ii < 16; ++ii) { const float s1 = wave_sum(y0[ii] + y1[ii]), s2 = wave_sum(y0[ii] * y0[ii] + y1[ii] * y1[ii]); if (lane == 0) red[ii * 8 + wave] = (f32x2){s1, s2}; }
                        __syncthreads();
#pragma unroll
                        for (int ii = 0; ii < 16; ++ii) {
                            float s1 = 0.f, s2 = 0.f;
#pragma unroll
                            for (int w = 0; w < 8; ++w) { const f32x2 p = red[ii * 8 + w]; s1 += p.x; s2 += p.y; }
                            const float mean = s1 * (1.0f / CC), var = fmaxf(s2 * (1.0f / CC) - mean * mean, 0.f), rstd = 1.0f / sqrtf(var + EPS);
                            float o0 = (y0[ii] - mean) * rstd * lg.x + lb.x, o1 = (y1[ii] - mean) * rstd * lg.y + lb.y;
                            o0 = o0 * sigmoidf_(o0); o1 = o1 * sigmoidf_(o1);
                            *(unsigned*)(AC + (size_t)(tb0 + hf * 16 + ii) * DM + AW + c0) = pk2(o0, o1);
                        }
                        __syncthreads();
                    }
                }
            }
        }
    }
    SEAM(2);

    for (int rep_ = 0; rep_ < (IN(3) ? 1 : 0); ++rep_) { DECL_PTRS;
        constexpr int KH_OFF = 0, KL_OFF = 64 * KROW;
        for (int it = blk; it < NB * NH * NBLK; it += G) {
            const int bh = it >> 6, own = it & 63, b = bh >> 3, hh = bh & 7;
            if (own == 0) continue;
            f32x2 kvv[8];
#pragma unroll
            for (int i = 0; i < 8; ++i) { const int p2 = tid + 512 * i; kvv[i] = *(const f32x2*)(KBAR + (size_t)bh * NBLK * HD + 2 * p2); }
#pragma unroll
            for (int i = 0; i < 8; ++i) { const int p2 = tid + 512 * i, jr = p2 >> 6, d = (p2 & 63) * 2; const f32x2 kv = kvv[i];
                const unsigned hw = pk2s(kv.x, kv.y); const unsigned lw = pk2s(kv.x - bf_lo(hw), kv.y - bf_hi(hw));
                *(LAS unsigned*)(lds + KH_OFF + jr * KROW + d * 2) = hw; *(LAS unsigned*)(lds + KL_OFF + jr * KROW + d * 2) = lw; }
            const int ql = own * 256 + wave * 32 + l31;
            bf16x8 qf[8]; load_q(qf, Q + (size_t)(b * S + ql) * AW + hh * HD, hi);
            __syncthreads();
            f32x16 g0, g1;
#pragma unroll
            for (int r = 0; r < 16; ++r) { g0[r] = 0.f; g1[r] = 0.f; }
            const LAS unsigned char* kp = lds + l31 * KROW + 16 * hi;
#pragma unroll
            for (int ks = 0; ks < 8; ++ks) {
                g0 = __builtin_amdgcn_mfma_f32_32x32x16_bf16(*(const LAS bf16x8*)(kp + KH_OFF + 32 * ks), qf[ks], g0, 0, 0, 0);
                g0 = __builtin_amdgcn_mfma_f32_32x32x16_bf16(*(const LAS bf16x8*)(kp + KL_OFF + 32 * ks), qf[ks], g0, 0, 0, 0);
            }
            if (own > 32) {
#pragma unroll
                for (int ks = 0; ks < 8; ++ks) {
                    g1 = __builtin_amdgcn_mfma_f32_32x32x16_bf16(*(const LAS bf16x8*)(kp + KH_OFF + 32 * KROW + 32 * ks), qf[ks], g1, 0, 0, 0);
                    g1 = __builtin_amdgcn_mfma_f32_32x32x16_bf16(*(const LAS bf16x8*)(kp + KL_OFF + 32 * KROW + 32 * ks), qf[ks], g1, 0, 0, 0);
                }
            }
            float v0 = -INFINITY, v1 = -INFINITY, v2 = -INFINITY; int i0 = 64, i1 = 64, i2 = 64;
#define TOP3_INS(val, idx) do { const float dv_ = (val); const int di_ = (idx); if (di_ < own && dv_ > v2) { if (dv_ > v1) { v2 = v1; i2 = i1; if (dv_ > v0) { v1 = v0; i1 = i0; v0 = dv_; i0 = di_; } else { v1 = dv_; i1 = di_; } } else { v2 = dv_; i2 = di_; } } } while (0)
#pragma unroll
            for (int r = 0; r < 16; ++r) TOP3_INS(g0[r], crow(r, hi));
            if (own > 32) {
#pragma unroll
                for (int r = 0; r < 16; ++r) TOP3_INS(g1[r], 32 + crow(r, hi));
            }
            const float pv0 = __shfl_xor(v0, 32), pv1 = __shfl_xor(v1, 32), pv2 = __shfl_xor(v2, 32); const int pi0 = __shfl_xor(i0, 32), pi1 = __shfl_xor(i1, 32), pi2 = __shfl_xor(i2, 32);
#define TOP3_MRG(val, idx) do { const float dv_ = (val); const int di_ = (idx); if (di_ < own) { \
                if (dv_ > v2 || (dv_ == v2 && di_ < i2)) { if (dv_ > v1 || (dv_ == v1 && di_ < i1)) { v2 = v1; i2 = i1; if (dv_ > v0 || (dv_ == v0 && di_ < i0)) { v1 = v0; i1 = i0; v0 = dv_; i0 = di_; } else { v1 = dv_; i1 = di_; } } else { v2 = dv_; i2 = di_; } } } } while (0)
            TOP3_MRG(pv0, pi0); TOP3_MRG(pv1, pi1); TOP3_MRG(pv2, pi2);
            const int nsel = own < 3 ? own : 3;
            LAS unsigned char* sel = lds + 2 * 64 * KROW;
            if (hi == 0) { const int qi = wave * 32 + l31; sel[qi] = (unsigned char)(nsel > 0 ? i0 : 255); sel[256 + qi] = (unsigned char)(nsel > 1 ? i1 : 255); sel[512 + qi] = (unsigned char)(nsel > 2 ? i2 : 255); }
            __syncthreads();
            for (int jl = wave; jl < own; jl += 8) {
                unsigned long long bm[12]; bool mt[12]; unsigned total = 0u;
#pragma unroll
                for (int sk = 0; sk < 12; ++sk) { mt[sk] = sel[(sk >> 2) * 256 + lane + 64 * (sk & 3)] == (unsigned char)jl; bm[sk] = __ballot(mt[sk]); total += (unsigned)__popcll(bm[sk]); }
                if (total == 0u) continue;
                unsigned basep = 0u; if (lane == 0) basep = atomicAdd(&CNT[bh * NBLK + jl], total);
                unsigned run = (unsigned)__builtin_amdgcn_readfirstlane((int)basep);
                const unsigned long long lt = (1ull << lane) - 1ull;
#pragma unroll
                for (int sk = 0; sk < 12; ++sk) {
                    if (mt[sk]) __hip_atomic_store(&LIST[(size_t)(bh * NBLK + jl) * S + run + (unsigned)__popcll(bm[sk] & lt)], (unsigned)((own * 256 + lane + 64 * (sk & 3)) | ((sk >> 2) << 14)), __ATOMIC_RELAXED, __HIP_MEMORY_SCOPE_AGENT);
                    run += (unsigned)__popcll(bm[sk]);
                }
            }
            __syncthreads();
        }
    }
    SEAM(3);

    for (int rep_ = 0; rep_ < (IN(4) ? 1 + ((REP_MASK >> 4) & 1) : 0); ++rep_) { DECL_PTRS;
        LAS unsigned* pf = (LAS unsigned*)(lds + CNT_OFF);
        LAS unsigned* wtot = (LAS unsigned*)(lds + RED_OFF);
        {
            const unsigned c0 = __hip_atomic_load(&CNT[2 * tid], __ATOMIC_RELAXED, __HIP_MEMORY_SCOPE_AGENT), c1 = __hip_atomic_load(&CNT[2 * tid + 1], __ATOMIC_RELAXED, __HIP_MEMORY_SCOPE_AGENT);
            const unsigned ua = (c0 + 31u) >> 5, ub = (c1 + 31u) >> 5, us = ua + ub;
            unsigned v = us;
#pragma unroll
            for (int o = 1; o < 64; o <<= 1) { const unsigned u = __shfl_up(v, o); if (lane >= o) v += u; }
            if (lane == 63) wtot[wave] = v;
            __syncthreads();
            unsigned off = 0u;
            for (int w = 0; w < wave; ++w) off += wtot[w];
            const unsigned excl = off + v - us;
            pf[2 * tid] = excl + ua; pf[2 * tid + 1] = excl + us;
            __syncthreads();
        }
        const unsigned total = pf[NB * NH * NBLK - 1];
        const unsigned glo = (unsigned)(((unsigned long long)total * (unsigned)blk) / (unsigned)G), ghi = (unsigned)(((unsigned long long)total * (unsigned)(blk + 1)) / (unsigned)G);
        int lo_ = 0, hi_ = NB * NH * NBLK - 1;
        while (lo_ < hi_) { const int mid = (lo_ + hi_) >> 1; if (pf[mid] > glo) hi_ = mid; else lo_ = mid + 1; }
        int bhj = __builtin_amdgcn_readfirstlane(lo_); unsigned g = glo;
        while (g < ghi) {
            const unsigned base = (unsigned)__builtin_amdgcn_readfirstlane((int)(bhj ? pf[bhj - 1] : 0u)), lend = (unsigned)__builtin_amdgcn_readfirstlane((int)pf[bhj]);
            const unsigned end = lend < ghi ? lend : ghi;
            const int cnt = __builtin_amdgcn_readfirstlane((int)__hip_atomic_load(&CNT[bhj], __ATOMIC_RELAXED, __HIP_MEMORY_SCOPE_AGENT));
            const int bh = bhj >> 6, j = bhj & 63, b = bh >> 3, hh = bh & 7;
            attn_stage(lds, K + (size_t)(b * S + j * 256) * AW + hh * HD, AW, VT + (size_t)(bh * HD) * S + j * 256, S, TB + hh * 2048, tid);
            __syncthreads();
            const float cbias = ((const LAS float*)(lds + TB_OFF))[2047];
            unsigned gg = g + (unsigned)wave;
            unsigned e1 = (unsigned)(S - 1), e2 = (unsigned)(S - 1); bool v1 = false, v2 = false;
            bf16x8 qn[8];
            if (gg < end) { const int ix = (int)(gg - base) * 32 + l31; v1 = ix < cnt; if (v1) e1 = __hip_atomic_load(&LIST[(size_t)bhj * S + ix], __ATOMIC_RELAXED, __HIP_MEMORY_SCOPE_AGENT); }
            if (gg + 8u < end) { const int ix = (int)(gg + 8u - base) * 32 + l31; v2 = ix < cnt; if (v2) e2 = __hip_atomic_load(&LIST[(size_t)bhj * S + ix], __ATOMIC_RELAXED, __HIP_MEMORY_SCOPE_AGENT); }
            if (gg < end) load_q(qn, Q + (size_t)(b * S + (int)(e1 & 0x3fff)) * AW + hh * HD, hi);
            for (; gg < end; gg += 8u) {
                const unsigned e = e1; const bool valid = v1;
                bf16x8 qf[8];
#pragma unroll
                for (int ks = 0; ks < 8; ++ks) qf[ks] = qn[ks];
                e1 = e2; v1 = v2; e2 = (unsigned)(S - 1); v2 = false;
                if (gg + 16u < end) { const int ix = (int)(gg + 16u - base) * 32 + l31; v2 = ix < cnt; if (v2) e2 = __hip_atomic_load(&LIST[(size_t)bhj * S + ix], __ATOMIC_RELAXED, __HIP_MEMORY_SCOPE_AGENT); }
                if (gg + 8u < end) load_q(qn, Q + (size_t)(b * S + (int)(e1 & 0x3fff)) * AW + hh * HD, hi);
                const int ql = e & 0x3fff, slot = e >> 14, qrow = b * S + ql, qrel = ql - j * 256;
                const bool fast = __all(qrel - 255 >= 1512);
                f32x16 O[4]; float m, l;
                attn_core<0>(lds, qf, qrel, SC, 4, fast, cbias, O, m, l, lane);
                store_o16(PO + ((size_t)slot * T + qrow) * AW + hh * HD, O, 1.0f / l, hi, valid);
                if (valid) {
                    if (hi == 0) __hip_atomic_store((unsigned long long*)PML + ((size_t)(qrow * NH + hh) * 3 + slot), ((unsigned long long)__float_as_uint(l) << 32) | (unsigned long long)__float_as_uint(m), __ATOMIC_RELAXED, __HIP_MEMORY_SCOPE_AGENT);
                }
            }
            __syncthreads();
            g = end; ++bhj;
            while (bhj < NB * NH * NBLK && (unsigned)__builtin_amdgcn_readfirstlane((int)pf[bhj]) == lend) ++bhj;
        }
    }
    SEAM(4);

    for (int rep_ = 0; rep_ < (IN(5) ? 1 + ((REP_MASK >> 5) & 1) : 0); ++rep_) { DECL_PTRS;
        for (int it = blk; it < NB * NH * NBLK; it += G) {
            const int bh = it >> 6, j = it & 63, b = bh >> 3, hh = bh & 7;
            attn_stage(lds, K + (size_t)(b * S + j * 256) * AW + hh * HD, AW, VT + (size_t)(bh * HD) * S + j * 256, S, TB + hh * 2048, tid);
            __syncthreads();
            const int qrel = wave * 32 + l31, qrow = b * S + j * 256 + qrel;
            f32x16 O[4]; float m, l;
            bf16x8 qf[8]; load_q(qf, Q + (size_t)qrow * AW + hh * HD, hi);
            unsigned long long pw[3];
#pragma unroll
            for (int s = 0; s < 3; ++s) { pw[s] = 0ull; if (s < (j < 3 ? j : 3)) pw[s] = __hip_atomic_load((unsigned long long*)PML + ((size_t)(qrow * NH + hh) * 3 + s), __ATOMIC_RELAXED, __HIP_MEMORY_SCOPE_AGENT); }
            attn_core<1>(lds, qf, qrel, SC, (wave >> 1) + 1, false, 0.f, O, m, l, lane);
            const int nsel = j < 3 ? j : 3;
            float M = m, ms[3], lsv[3];
#pragma unroll
            for (int s = 0; s < 3; ++s) { ms[s] = -1e30f; lsv[s] = 0.f; if (s < nsel) { ms[s] = __uint_as_float((unsigned)pw[s]); lsv[s] = __uint_as_float((unsigned)(pw[s] >> 32)); M = fmaxf(M, ms[s]); } }
            const float wown = ex2(m - M); float den = l * wown, wsl[3];
#pragma unroll
            for (int s = 0; s < 3; ++s) { wsl[s] = lsv[s] * ex2(ms[s] - M); den += wsl[s]; }
            const float inv = 1.0f / den;
            bf16* op = AC + (size_t)qrow * DM + hh * HD + 4 * hi;
#pragma unroll
            for (int hf = 0; hf < 2; ++hf) {
                v2u pp[3][2][4];
#pragma unroll
                for (int s = 0; s < 3; ++s) if (s < nsel) {
#pragma unroll
                    for (int d2 = 0; d2 < 2; ++d2)
#pragma unroll
                        for (int g4 = 0; g4 < 4; ++g4) pp[s][d2][g4] = *(const v2u*)(PO + ((size_t)s * T + qrow) * AW + hh * HD + 4 * hi + 32 * (2 * hf + d2) + 8 * g4);
                }
#pragma unroll
                for (int d2 = 0; d2 < 2; ++d2)
#pragma unroll
                    for (int g4 = 0; g4 < 4; ++g4) { const int dt = 2 * hf + d2;
                        float o0 = O[dt][4 * g4] * wown, o1 = O[dt][4 * g4 + 1] * wown, o2 = O[dt][4 * g4 + 2] * wown, o3 = O[dt][4 * g4 + 3] * wown;
#pragma unroll
                        for (int s = 0; s < 3; ++s) if (s < nsel) { const v2u p = pp[s][d2][g4];
                            o0 += wsl[s] * bf_lo(p.x); o1 += wsl[s] * bf_hi(p.x); o2 += wsl[s] * bf_lo(p.y); o3 += wsl[s] * bf_hi(p.y); }
                        v2u w; w.x = pk2(o0 * inv, o1 * inv); w.y = pk2(o2 * inv, o3 * inv); *(v2u*)(op + 32 * dt + 8 * g4) = w;
                    }
            }
            __syncthreads();
        }
    }
    SEAM(5);

#if DBG == 2
    { DECL_PTRS; for (size_t i = (size_t)blk * 512 + tid; i < (size_t)T * DM; i += (size_t)G * 512) out[i] = __uint_as_float(((unsigned)AC[i] << 16)); return; }
#endif
    for (int rep_ = 0; rep_ < (IN(6) ? 1 + ((REP_MASK >> 6) & 1) : 0); ++rep_) { DECL_PTRS;
        pg8::Gemm g{AC, WOUT_T, T, DM, DM}; pg8::StaticOrder So; So.init(T, DM, G, blk);
        pg8::EpiResBf16Ssq<0> E{x, NBUF, DM, SSQ1, nullptr};
        pg8::gemm_phase<pg8::EpiResBf16Ssq<0>, pg8::StaticOrder, true, true>(lds, g, So, E, tid);
    }
    SEAM2(6, 8);
#if DBG == 3
    return;
#endif
    for (int rep_ = 0; rep_ < (IN(8) ? 1 + ((REP_MASK >> 8) & 1) : 0); ++rep_) { DECL_PTRS;
        pg8::Gemm g{NBUF, WQ_T, T, XW, DM}; pg8::StaticOrder So; So.init(T, XW, G, blk);
        pg8::EpiBf16X<0, 1> E{QC, XW, 0, 0, -1, nullptr, 1, 1, SSQ1};
        pg8::gemm_phase<pg8::EpiBf16X<0, 1>, pg8::StaticOrder, true, true>(lds, g, So, E, tid);
    }
    for (int rep_ = 0; rep_ < (IN(9) ? 1 + ((REP_MASK >> 9) & 1) : 0); ++rep_) { DECL_PTRS;
        asm volatile("s_waitcnt vmcnt(0)" ::: "memory"); __syncthreads();
        pg8::StaticOrder So8; So8.init(T, XW, G, blk); pg8::Unit u8;
        for (int ui = 0; So8.next(ui >> 1, u8); ++ui) {
            const int tl = u8.pm, hc = 2 * u8.pn + (ui & 1), b = tl / (S / 256);
            attn_stage(lds, KC + (size_t)(b * NMEM) * XW + hc * HD, XW, VCT + (size_t)((b * XH + hc) * HD) * NMEM, NMEM, nullptr, tid);
            __syncthreads();
            const int qrow = tl * 256 + wave * 32 + l31;
            f32x16 O[4]; float m, l;
            bf16x8 qf[8]; load_q(qf, QC + (size_t)qrow * XW + hc * HD, hi);
            attn_core<2>(lds, qf, 0, SC, 4, false, 0.f, O, m, l, lane);
            store_o16(OC + (size_t)qrow * XW + hc * HD, O, 1.0f / l, hi, true);
            __syncthreads();
        }
    }
    SEAM(9);
#if DBG == 10
    return;
#endif
#if DBG == 7
    { DECL_PTRS; for (size_t i = (size_t)blk * 512 + tid; i < (size_t)T * DM; i += (size_t)G * 512) { const size_t t = i >> 11, c = i & 2047; out[i] = c < 512 ? __uint_as_float(((unsigned)QC[t * 512 + c] << 16)) : 0.f; } return; }
#endif
#if DBG == 8
    { DECL_PTRS; for (size_t i = (size_t)blk * 512 + tid; i < (size_t)T * DM; i += (size_t)G * 512) { const size_t t = i >> 11, c = i & 2047; out[i] = c < 512 ? __uint_as_float(((unsigned)OC[t * 512 + c] << 16)) : 0.f; } return; }
#endif
#if DBG == 5
    { DECL_PTRS; for (size_t i = (size_t)blk * 512 + tid; i < (size_t)T * DM; i += (size_t)G * 512) { const size_t t = i >> 11, c = i & 2047; out[i] = c < 512 ? __uint_as_float(((unsigned)OC[t * 512 + c] << 16)) : (c < 1024 ? __uint_as_float(((unsigned)QC[t * 512 + c - 512] << 16)) : 0.f); } return; }
#endif
    for (int rep_ = 0; rep_ < (IN(10) ? 1 + ((REP_MASK >> 10) & 1) : 0); ++rep_) { DECL_PTRS;
        pg8::Gemm g{OC, WO_T, T, DM, XW}; pg8::StaticOrder So; So.init(T, DM, G, blk);
        pg8::EpiResBf16Ssq<1> E{NBUF, NBUF, DM, SSQ2, nullptr};
        pg8::gemm_phase<pg8::EpiResBf16Ssq<1>, pg8::StaticOrder, true, true>(lds, g, So, E, tid);
    }
    SEAM2(10, 12);
#if DBG == 4
    return;
#endif
    for (int rep_ = 0; rep_ < (IN(12) ? 1 + ((REP_MASK >> 12) & 1) : 0); ++rep_) { DECL_PTRS;
        pg8::Gemm g{NBUF, W1_T, T, FF, DM}; pg8::StaticOrder So; So.init(T, FF, G, blk);
        pg8::EpiBf16X<2, 0> E{FB, FF, 0, 0, -1, nullptr, 1, 1, nullptr};
        pg8::gemm_phase<pg8::EpiBf16X<2, 0>, pg8::StaticOrder, true, true>(lds, g, So, E, tid);
    }
    SEAM(12);
    for (int rep_ = 0; rep_ < (IN(13) ? 1 + ((REP_MASK >> 13) & 1) : 0); ++rep_) { DECL_PTRS;
        pg8::Gemm g{FB, W2_T, T, DM, FF}; pg8::StaticOrder So; So.init(T, DM, G, blk);
        pg8::EpiResBf16Ssq<1, 1> E{NBUF, NBUF, DM, SSQ3, SSQ2};
        pg8::gemm_phase<pg8::EpiResBf16Ssq<1, 1>, pg8::StaticOrder, true, true>(lds, g, So, E, tid);
    }
    SEAM(13);
    for (int rep_ = 0; rep_ < (IN(14) ? 1 : 0); ++rep_) { DECL_PTRS;
        const int gw = blk * 8 + wave, NGW = G * 8;
        f32x4 gv[8];
#pragma unroll
        for (int jj = 0; jj < 8; ++jj) gv[jj] = ((const f32x4*)g_final)[lane + 64 * jj];
        for (int mrow = gw; mrow < T; mrow += NGW) {
            const float rstd = 1.0f / sqrtf(SSQ3[mrow] * (1.0f / DM) + EPS);
            const v2u* hr = (const v2u*)(NBUF + (size_t)mrow * DM) + lane; f32x4* o = (f32x4*)(out + (size_t)mrow * DM) + lane;
            v2u hv[8];
#pragma unroll
            for (int jj = 0; jj < 8; ++jj) hv[jj] = hr[64 * jj];
#pragma unroll
            for (int jj = 0; jj < 8; ++jj) o[64 * jj] = (f32x4){bf_lo(hv[jj].x) * rstd * gv[jj].x, bf_hi(hv[jj].x) * rstd * gv[jj].y, bf_lo(hv[jj].y) * rstd * gv[jj].z, bf_hi(hv[jj].y) * rstd * gv[jj].w};
        }
    }
#undef IN
#undef SEAM
}

extern "C" void kernel_launch(void* const* d_in, const int* in_sizes, int n_in, void* d_out, int out_size, void* d_ws, size_t ws_size, hipStream_t stream) {
    static int grid = 0;
    if (grid == 0) {
        if (n_in != 20 || out_size != T * DM || ws_size < WS_END) { fprintf(stderr, "kernel_launch: unexpected sizes n_in %d out %d ws %zu\n", n_in, out_size, ws_size); grid = -1; return; }
        int dev = 0, cus = 0, per_cu = 0;
        (void)hipGetDevice(&dev); (void)hipDeviceGetAttribute(&cus, hipDeviceAttributeMultiprocessorCount, dev);
        (void)hipFuncSetAttribute((const void*)fwd, hipFuncAttributeMaxDynamicSharedMemorySize, LDS_BYTES);
        (void)hipOccupancyMaxActiveBlocksPerMultiprocessor(&per_cu, (const void*)fwd, 512, LDS_BYTES);
        if (per_cu < 1) { fprintf(stderr, "kernel_launch: occupancy query says %d blocks per CU\n", per_cu); per_cu = 1; }
        grid = cus;
        (void)hipGetLastError();
    }
    if (grid < 0) return;
    if (hipMemsetAsync((char*)d_ws + WS_CTL, 0, 1048576, stream) != hipSuccess) { fprintf(stderr, "kernel_launch: memset failed\n"); return; }
    Args a{};
    for (int i = 0; i < 20; ++i) a.in[i] = (const float*)d_in[i];
    a.out = (float*)d_out; a.ws = (unsigned char*)d_ws;
#if MK_PER_PHASE
    for (int p = 0; p < NPHASE; ++p) { if (p == 7 || p == 11) continue; a.ph_lo = p; a.ph_hi = p + 1; hipLaunchKernelGGL(fwd, dim3(grid), dim3(512), LDS_BYTES, stream, a); }
#else
    a.ph_lo = 0; a.ph_hi = NPHASE;
    void* args[] = {&a};
    hipError_t e = hipLaunchCooperativeKernel((const void*)fwd, dim3(grid), dim3(512), args, LDS_BYTES, stream);
    if (e != hipSuccess) fprintf(stderr, "kernel_launch: cooperative launch failed: %s (grid %d)\n", hipGetErrorString(e), grid);
#endif
}
```

```cpp
#include <hip/hip_runtime.h>
#include <cstdio>
#include <cstdint>
namespace pg8 {
#define PG8_LAS __attribute__((address_space(3)))
typedef unsigned short bf16_t;
typedef short bf16x8 __attribute__((ext_vector_type(8)));
typedef float f32x4 __attribute__((ext_vector_type(4)));
typedef unsigned u32x4 __attribute__((ext_vector_type(4)));
constexpr int BM = 256, BK = 64, HALF = 128, HTB = HALF * BK * 2  , STAGE_BYTES = 8 * HTB, NXCD = 8, WGM = 8;

__host__ __device__ __forceinline__ int lds_byte(int r, int c) { const int st = (r >> 4) * 2 + (c >> 5), rr = r & 15, cc = c & 31, ob = rr * 64 + cc * 2; return st * 1024 + (ob ^ (((ob >> 9) & 1) << 5)); }
__host__ __device__ __forceinline__ void stage_rc(int b, int& R, int& C) { const int st = b / 1024, sb = b % 1024, swz = sb ^ (((sb >> 9) & 1) << 5); R = (st >> 1) * 16 + swz / 64; C = (st & 1) * 32 + (swz % 64) / 2; }
__host__ __device__ __forceinline__ int perm32(int rho) { const int n = rho >> 4, i = rho & 15; return 8 * (i >> 2) + 4 * n + (i & 3); }

struct Unit { int pm, pn; };
struct Gemm { const bf16_t* A; const bf16_t* Bt; int M, N, K; };

struct StaticOrder {
    int nM, nN, nwg, G, c;
    __host__ __device__ void init(int M, int N, int G_, int c_) { nM = M / BM; nN = N / BM; nwg = nM * nN; G = G_; c = c_; }
    __host__ __device__ bool next(int i, Unit& u) const {
        const long L = (long)i * G + c; if (L >= nwg) return false;
        int wgid = (int)L; { const int q = nwg / NXCD, r = nwg % NXCD, xcd = wgid % NXCD, off = wgid / NXCD; wgid = (xcd < r ? xcd * (q + 1) : r * (q + 1) + (xcd - r) * q) + off; }
        const int nig = WGM * nN, gid = wgid / nig, fm = gid * WGM, gsz = (nM - fm) < WGM ? (nM - fm) : WGM;
        u.pm = fm + ((wgid % nig) % gsz); u.pn = (wgid % nig) / gsz; return true;
    }
    __device__ __forceinline__ void a_ready(const Unit&) const {}
    __device__ __forceinline__ void done(const Unit&) const {}
};

__device__ __forceinline__ unsigned cvt_pk_bf16(float lo, float hi) { unsigned r; asm volatile("v_cvt_pk_bf16_f32 %0, %1, %2" : "=v"(r) : "v"(lo), "v"(hi)); return r; }
typedef float f32x2 __attribute__((ext_vector_type(2)));
__device__ __forceinline__ f32x2 gelu_pk(f32x2 v) {
    const f32x2 av = __builtin_elementwise_abs(v), d = av * 0.2316418882f + 1.0f;
    f32x2 t; t.x = __builtin_amdgcn_rcpf(d.x); t.y = __builtin_amdgcn_rcpf(d.y);
    f32x2 q = t * 0.5307027145f + (-0.7265760135f); q = q * t + 0.7107068705f; q = q * t + (-0.142248368f); q = q * t + 0.127414796f; q = q * t;
    const f32x2 s = (v * v) * (-0.72134752044f);
    f32x2 e; e.x = __builtin_amdgcn_exp2f(s.x); e.y = __builtin_amdgcn_exp2f(s.y);
    const f32x2 m = v * (q * e), r = v - m;
    f32x2 o; o.x = v.x < 0.f ? m.x : r.x; o.y = v.y < 0.f ? m.y : r.y; return o;
}


__device__ __forceinline__ unsigned short bf16_1(float v) { return (unsigned short)(cvt_pk_bf16(v, v) & 0xffffu); }
template <int ACT  , int RS = 0  > struct EpiBf16X {
    static constexpr bool PERM = true, AFTER_DRAIN = false;
    bf16_t* O; int ldc; int split_cols; size_t split_stride; int tr_tile; bf16_t* OT; int seqlen; int nheads; const float* ssq;
    __device__ __forceinline__ void operator()(const f32x4 (&acc)[2][2][4][2], const Unit& u, int wr, int wc, int fr, int fq) const {
        const int row0 = u.pm * BM + wr * 64 + fr; int colt = u.pn * BM; bf16_t* base = O; int t = 0;
        if (split_cols) { t = colt / split_cols; base += (size_t)t * split_stride; colt -= t * split_cols; }
        const int col0 = colt + wc * 32 + 8 * fq;
        if (RS == 0 && t == tr_tile) {
#pragma unroll
            for (int ai = 0; ai < 2; ++ai)
#pragma unroll
                for (int m = 0; m < 4; ++m) { const int row = row0 + ai * HALF + m * 16; const int b = row / seqlen, s = row - b * seqlen;
#pragma unroll
                    for (int bj = 0; bj < 2; ++bj)
#pragma unroll
                        for (int n = 0; n < 2; ++n)
#pragma unroll
                            for (int j = 0; j < 4; ++j) { const int col = col0 + bj * HALF + 4 * n + j; const int hh = col >> 7, d = col & 127;
                                OT[((size_t)(b * nheads + hh) * 128 + d) * (size_t)seqlen + s] = bf16_1(acc[ai][bj][m][n][j]); } }
        } else {
#pragma unroll
            for (int ai = 0; ai < 2; ++ai)
#pragma unroll
                for (int m = 0; m < 4; ++m) { bf16_t* rowp = base + (size_t)(row0 + ai * HALF + m * 16) * ldc + col0;
                    float rsc = 1.f;
                    if (RS) { const float r = 1.0f / sqrtf(ssq[row0 + ai * HALF + m * 16] * (1.0f / 2048.0f) + 1e-6f); rsc = (ACT == 2) ? r * r : r; }
#pragma unroll
                    for (int bj = 0; bj < 2; ++bj) { f32x4 v0 = acc[ai][bj][m][0], v1 = acc[ai][bj][m][1];
                        if (RS && ACT != 2) { v0 = v0 * rsc; v1 = v1 * rsc; }
                        if (ACT == 2) {
#pragma unroll
                            for (int j = 0; j < 4; ++j) { float a = v0[j] > 0.f ? v0[j] : 0.f; v0[j] = a * a * rsc; float b = v1[j] > 0.f ? v1[j] : 0.f; v1[j] = b * b * rsc; } }
                        u32x4 w; w.x = cvt_pk_bf16(v0[0], v0[1]); w.y = cvt_pk_bf16(v0[2], v0[3]); w.z = cvt_pk_bf16(v1[0], v1[1]); w.w = cvt_pk_bf16(v1[2], v1[3]);
                        *(u32x4*)(rowp + bj * HALF) = w; } }
        }
    }
};
struct EpiResNorm {
    static constexpr bool PERM = false, AFTER_DRAIN = false;
    const float* base; float* out; int ldc; const float* gain; bf16_t* HG; float* ssq;
    __device__ __forceinline__ void operator()(const f32x4 (&acc)[2][2][4][2], const Unit& u, int wr, int wc, int fr, int fq) const {
        const int row0 = u.pm * BM + wr * 64 + fr, col0 = u.pn * BM + wc * 32 + 4 * fq;
        f32x4 gv[2][2];
#pragma unroll
        for (int bj = 0; bj < 2; ++bj)
#pragma unroll
            for (int n = 0; n < 2; ++n) gv[bj][n] = *(const f32x4*)(gain + col0 + bj * HALF + n * 16);
#pragma unroll
        for (int ai = 0; ai < 2; ++ai)
#pragma unroll
            for (int m = 0; m < 4; ++m) { const int row = row0 + ai * HALF + m * 16; const size_t off = (size_t)row * ldc + col0; float sq = 0.f;
#pragma unroll
                for (int bj = 0; bj < 2; ++bj)
#pragma unroll
                    for (int n = 0; n < 2; ++n) { const f32x4 h = *(const f32x4*)(base + off + bj * HALF + n * 16) + acc[ai][bj][m][n]; *(f32x4*)(out + off + bj * HALF + n * 16) = h;
                        sq += (h[0] * h[0] + h[1] * h[1]) + (h[2] * h[2] + h[3] * h[3]);
                        const f32x4 hg = h * gv[bj][n]; unsigned w0 = cvt_pk_bf16(hg[0], hg[1]), w1 = cvt_pk_bf16(hg[2], hg[3]);
                        typedef unsigned u32x2v __attribute__((ext_vector_type(2))); u32x2v w; w.x = w0; w.y = w1; *(u32x2v*)(HG + off + bj * HALF + n * 16) = w; }
                sq += __shfl_xor(sq, 16); sq += __shfl_xor(sq, 32);
                if (fq == 0) unsafeAtomicAdd(ssq + row, sq); }
    }
};
template <int B16  , int RS2 = 0  > struct EpiResBf16Ssq {
    static constexpr bool PERM = true, AFTER_DRAIN = false;
    const void* base; bf16_t* HB; int ldc; float* ssq; const float* ssq_in;
    __device__ __forceinline__ void operator()(const f32x4 (&acc)[2][2][4][2], const Unit& u, int wr, int wc, int fr, int fq) const {
        const int row0 = u.pm * BM + wr * 64 + fr, col0 = u.pn * BM + wc * 32 + 8 * fq;
        float rq[2][4], sqv[2][4];
#pragma unroll
        for (int ai = 0; ai < 2; ++ai)
#pragma unroll
            for (int m = 0; m < 4; ++m) rq[ai][m] = RS2 ? ssq_in[row0 + ai * HALF + m * 16] : 0.f;
#pragma unroll
        for (int ai = 0; ai < 2; ++ai)
#pragma unroll
            for (int m = 0; m < 4; ++m) { const int row = row0 + ai * HALF + m * 16; const size_t off = (size_t)row * ldc + col0; float sq = 0.f;
                float rs2 = 1.f; if (RS2) rs2 = 1.0f / (rq[ai][m] * (1.0f / 2048.0f) + 1e-6f);
#pragma unroll
                for (int bj = 0; bj < 2; ++bj) { f32x4 b0, b1;
                    if (B16) { const u32x4 bw = *(const u32x4*)((const bf16_t*)base + off + bj * HALF);
                        b0 = (f32x4){__uint_as_float(bw.x << 16), __uint_as_float(bw.x & 0xffff0000u), __uint_as_float(bw.y << 16), __uint_as_float(bw.y & 0xffff0000u)};
                        b1 = (f32x4){__uint_as_float(bw.z << 16), __uint_as_float(bw.z & 0xffff0000u), __uint_as_float(bw.w << 16), __uint_as_float(bw.w & 0xffff0000u)}; }
                    else { b0 = *(const f32x4*)((const float*)base + off + bj * HALF); b1 = *(const f32x4*)((const float*)base + off + bj * HALF + 4); }
                    const f32x4 h0 = RS2 ? b0 + acc[ai][bj][m][0] * rs2 : b0 + acc[ai][bj][m][0], h1 = RS2 ? b1 + acc[ai][bj][m][1] * rs2 : b1 + acc[ai][bj][m][1];
                    sq += ((h0[0] * h0[0] + h0[1] * h0[1]) + (h0[2] * h0[2] + h0[3] * h0[3])) + ((h1[0] * h1[0] + h1[1] * h1[1]) + (h1[2] * h1[2] + h1[3] * h1[3]));
                    u32x4 w; w.x = cvt_pk_bf16(h0[0], h0[1]); w.y = cvt_pk_bf16(h0[2], h0[3]); w.z = cvt_pk_bf16(h1[0], h1[1]); w.w = cvt_pk_bf16(h1[2], h1[3]);
                    *(u32x4*)(HB + off + bj * HALF) = w; }
                sqv[ai][m] = sq; }
#pragma unroll
        for (int ai = 0; ai < 2; ++ai)
#pragma unroll
            for (int m = 0; m < 4; ++m) { float sq = sqv[ai][m]; sq += __shfl_xor(sq, 16); sq += __shfl_xor(sq, 32); if (fq == 0) unsafeAtomicAdd(ssq + row0 + ai * HALF + m * 16, sq); }
    }
};
struct EpiResF32 {
    static constexpr bool PERM = false, AFTER_DRAIN = false;
    const float* base; float* out; int ldc;
    __device__ __forceinline__ void operator()(const f32x4 (&acc)[2][2][4][2], const Unit& u, int wr, int wc, int fr, int fq) const {
        const int row0 = u.pm * BM + wr * 64 + fr, col0 = u.pn * BM + wc * 32 + 4 * fq;
#pragma unroll
        for (int ai = 0; ai < 2; ++ai)
#pragma unroll
            for (int m = 0; m < 4; ++m) { const size_t off = (size_t)(row0 + ai * HALF + m * 16) * ldc + col0;
#pragma unroll
                for (int bj = 0; bj < 2; ++bj)
#pragma unroll
                    for (int n = 0; n < 2; ++n) { const f32x4 bs = *(const f32x4*)(base + off + bj * HALF + n * 16); *(f32x4*)(out + off + bj * HALF + n * 16) = bs + acc[ai][bj][m][n]; } }
    }
};

template <class Epi, class Sched, bool ALIGN_EPI = false, bool SP2 = false>
__device__ __forceinline__ void gemm_phase(PG8_LAS unsigned char* lds, const Gemm g, const Sched& S, const Epi& E, const int tid) {
    const int wid = __builtin_amdgcn_readfirstlane(tid >> 6), lane = tid & 63, wr = wid >> 2, wc = wid & 3, fr = lane & 15, fq = lane >> 4;
    const int K = g.K, nt = K / BK;
    unsigned voffA[2], voffB[2];
#pragma unroll
    for (int i = 0; i < 2; ++i) { int R, C; stage_rc(tid * 16 + i * 8192, R, C); const int Rb = Epi::PERM ? ((R & ~31) + perm32(R & 31)) : R;
        voffA[i] = (unsigned)(R * K + C) * 2u; voffB[i] = (unsigned)(Rb * K + C) * 2u; }
    const size_t kstep = (size_t)(BK * 2);
    const size_t hstep = (size_t)HALF * K * 2;
    const size_t tstep = 2 * hstep;
    const unsigned ldsw = (unsigned)wid * 1024u;
    const int aoff = lds_byte(wr * 64 + fr, fq * 8), boff = lds_byte(wc * 32 + fr, fq * 8);
#define PG8_SA(b, h) (((b) * 2 + (h)) * HTB)
#define PG8_SB(b, h) ((4 + (b) * 2 + (h)) * HTB)
#define PG8_STAGE(bufoff, gbase, voff) do { _Pragma("unroll") for (int _i = 0; _i < 2; ++_i) \
        __builtin_amdgcn_global_load_lds((const unsigned*)((const char*)(gbase) + (voff)[_i]), (PG8_LAS unsigned*)(lds + (bufoff) + ldsw + _i * 8192), 16, 0, 0); } while (0)
#define PG8_LDA(dst, b, h) do { _Pragma("unroll") for (int m = 0; m < 4; ++m) _Pragma("unroll") for (int k = 0; k < 2; ++k) dst[m][k] = *(const PG8_LAS bf16x8*)(lds + PG8_SA(b, h) + aoff + m * 2048 + k * 1024); } while (0)
#define PG8_LDB(dst, b, h) do { _Pragma("unroll") for (int n = 0; n < 2; ++n) _Pragma("unroll") for (int k = 0; k < 2; ++k) dst[n][k] = *(const PG8_LAS bf16x8*)(lds + PG8_SB(b, h) + boff + n * 2048 + k * 1024); } while (0)
#define PG8_MMA(ai, bj, At, Bt) do { __builtin_amdgcn_s_setprio(1); _Pragma("unroll") for (int m = 0; m < 4; ++m) _Pragma("unroll") for (int n = 0; n < 2; ++n) _Pragma("unroll") for (int k = 0; k < 2; ++k) \
        acc[ai][bj][m][n] = __builtin_amdgcn_mfma_f32_16x16x32_bf16(Bt[n][k], At[m][k], acc[ai][bj][m][n], 0, 0, 0); __builtin_amdgcn_s_setprio(0); } while (0)
#define PG8_WAIT_V(n) asm volatile("s_waitcnt vmcnt(" #n ")" ::: "memory")
#define PG8_WAIT_L(n) asm volatile("s_waitcnt lgkmcnt(" #n ")" ::: "memory")
#define PG8_BAR __builtin_amdgcn_s_barrier()
#define PG8_SCHED __builtin_amdgcn_sched_barrier(0)
    Unit cur, nxt; int ui = 0;
    if (!S.next(0, cur)) return;
    f32x4 acc[2][2][4][2];
#pragma unroll
    for (int a = 0; a < 2; ++a)
#pragma unroll
        for (int b = 0; b < 2; ++b)
#pragma unroll
            for (int m = 0; m < 4; ++m)
#pragma unroll
                for (int n = 0; n < 2; ++n) acc[a][b][m][n] = (f32x4){0.f, 0.f, 0.f, 0.f};
    bf16x8 At[4][2], B0[2][2], B1[2][2];
    const char* cA = (const char*)g.A + (size_t)cur.pm * tstep; const char* cB = (const char*)g.Bt + (size_t)cur.pn * tstep;
    S.a_ready(cur);
    if constexpr (SP2) {
        PG8_STAGE(PG8_SB(0, 0), cB, voffB); PG8_STAGE(PG8_SB(0, 1), cB + hstep, voffB); PG8_STAGE(PG8_SA(0, 0), cA, voffA); PG8_STAGE(PG8_SA(0, 1), cA + hstep, voffA);
        if (wr == 1) PG8_BAR;
        PG8_WAIT_V(2); PG8_BAR;
        PG8_STAGE(PG8_SB(1, 0), cB + kstep, voffB); PG8_STAGE(PG8_SA(1, 0), cA + kstep, voffA); PG8_STAGE(PG8_SB(1, 1), cB + hstep + kstep, voffB);
        PG8_WAIT_V(6); PG8_BAR;
    } else {
        PG8_STAGE(PG8_SB(0, 0), cB, voffB); PG8_STAGE(PG8_SA(0, 0), cA, voffA); PG8_STAGE(PG8_SB(0, 1), cB + hstep, voffB); PG8_STAGE(PG8_SA(0, 1), cA + hstep, voffA);
        if (wr == 1) PG8_BAR;
        PG8_WAIT_V(4); PG8_BAR;
        PG8_STAGE(PG8_SB(1, 0), cB + kstep, voffB); PG8_STAGE(PG8_SA(1, 0), cA + kstep, voffA); PG8_STAGE(PG8_SB(1, 1), cB + hstep + kstep, voffB);
        PG8_WAIT_V(6); PG8_BAR;
    }
    for (;;) {
        const bool has_next = S.next(ui + 1, nxt);
        const char* nA = has_next ? (const char*)g.A + (size_t)nxt.pm * tstep : cA; const char* nB = has_next ? (const char*)g.Bt + (size_t)nxt.pn * tstep : cB;
        for (int t = 0; t < nt; t += 2) {
            const bool last = (t == nt - 2);
            const char* a1 = cA + (size_t)(t + 1) * kstep;
            const char* a2 = last ? nA : cA + (size_t)(t + 2) * kstep; const char* b2 = last ? nB : cB + (size_t)(t + 2) * kstep;
            const char* a3 = a2 + kstep; const char* b3 = b2 + kstep;
            if (last && has_next) S.a_ready(nxt);
            if constexpr (SP2) {
            PG8_LDB(B0, 0, 0); PG8_LDB(B1, 0, 1); PG8_SCHED; PG8_LDA(At, 0, 0); PG8_STAGE(PG8_SA(1, 1), a1 + hstep, voffA);
            PG8_WAIT_V(8); PG8_WAIT_L(0); PG8_BAR; PG8_MMA(0, 0, At, B0); PG8_MMA(0, 1, At, B1); PG8_BAR; PG8_SCHED;
            PG8_LDA(At, 0, 1); PG8_STAGE(PG8_SB(0, 0), b2, voffB); PG8_STAGE(PG8_SB(0, 1), b2 + hstep, voffB); PG8_STAGE(PG8_SA(0, 0), a2, voffA);
            PG8_WAIT_V(8); PG8_WAIT_L(0); PG8_BAR; PG8_MMA(1, 0, At, B0); PG8_MMA(1, 1, At, B1); PG8_BAR; PG8_SCHED;
            PG8_LDB(B0, 1, 0); PG8_LDB(B1, 1, 1); PG8_SCHED; PG8_LDA(At, 1, 0); PG8_STAGE(PG8_SA(0, 1), a2 + hstep, voffA);
            PG8_WAIT_V(8); PG8_WAIT_L(0); PG8_BAR; PG8_MMA(0, 0, At, B0); PG8_MMA(0, 1, At, B1); PG8_BAR; PG8_SCHED;
            PG8_LDA(At, 1, 1); PG8_STAGE(PG8_SB(1, 0), b3, voffB); PG8_STAGE(PG8_SB(1, 1), b3 + hstep, voffB); PG8_STAGE(PG8_SA(1, 0), a3, voffA);
            PG8_WAIT_V(8); PG8_WAIT_L(0); PG8_BAR; PG8_MMA(1, 0, At, B0); PG8_MMA(1, 1, At, B1); PG8_BAR; PG8_SCHED;
            } else {
            PG8_LDB(B0, 0, 0); PG8_SCHED; PG8_LDA(At, 0, 0); PG8_STAGE(PG8_SA(1, 1), a1 + hstep, voffA);
            PG8_WAIT_L(8); PG8_BAR; PG8_WAIT_L(0); PG8_MMA(0, 0, At, B0); PG8_BAR; PG8_SCHED;
            PG8_LDB(B1, 0, 1); PG8_STAGE(PG8_SB(0, 0), b2, voffB);
            PG8_BAR; PG8_WAIT_L(0); PG8_MMA(0, 1, At, B1); PG8_BAR;
            PG8_LDA(At, 0, 1); PG8_STAGE(PG8_SA(0, 0), a2, voffA);
            PG8_BAR; PG8_WAIT_L(0); PG8_MMA(1, 0, At, B0); PG8_BAR; PG8_SCHED;
            PG8_STAGE(PG8_SB(0, 1), b2 + hstep, voffB);
            PG8_WAIT_V(6); PG8_BAR; PG8_MMA(1, 1, At, B1); PG8_BAR;
            PG8_LDB(B0, 1, 0); PG8_SCHED; PG8_LDA(At, 1, 0); PG8_STAGE(PG8_SA(0, 1), a2 + hstep, voffA);
            PG8_WAIT_L(8); PG8_BAR; PG8_WAIT_L(0); PG8_MMA(0, 0, At, B0); PG8_BAR; PG8_SCHED;
            PG8_LDB(B1, 1, 1); PG8_STAGE(PG8_SB(1, 0), b3, voffB);
            PG8_BAR; PG8_WAIT_L(0); PG8_MMA(0, 1, At, B1); PG8_BAR;
            PG8_LDA(At, 1, 1); PG8_STAGE(PG8_SA(1, 0), a3, voffA);
            PG8_BAR; PG8_WAIT_L(0); PG8_MMA(1, 0, At, B0); PG8_BAR; PG8_SCHED;
            PG8_STAGE(PG8_SB(1, 1), b3 + hstep, voffB);
            PG8_WAIT_V(6); PG8_BAR; PG8_MMA(1, 1, At, B1); PG8_BAR;
            }
        }
        if constexpr (ALIGN_EPI) { if (wr == 0) PG8_BAR; }
        if constexpr (!Epi::AFTER_DRAIN) { E(acc, cur, wr, wc, fr, fq); S.done(cur); }
        if (!has_next) break;
#pragma unroll
        for (int a = 0; a < 2; ++a)
#pragma unroll
            for (int b = 0; b < 2; ++b)
#pragma unroll
                for (int m = 0; m < 4; ++m)
#pragma unroll
                    for (int n = 0; n < 2; ++n) acc[a][b][m][n] = (f32x4){0.f, 0.f, 0.f, 0.f};
        cur = nxt; cA = nA; cB = nB; ++ui;
        if constexpr (ALIGN_EPI) { if (wr == 1) PG8_BAR; }
    }
    PG8_WAIT_V(0);
    if constexpr (!ALIGN_EPI) { if (wr == 0) PG8_BAR; }
    PG8_BAR;
    if constexpr (Epi::AFTER_DRAIN) { E.fused(acc, cur, wr, wc, fr, fq, lds, wid, lane); S.done(cur); }
#undef PG8_SA
#undef PG8_SB
#undef PG8_STAGE
#undef PG8_LDA
#undef PG8_LDB
#undef PG8_MMA
#undef PG8_WAIT_V
#undef PG8_WAIT_L
#undef PG8_BAR
#undef PG8_SCHED
}
}

#include <hip/hip_cooperative_groups.h>
namespace cg = cooperative_groups;
#define LAS __attribute__((address_space(3)))
typedef unsigned short bf16;
typedef unsigned v4u __attribute__((ext_vector_type(4)));
typedef unsigned v2u __attribute__((ext_vector_type(2)));
typedef float f32x4 __attribute__((ext_vector_type(4)));
typedef float f32x2 __attribute__((ext_vector_type(2)));
typedef float f32x16 __attribute__((ext_vector_type(16)));
typedef short bf16x8 __attribute__((ext_vector_type(8)));

#ifndef MK_PER_PHASE
#define MK_PER_PHASE 0
#endif
constexpr int NB = 2, S = 16384, DM = 2048, T = NB * S, NH = 8, HD = 128, AW = 1024, CC = 1024, INW = 5120, FF = 8192, NMEM = 256, XH = 4, XW = 512, CONVK = 31, NBLK = 64;
constexpr float EPS = 1e-6f, LOG2E = 1.4426950408889634f;
constexpr int NPHASE = 15;
constexpr size_t MiB = 1u << 20;
constexpr size_t WS_CTL = 0; constexpr int CW_BAR = 4096;
constexpr size_t WS_WIN = 2 * MiB, WS_WOUT = 22 * MiB, WS_WQ = 30 * MiB, WS_WKV = 32 * MiB, WS_WO = 36 * MiB, WS_W1 = 38 * MiB, WS_W2 = 70 * MiB;
constexpr size_t WS_KBAR = 102 * MiB, WS_TB = 103 * MiB, WS_MN = 104 * MiB, WS_KC = 106 * MiB, WS_VCT = 107 * MiB;
constexpr size_t WS_NB = 112 * MiB;
constexpr size_t WS_Q = 240 * MiB, WS_K = 304 * MiB, WS_VT = 368 * MiB, WS_UV = 432 * MiB, WS_UG = 496 * MiB;
constexpr size_t WS_AC = 560 * MiB;
constexpr size_t WS_F = 240 * MiB;
constexpr size_t WS_QC = 240 * MiB, WS_OC = 272 * MiB;
constexpr size_t WS_PO = 752 * MiB;
constexpr size_t WS_PML = 944 * MiB;
constexpr size_t WS_LIST = 952 * MiB;
constexpr size_t WS_END = 1016 * MiB;
constexpr int LDS_BYTES = 152064;
constexpr int KS_OFF = 0, KROW = 272, VS_OFF = 256 * 272, VROW = 528  , TB_OFF = VS_OFF + 128 * 528, RED_OFF = TB_OFF + 8192, CNT_OFF = RED_OFF + 2048, PT_OFF = CNT_OFF + 4096, ST_OFF = PT_OFF + 192;
static_assert(PT_OFF + 256 <= LDS_BYTES, "LDS map");

__device__ __forceinline__ float bf_lo(unsigned w) { return __uint_as_float(w << 16); }
__device__ __forceinline__ float bf_hi(unsigned w) { return __uint_as_float(w & 0xffff0000u); }
typedef __bf16 bf16x2_t __attribute__((ext_vector_type(2)));
__device__ __forceinline__ unsigned pk2(float lo, float hi) { return pg8::cvt_pk_bf16(lo, hi); }
__device__ __forceinline__ unsigned pk2s(float lo, float hi) { f32x2 v = {lo, hi}; bf16x2_t b = __builtin_convertvector(v, bf16x2_t); return __builtin_bit_cast(unsigned, b); }
__device__ __forceinline__ float ex2(float x) { return __builtin_amdgcn_exp2f(x); }
__device__ __forceinline__ float wave_sum(float v) {
#pragma unroll
    for (int o = 1; o < 64; o <<= 1) v += __shfl_xor(v, o);
    return v;
}
__device__ __forceinline__ float sigmoidf_(float x) { return 1.0f / (1.0f + __expf(-x)); }

__device__ __forceinline__ void p0_transpose_item(const float* W, int K, int N, bf16* WT, int row_off, LAS float* scr, int item, int lane, const float* gk = nullptr) {
    const int nblk = N / 32, kb = item / nblk, nb = item % nblk, k0 = 64 * kb, n0 = 32 * nb;
    float wv[32];
#pragma unroll
    for (int i = 0; i < 32; ++i) { const int kk = 2 * i + (lane >> 5); wv[i] = W[(size_t)(k0 + kk) * N + n0 + (lane & 31)]; }
    if (gk) {
#pragma unroll
        for (int i = 0; i < 32; ++i) wv[i] *= gk[k0 + 2 * i + (lane >> 5)];
    }
#pragma unroll
    for (int i = 0; i < 32; ++i) { const int kk = 2 * i + (lane >> 5); scr[kk * 33 + (lane & 31)] = wv[i]; }
    asm volatile("s_waitcnt lgkmcnt(0)" ::: "memory");
    const int c = lane & 7;
#pragma unroll
    for (int j = 0; j < 4; ++j) { const int n = (lane >> 3) + 8 * j; const LAS float* s = scr + (8 * c) * 33 + n;
        v4u o; o.x = pk2(s[0 * 33], s[1 * 33]); o.y = pk2(s[2 * 33], s[3 * 33]); o.z = pk2(s[4 * 33], s[5 * 33]); o.w = pk2(s[6 * 33], s[7 * 33]);
        *(v4u*)(WT + (size_t)(row_off + n0 + n) * K + k0 + 8 * c) = o; }
    asm volatile("s_waitcnt lgkmcnt(0)" ::: "memory");
}
__device__ __forceinline__ void rms_row_bf16(const float* xrow, const float* g, bf16* orow, int lane) {
    const f32x4* xr = (const f32x4*)xrow + lane; f32x4 v[8]; float s = 0.f;
#pragma unroll
    for (int j = 0; j < 8; ++j) { v[j] = xr[64 * j]; s += (v[j].x * v[j].x + v[j].y * v[j].y) + (v[j].z * v[j].z + v[j].w * v[j].w); }
    const float rstd = 1.0f / sqrtf(wave_sum(s) * (1.0f / DM) + EPS);
    const f32x4* gr = (const f32x4*)g + lane; v2u* o8 = (v2u*)orow + lane;
#pragma unroll
    for (int j = 0; j < 8; ++j) { const f32x4 gv = gr[64 * j]; v2u w; w.x = pk2(v[j].x * rstd * gv.x, v[j].y * rstd * gv.y); w.y = pk2(v[j].z * rstd * gv.z, v[j].w * rstd * gv.w); o8[64 * j] = w; }
}
__device__ __forceinline__ void rms_row_f32(const float* xrow, const float* g, float* orow, int lane) {
    const f32x4* xr = (const f32x4*)xrow + lane; f32x4 v[8]; float s = 0.f;
#pragma unroll
    for (int j = 0; j < 8; ++j) { v[j] = xr[64 * j]; s += (v[j].x * v[j].x + v[j].y * v[j].y) + (v[j].z * v[j].z + v[j].w * v[j].w); }
    const float rstd = 1.0f / sqrtf(wave_sum(s) * (1.0f / DM) + EPS);
    const f32x4* gr = (const f32x4*)g + lane; f32x4* o = (f32x4*)orow + lane;
#pragma unroll
    for (int j = 0; j < 8; ++j) { const f32x4 gv = gr[64 * j]; o[64 * j] = v[j] * rstd * gv; }
}

__device__ __forceinline__ int crow(int r, int hi) { return (r & 3) + 8 * (r >> 2) + 4 * hi; }
__device__ __forceinline__ void attn_stage(LAS unsigned char* lds, const bf16* Kg, unsigned kstride, const bf16* VTg, unsigned vstride, const float* tbg, int tid) {
    const unsigned ko = (unsigned)(tid >> 4) * (kstride * 2u) + (unsigned)(tid & 15) * 16u, vo = (unsigned)(tid >> 5) * (vstride * 2u) + (unsigned)(tid & 31) * 16u;
    const unsigned kl = (unsigned)(tid >> 4) * KROW + (unsigned)(tid & 15) * 16u, vl = (unsigned)(tid >> 5) * VROW + (unsigned)(tid & 31) * 16u;
    v4u kx[8], vx[8];
#pragma unroll
    for (int p = 0; p < 8; ++p) kx[p] = *(const v4u*)((const unsigned char*)Kg + (size_t)p * 32 * kstride * 2 + ko);
#pragma unroll
    for (int p = 0; p < 8; ++p) vx[p] = *(const v4u*)((const unsigned char*)VTg + (size_t)p * 16 * vstride * 2 + vo);
#pragma unroll
    for (int p = 0; p < 8; ++p) *(LAS v4u*)(lds + KS_OFF + p * 32 * KROW + kl) = kx[p];
    { const unsigned c = (unsigned)(tid & 31), vl2 = (unsigned)(tid >> 5) * VROW + (c >> 1) * 32u + (c & 1u) * 8u;
#pragma unroll
      for (int p = 0; p < 8; ++p) { v2u a2, b2; a2.x = vx[p].x; a2.y = vx[p].y; b2.x = vx[p].z; b2.y = vx[p].w;
        *(LAS v2u*)(lds + VS_OFF + p * 16 * VROW + vl2) = a2; *(LAS v2u*)(lds + VS_OFF + p * 16 * VROW + vl2 + 16) = b2; } }
    if (tbg) { const f32x4 x = ((const f32x4*)tbg)[tid]; ((LAS f32x4*)(lds + TB_OFF))[tid] = x; }
}
__device__ __forceinline__ void load_q(bf16x8 (&qf)[8], const bf16* qp, int hi) {
#pragma unroll
    for (int ks = 0; ks < 8; ++ks) qf[ks] = *(const bf16x8*)(qp + 16 * ks + 8 * hi);
}
__device__ __forceinline__ void store_o16(bf16* rowbase, const f32x16 (&O)[4], float scale, int hi, bool doit) {
#pragma unroll
    for (int dt = 0; dt < 4; ++dt)
#pragma unroll
        for (int gp = 0; gp < 2; ++gp) {
            const int ga = 2 * gp, gb = 2 * gp + 1;
            const unsigned ax = pk2(O[dt][4 * ga] * scale, O[dt][4 * ga + 1] * scale), ay = pk2(O[dt][4 * ga + 2] * scale, O[dt][4 * ga + 3] * scale);
            const unsigned bx = pk2(O[dt][4 * gb] * scale, O[dt][4 * gb + 1] * scale), by = pk2(O[dt][4 * gb + 2] * scale, O[dt][4 * gb + 3] * scale);
            const v2u r1 = __builtin_amdgcn_permlane32_swap(ax, bx, false, false), r2 = __builtin_amdgcn_permlane32_swap(ay, by, false, false);
            v4u w; w.x = r1.x; w.y = r2.x; w.z = r1.y; w.w = r2.y;
            if (doit) *(v4u*)(rowbase + 32 * dt + 8 * (hi ? gb : ga)) = w;
        }
}
template <int MODE>
__device__ __forceinline__ void attn_core(LAS unsigned char* lds, const bf16x8 (&qf)[8], int qrel, float sc, int nchunks, bool fast, float cbias, f32x16 (&O)[4], float& m, float& l, int lane) {
    const int l31 = lane & 31, hi = lane >> 5;
#pragma unroll
    for (int dt = 0; dt < 4; ++dt)
#pragma unroll
        for (int r = 0; r < 16; ++r) O[dt][r] = 0.f;
    m = -1e30f; l = 0.f;
    const LAS float* tb = (const LAS float*)(lds + TB_OFF);
#pragma unroll 1
    for (int c = 0; c < nchunks; ++c) {
        f32x16 s0, s1;
#pragma unroll
        for (int r = 0; r < 16; ++r) { s0[r] = 0.f; s1[r] = 0.f; }
        const LAS unsigned char* kp = lds + KS_OFF + (64 * c + l31) * KROW + 16 * hi;
#pragma unroll
        for (int h2 = 0; h2 < 2; ++h2) {
            bf16x8 ka[4], kb[4];
#pragma unroll
            for (int ks = 0; ks < 4; ++ks) { ka[ks] = *(const LAS bf16x8*)(kp + 32 * (4 * h2 + ks)); kb[ks] = *(const LAS bf16x8*)(kp + 32 * KROW + 32 * (4 * h2 + ks)); }
#pragma unroll
            for (int ks = 0; ks < 4; ++ks) {
                s0 = __builtin_amdgcn_mfma_f32_32x32x16_bf16(ka[ks], qf[4 * h2 + ks], s0, 0, 0, 0);
                s1 = __builtin_amdgcn_mfma_f32_32x32x16_bf16(kb[ks], qf[4 * h2 + ks], s1, 0, 0, 0);
            }
        }
        float mx = -INFINITY;
#pragma unroll
        for (int r = 0; r < 16; ++r) {
            const int d0 = qrel - (64 * c + crow(r, hi)), d1 = d0 - 32;
            float t0 = s0[r] * sc, t1 = s1[r] * sc;
            if (MODE == 0) { if (fast) { t0 += cbias; t1 += cbias; } else { t0 += tb[d0 < 2047 ? d0 : 2047]; t1 += tb[d1 < 2047 ? d1 : 2047]; } }
            if (MODE == 1) { t0 = d0 >= 0 ? t0 + tb[d0 > 0 ? d0 : 0] : -INFINITY; t1 = d1 >= 0 ? t1 + tb[d1 > 0 ? d1 : 0] : -INFINITY; }
            s0[r] = t0; s1[r] = t1; mx = fmaxf(mx, fmaxf(t0, t1));
        }
        mx = fmaxf(mx, __shfl_xor(mx, 32));
        const float mn = fmaxf(m, mx), alpha = ex2(m - mn); m = mn;
        float ls = 0.f;
#pragma unroll
        for (int r = 0; r < 16; ++r) { s0[r] = ex2(s0[r] - mn); s1[r] = ex2(s1[r] - mn); ls += s0[r] + s1[r]; }
        l = l * alpha + ls;
#pragma unroll
        for (int dt = 0; dt < 4; ++dt)
#pragma unroll
            for (int r = 0; r < 16; ++r) O[dt][r] *= alpha;
#pragma unroll
        for (int kt2 = 0; kt2 < 2; ++kt2) {
            bf16x8 pb[2];
#pragma unroll
            for (int sp = 0; sp < 2; ++sp) {
                v4u pw;
                if (kt2 == 0) { pw.x = pk2s(s0[8 * sp + 0], s0[8 * sp + 1]); pw.y = pk2s(s0[8 * sp + 2], s0[8 * sp + 3]); pw.z = pk2s(s0[8 * sp + 4], s0[8 * sp + 5]); pw.w = pk2s(s0[8 * sp + 6], s0[8 * sp + 7]); }
                else          { pw.x = pk2s(s1[8 * sp + 0], s1[8 * sp + 1]); pw.y = pk2s(s1[8 * sp + 2], s1[8 * sp + 3]); pw.z = pk2s(s1[8 * sp + 4], s1[8 * sp + 5]); pw.w = pk2s(s1[8 * sp + 6], s1[8 * sp + 7]); }
                pb[sp] = __builtin_bit_cast(bf16x8, pw);
            }
            const LAS unsigned char* vp = lds + VS_OFF + l31 * VROW + (64 * c + 32 * kt2) * 2 + 16 * hi;
            bf16x8 va[2][4];
#pragma unroll
            for (int sp = 0; sp < 2; ++sp)
#pragma unroll
                for (int dt = 0; dt < 4; ++dt) va[sp][dt] = *(const LAS bf16x8*)(vp + sp * 32 + dt * 32 * VROW);
#pragma unroll
            for (int sp = 0; sp < 2; ++sp)
#pragma unroll
                for (int dt = 0; dt < 4; ++dt) O[dt] = __builtin_amdgcn_mfma_f32_32x32x16_bf16(va[sp][dt], pb[sp], O[dt], 0, 0, 0);
        }
    }
    l += __shfl_xor(l, 32);
}

#define XB_TMO      128
#define XB_XCNT(j)  (256  + 64 * (j))
#define XB_XSUB(j)  (1280 + 64 * (j))
#define XB_XGEN(j)  (2304 + 64 * (j))
#define XB_TOP      3328
#define XB_TOPGEN   3392
#define XCD_BAR_WORDS 3456
#define XB_SPIN_CAP (1u << 18)

__device__ __forceinline__ unsigned xb_ld(unsigned* p)              { return __hip_atomic_load(p, __ATOMIC_RELAXED, __HIP_MEMORY_SCOPE_AGENT); }
__device__ __forceinline__ unsigned xb_add(unsigned* p, unsigned v) { return __hip_atomic_fetch_add(p, v, __ATOMIC_RELAXED, __HIP_MEMORY_SCOPE_AGENT); }
__device__ __forceinline__ unsigned xb_xcc_id() { return (unsigned)__builtin_amdgcn_s_getreg((3 << 11) | 20) & 0xFu; }
#define XB_SPIN(cond, bar) do { unsigned _sp = 0; while (cond) { __builtin_amdgcn_s_sleep(1); \
    if ((++_sp & 255u) == 0u) { if (xb_ld(&(bar)[XB_TMO])) break; if (_sp > XB_SPIN_CAP) { atomicAdd(&(bar)[XB_TMO], 1u); break; } } } } while (0)

struct XcdBarrier {
    unsigned* bar; unsigned x;
    volatile LAS unsigned* st;
};

__device__ __forceinline__ XcdBarrier xcd_barrier_post(unsigned* bar, volatile LAS unsigned* st, int tid) {
    XcdBarrier b; b.bar = bar; b.x = xb_xcc_id(); b.st = st;
    if (tid == 0) (void)xb_add(&bar[XB_XCNT(b.x)], 1u);
    return b;
}
__device__ __forceinline__ void xcd_barrier_complete(unsigned* bar, unsigned x, unsigned& nloc, unsigned& nx) {
    const unsigned G = gridDim.x * gridDim.y * gridDim.z;
    unsigned sum, cnt, mine, sp = 0u;
    for (;;) {
        sum = 0u; cnt = 0u; mine = 0u;
#pragma unroll
        for (unsigned j = 0; j < 16; ++j) { const unsigned c = xb_ld(&bar[XB_XCNT(j)]); sum += c; cnt += (c > 0u) ? 1u : 0u; mine = (j == x) ? c : mine; }
        if (sum == G) break;
        __builtin_amdgcn_s_sleep(1);
        if ((++sp & 255u) == 0u) { if (xb_ld(&bar[XB_TMO])) break; if (sp > XB_SPIN_CAP) { atomicAdd(&bar[XB_TMO], 1u); break; } }
    }
    nloc = mine > 0u ? mine : 1u; nx = cnt > 0u ? cnt : 1u;
}

__device__ __forceinline__ void xcd_barrier(const XcdBarrier& b, int tid) {
    asm volatile("s_waitcnt vmcnt(0)" ::: "memory");
    __syncthreads();
    if (tid == 0) {
        unsigned* bar = b.bar;
        __builtin_amdgcn_s_waitcnt(0);
        unsigned nloc = b.st[0], nx = b.st[1];
        if (nloc == 0u) { xcd_barrier_complete(bar, b.x, nloc, nx); b.st[0] = nloc; b.st[1] = nx; }
        const unsigned old = xb_add(&bar[XB_XSUB(b.x)], 1u);
        const unsigned gen = old / nloc;
        if (old + 1u == (gen + 1u) * nloc) {
            __builtin_amdgcn_fence(__ATOMIC_RELEASE, "agent");
            asm volatile("s_waitcnt vmcnt(0)" ::: "memory");
            const unsigned og = xb_add(&bar[XB_TOP], 1u);
            const unsigned tg = og / nx;
            if (og + 1u == (tg + 1u) * nx) xb_add(&bar[XB_TOPGEN], 1u);
            else XB_SPIN(xb_ld(&bar[XB_TOPGEN]) == tg, bar);
            __builtin_amdgcn_fence(__ATOMIC_ACQUIRE, "agent");
            xb_add(&bar[XB_XGEN(b.x)], 1u);
            asm volatile("s_waitcnt vmcnt(0)" ::: "memory");
        } else {
            XB_SPIN(xb_ld(&bar[XB_XGEN(b.x)]) == gen, bar);
            __builtin_amdgcn_fence(__ATOMIC_ACQUIRE, "agent");
            asm volatile("s_waitcnt vmcnt(0)" ::: "memory");
        }
    }
    __syncthreads();
}

struct Args { const float* in[20]; float* out; unsigned char* ws; int ph_lo, ph_hi; };

__global__ void __launch_bounds__(512, 2) fwd(Args a) {
    extern __shared__ __attribute__((aligned(16))) unsigned char lds_raw[];
    LAS unsigned char* lds = (LAS unsigned char*)lds_raw;
    const int wave = __builtin_amdgcn_readfirstlane((int)threadIdx.x >> 6);
    const int G = gridDim.x, blk = blockIdx.x;
    const int lo = a.ph_lo, hiP = a.ph_hi;
    LAS unsigned long long* ptab = (LAS unsigned long long*)(lds + PT_OFF);
    if (threadIdx.x == 0) {
#pragma unroll
        for (int i = 0; i < 20; ++i) ptab[i] = (unsigned long long)a.in[i];
        ptab[20] = (unsigned long long)a.out; ptab[21] = (unsigned long long)a.ws;
        ((LAS unsigned*)(lds + ST_OFF))[0] = 0u; ((LAS unsigned*)(lds + ST_OFF))[1] = 0u;
    }
    __syncthreads();
    if (a.ph_hi - a.ph_lo > 1) {
        cg::this_grid().sync();
        const int lane_ = (int)__builtin_amdgcn_mbcnt_hi(~0u, __builtin_amdgcn_mbcnt_lo(~0u, 0u));
        (void)xcd_barrier_post((unsigned*)(a.ws + WS_CTL) + CW_BAR, (volatile LAS unsigned*)(lds + ST_OFF), wave * 64 + lane_);
    }
#define LDP(i) ((unsigned char*)(__attribute__((address_space(1))) unsigned char*)(((unsigned long long)(unsigned)__builtin_amdgcn_readfirstlane((int)(unsigned)(ptab[i] >> 32)) << 32) | (unsigned long long)(unsigned)__builtin_amdgcn_readfirstlane((int)(unsigned)ptab[i])))
#define DECL_PTRS \
    const int lane = (int)__builtin_amdgcn_mbcnt_hi(~0u, __builtin_amdgcn_mbcnt_lo(~0u, 0u)), tid = wave * 64 + lane, l31 = lane & 31, hi = lane >> 5; (void)tid; (void)l31; (void)hi; \
    const float* const x = (const float*)LDP(0); (void)x; \
    const float* const mem = (const float*)LDP(1); (void)mem; \
    const float* const g_mix = (const float*)LDP(2); (void)g_mix; \
    const float* const w_in = (const float*)LDP(3); (void)w_in; \
    const float* const conv_w = (const float*)LDP(4); (void)conv_w; \
    const float* const conv_b = (const float*)LDP(5); (void)conv_b; \
    const float* const ln_g = (const float*)LDP(6); (void)ln_g; \
    const float* const ln_b = (const float*)LDP(7); (void)ln_b; \
    const float* const w_out = (const float*)LDP(8); (void)w_out; \
    const float* const rel_bias = (const float*)LDP(9); (void)rel_bias; \
    const float* const g_cross = (const float*)LDP(10); (void)g_cross; \
    const float* const g_mem = (const float*)LDP(11); (void)g_mem; \
    const float* const wq_c = (const float*)LDP(12); (void)wq_c; \
    const float* const wk_c = (const float*)LDP(13); (void)wk_c; \
    const float* const wv_c = (const float*)LDP(14); (void)wv_c; \
    const float* const wo_c = (const float*)LDP(15); (void)wo_c; \
    const float* const g_mlp = (const float*)LDP(16); (void)g_mlp; \
    const float* const w1 = (const float*)LDP(17); (void)w1; \
    const float* const w2 = (const float*)LDP(18); (void)w2; \
    const float* const g_final = (const float*)LDP(19); (void)g_final; \
    float* const out = (float*)LDP(20); (void)out; unsigned char* const ws = LDP(21); (void)ws; \
    unsigned* const CNT = (unsigned*)(ws + WS_CTL); (void)CNT; float* const SSQ1 = (float*)(ws + WS_CTL + 262144); (void)SSQ1; float* const SSQ2 = (float*)(ws + WS_CTL + 524288); (void)SSQ2; float* const SSQ3 = (float*)(ws + WS_CTL + 786432); (void)SSQ3; \
    bf16* const WIN_T = (bf16*)(ws + WS_WIN); (void)WIN_T; \
    bf16* const WOUT_T = (bf16*)(ws + WS_WOUT); (void)WOUT_T; \
    bf16* const WQ_T = (bf16*)(ws + WS_WQ); (void)WQ_T; \
    bf16* const WKV_T = (bf16*)(ws + WS_WKV); (void)WKV_T; \
    bf16* const WO_T = (bf16*)(ws + WS_WO); (void)WO_T; \
    bf16* const W1_T = (bf16*)(ws + WS_W1); (void)W1_T; \
    bf16* const W2_T = (bf16*)(ws + WS_W2); (void)W2_T; \
    float* const KBAR = (float*)(ws + WS_KBAR); (void)KBAR; \
    float* const TB = (float*)(ws + WS_TB); (void)TB; \
    bf16* const MN = (bf16*)(ws + WS_MN); (void)MN; \
    bf16* const KC = (bf16*)(ws + WS_KC); (void)KC; \
    bf16* const VCT = (bf16*)(ws + WS_VCT); (void)VCT; \
    bf16* const NBUF = (bf16*)(ws + WS_NB); (void)NBUF; \
    bf16* const Q = (bf16*)(ws + WS_Q); (void)Q; \
    bf16* const K = (bf16*)(ws + WS_K); (void)K; \
    bf16* const VT = (bf16*)(ws + WS_VT); (void)VT; \
    bf16* const UV = (bf16*)(ws + WS_UV); (void)UV; \
    bf16* const UG = (bf16*)(ws + WS_UG); (void)UG; \
    bf16* const AC = (bf16*)(ws + WS_AC); (void)AC; \
    bf16* const FB = (bf16*)(ws + WS_F); (void)FB; \
    bf16* const QC = (bf16*)(ws + WS_QC); (void)QC; \
    bf16* const OC = (bf16*)(ws + WS_OC); (void)OC; \
    bf16* const PO = (bf16*)(ws + WS_PO); (void)PO; \
    float* const PML = (float*)(ws + WS_PML); (void)PML; \
    unsigned* const LIST = (unsigned*)(ws + WS_LIST); (void)LIST; \
    do {} while (0)
    const float SC = 0.08838834764831845f * LOG2E;
#ifndef DBG
#define DBG 0
#endif
#ifndef REP_MASK
#define REP_MASK 0
#endif
#ifndef PH_MASK
#define PH_MASK 0x7fff
#endif
#define IN(k) (((PH_MASK >> (k)) & 1) && lo <= (k) && (k) < hiP)
#define SEAM2(k, kn) do { if (IN(k) && IN(kn)) { const int lane_ = (int)__builtin_amdgcn_mbcnt_hi(~0u, __builtin_amdgcn_mbcnt_lo(~0u, 0u)); \
        XcdBarrier b_; b_.bar = (unsigned*)(LDP(21) + WS_CTL) + CW_BAR; b_.x = xb_xcc_id(); b_.st = (volatile LAS unsigned*)(lds + ST_OFF); xcd_barrier(b_, wave * 64 + lane_); } } while (0)
#define SEAM(k) SEAM2(k, (k) + 1)
#define GRID_BAR() do { const int lane_ = (int)__builtin_amdgcn_mbcnt_hi(~0u, __builtin_amdgcn_mbcnt_lo(~0u, 0u)); \
        XcdBarrier b_; b_.bar = (unsigned*)(LDP(21) + WS_CTL) + CW_BAR; b_.x = xb_xcc_id(); b_.st = (volatile LAS unsigned*)(lds + ST_OFF); xcd_barrier(b_, wave * 64 + lane_); } while (0)

    for (int rep_ = 0; rep_ < (IN(0) ? 1 + ((REP_MASK >> 0) & 1) : 0); ++rep_) { DECL_PTRS;
        LAS float* scr = (LAS float*)(lds + wave * 16384);
        const int gw = blk * 8 + wave, NGW = G * 8;
        constexpr int I_IN = (DM / 64) * (INW / 32), I_OUT = (DM / 64) * (DM / 32), I_X = (DM / 64) * (XW / 32), I_O = (XW / 64) * (DM / 32), I_1 = (DM / 64) * (FF / 32), I_2 = (FF / 64) * (DM / 32);
        constexpr int NITEMS = I_IN + I_OUT + 3 * I_X + I_O + I_1 + I_2;
        const bool early = (G > 16) && (hiP - lo > 1);
        for (int it = gw; it < 2 * I_X; it += NGW) { if (it < I_X) p0_transpose_item(wk_c, DM, XW, WKV_T, 0, scr, it, lane); else p0_transpose_item(wv_c, DM, XW, WKV_T, XW, scr, it - I_X, lane); }
        for (int mrow = gw; mrow < NB * NMEM; mrow += NGW) rms_row_bf16(mem + (size_t)mrow * DM, g_mem, MN + (size_t)mrow * DM, lane);
        for (int i = blk * 512 + tid; i < NH * 2048; i += G * 512) {
            const int hh = i >> 11, d = i & 2047; int bucket = d;
            if (d >= 16) { const int lg = 16 + (int)(logf((float)d / 16.0f) / 4.852030263919617f * 16.0f); bucket = lg < 31 ? lg : 31; }
            TB[i] = rel_bias[bucket * NH + hh] * LOG2E;
        }
        if (early) { GRID_BAR(); }
        if (early && blk < 8) {
            pg8::Gemm g{MN, WKV_T, NB * NMEM, 2 * XW, DM}; pg8::StaticOrder So; So.init(NB * NMEM, 2 * XW, 8, blk);
            pg8::EpiBf16X<0> E{KC, XW, XW, (size_t)NB * NMEM * XW, 1, VCT, NMEM, XH, nullptr};
            pg8::gemm_phase<pg8::EpiBf16X<0>, pg8::StaticOrder, true, true>(lds, g, So, E, tid);
        } else {
        const int nb0 = early ? 8 : 0, gwb = (blk - nb0) * 8 + wave, NGWB = (G - nb0) * 8;
        constexpr int NREST = I_IN + I_OUT + I_X + I_O + I_1 + I_2;
        for (int it = gwb; it < NREST; it += NGWB) {
            int r = it;
            if (r < I_IN) { p0_transpose_item(w_in, DM, INW, WIN_T, 0, scr, r, lane); continue; } r -= I_IN;
            if (r < I_OUT) { p0_transpose_item(w_out, DM, DM, WOUT_T, 0, scr, r, lane); continue; } r -= I_OUT;
            if (r < I_X) { p0_transpose_item(wq_c, DM, XW, WQ_T, 0, scr, r, lane, g_cross); continue; } r -= I_X;
            if (r < I_O) { p0_transpose_item(wo_c, XW, DM, WO_T, 0, scr, r, lane); continue; } r -= I_O;
            if (r < I_1) { p0_transpose_item(w1, DM, FF, W1_T, 0, scr, r, lane, g_mlp); continue; } r -= I_1;
            p0_transpose_item(w2, FF, DM, W2_T, 0, scr, r, lane);
        }
        for (int mrow = gwb; mrow < T; mrow += 2 * NGWB) {
            const int r2 = mrow + NGWB;
            const f32x4* xa = (const f32x4*)(x + (size_t)mrow * DM) + lane; const f32x4* xb = (const f32x4*)(x + (size_t)(r2 < T ? r2 : mrow) * DM) + lane;
            f32x4 va[8], vb[8]; float sa = 0.f, sb = 0.f;
#pragma unroll
            for (int jj = 0; jj < 8; ++jj) { va[jj] = xa[64 * jj]; vb[jj] = xb[64 * jj]; }
#pragma unroll
            for (int jj = 0; jj < 8; ++jj) { sa += (va[jj].x * va[jj].x + va[jj].y * va[jj].y) + (va[jj].z * va[jj].z + va[jj].w * va[jj].w); sb += (vb[jj].x * vb[jj].x + vb[jj].y * vb[jj].y) + (vb[jj].z * vb[jj].z + vb[jj].w * vb[jj].w); }
            const float ra = 1.0f / sqrtf(wave_sum(sa) * (1.0f / DM) + EPS), rb = 1.0f / sqrtf(wave_sum(sb) * (1.0f / DM) + EPS);
            const f32x4* gr = (const f32x4*)g_mix + lane; v2u* oa = (v2u*)(NBUF + (size_t)mrow * DM) + lane; v2u* ob = (v2u*)(NBUF + (size_t)(r2 < T ? r2 : mrow) * DM) + lane;
#pragma unroll
            for (int jj = 0; jj < 8; ++jj) { const f32x4 gv = gr[64 * jj]; v2u w; w.x = pk2(va[jj].x * ra * gv.x, va[jj].y * ra * gv.y); w.y = pk2(va[jj].z * ra * gv.z, va[jj].w * ra * gv.w); oa[64 * jj] = w;
                if (r2 < T) { v2u w2; w2.x = pk2(vb[jj].x * rb * gv.x, vb[jj].y * rb * gv.y); w2.y = pk2(vb[jj].z * rb * gv.z, vb[jj].w * rb * gv.w); ob[64 * jj] = w2; } }
        }
        }
        __syncthreads();
    }
    SEAM(0);

    for (int rep_ = 0; rep_ < (IN(1) ? 1 + ((REP_MASK >> 1) & 1) : 0); ++rep_) { DECL_PTRS;
        { pg8::Gemm g{NBUF, WIN_T, T, INW, DM}; pg8::StaticOrder So; So.init(T, INW, G, blk);
          pg8::EpiBf16X<0> E{Q, AW, AW, (size_t)T * AW, 2, VT, S, NH, nullptr};
          pg8::gemm_phase<pg8::EpiBf16X<0>, pg8::StaticOrder, true, true>(lds, g, So, E, tid); }
        if (!((G > 16) && (hiP - lo > 1)))
        { pg8::Gemm g{MN, WKV_T, NB * NMEM, 2 * XW, DM}; pg8::StaticOrder So; So.init(NB * NMEM, 2 * XW, G, blk);
          pg8::EpiBf16X<0> E{KC, XW, XW, (size_t)NB * NMEM * XW, 1, VCT, NMEM, XH, nullptr};
          pg8::gemm_phase<pg8::EpiBf16X<0>, pg8::StaticOrder, true, true>(lds, g, So, E, tid); }
    }
    SEAM(1);

#if DBG == 9
    { DECL_PTRS; for (size_t i = (size_t)blk * 512 + tid; i < (size_t)T * DM; i += (size_t)G * 512) { out[i] = i < 262144 ? __uint_as_float(((unsigned)KC[i] << 16)) : (i < 524288 ? __uint_as_float(((unsigned)VCT[i - 262144] << 16)) : 0.f); } return; }
#endif
#if DBG == 1
    { DECL_PTRS; for (size_t i = (size_t)blk * 512 + tid; i < (size_t)T * DM; i += (size_t)G * 512) { const size_t t = i >> 11, c = i & 2047, e = t * 1024 + (c & 1023);
        const unsigned short v = c < 1024 ? (unsigned short)(Q[e] ^ UV[e]) : (unsigned short)(K[e] ^ UG[e] ^ VT[e]); out[i] = __uint_as_float(((unsigned)v << 16)) ; } return; }
#endif
    for (int rep_ = 0; rep_ < (IN(2) ? 1 + ((REP_MASK >> 2) & 1) : 0); ++rep_) { DECL_PTRS;
        for (int it = blk; it < 256; it += G) {
            const int b = it >> 7, j = (it >> 1) & 63, chh = it & 1, cp = tid & 255, rh = tid >> 8;
            const bf16* kp = K + (size_t)(b * S + j * 256 + rh * 128) * AW + chh * 512 + 2 * cp;
            float s0 = 0.f, s1 = 0.f;
#pragma unroll 8
            for (int r = 0; r < 128; ++r) { const unsigned w = *(const unsigned*)(kp + (size_t)r * AW); s0 += bf_lo(w); s1 += bf_hi(w); }
            LAS f32x2* red = (LAS f32x2*)lds;
            if (rh == 1) red[cp] = (f32x2){s0, s1};
            __syncthreads();
            if (rh == 0) { const f32x2 o = red[cp]; const int col = chh * 512 + 2 * cp, hh = col >> 7, d = col & 127;
                *(f32x2*)(KBAR + ((size_t)((b * NH + hh) * NBLK + j)) * HD + d) = (f32x2){(s0 + o.x) * (1.0f / 256.0f), (s1 + o.y) * (1.0f / 256.0f)}; }
            __syncthreads();
        }
        for (int seg = blk; seg < T / 128; seg += G) {
            const int t0 = seg * 128, c0 = 2 * tid;
            float w0[CONVK], w1r[CONVK];
#pragma unroll
            for (int k = 0; k < CONVK; ++k) { const f32x2 wv = *(const f32x2*)(conv_w + k * CC + c0); w0[k] = wv.x; w1r[k] = wv.y; }
            const f32x2 cb = *(const f32x2*)(conv_b + c0), lg = *(const f32x2*)(ln_g + c0), lb = *(const f32x2*)(ln_b + c0);
            float r0[32], r1[32];
#pragma unroll
            for (int i = 0; i < 32; ++i) { r0[i] = 0.f; r1[i] = 0.f; }
            LAS f32x2* red = (LAS f32x2*)(lds + RED_OFF);
#pragma unroll 1
            for (int ch = -1; ch < 4; ++ch) {
                const int tb0 = t0 + ch * 32;
                const bool zero = (ch < 0) && ((t0 & (S - 1)) == 0);
#pragma unroll
                for (int hf = 0; hf < 2; ++hf) {
                    float y0[16], y1[16];
#pragma unroll
                    for (int ii = 0; ii < 16; ++ii) {
                        const int i = hf * 16 + ii;
                        float h0 = 0.f, h1 = 0.f;
                        if (!zero) { const size_t off = (size_t)(tb0 + i) * CC + c0; const unsigned vv = *(const unsigned*)(UV + off), gg = *(const unsigned*)(UG + off);
                            h0 = bf_lo(vv) * sigmoidf_(bf_lo(gg)); h1 = bf_hi(vv) * sigmoidf_(bf_hi(gg)); }
                        r0[i] = h0; r1[i] = h1;
                        float a0 = cb.x, a1 = cb.y;
                        if (ch >= 0) {
#pragma unroll
                            for (int k = 0; k < CONVK; ++k) { a0 += r0[(i - 30 + k) & 31] * w0[k]; a1 += r1[(i - 30 + k) & 31] * w1r[k]; }
                        }
                        y0[ii] = a0; y1[ii] = a1;
                    }
                    if (ch >= 0) {
#pragma unroll
                        for (int ii = 0; ii < 16; ++ii) { const float s1 = wave_sum(y0[ii] + y1[ii]), s2 = wave_sum(y0[ii] * y0[ii] + y1[ii] * y1[ii]); if (lane == 0) red[ii * 8 + wave] = (f32x2){s1, s2}; }
                        __syncthreads();
#pragma unroll
                        for (int ii = 0; ii < 16; ++ii) {
                            float s1 = 0.f, s2 = 0.f;
#pragma unroll
                            for (int w = 0; w < 8; ++w) { const f32x2 p = red[ii * 8 + w]; s1 += p.x; s2 += p.y; }
                            const float mean = s1 * (1.0f / CC), var = fmaxf(s2 * (1.0f / CC) - mean * mean, 0.f), rstd = 1.0f / sqrtf(var + EPS);
                            float o0 = (y0[ii] - mean) * rstd * lg.x + lb.x, o1 = (y1[ii] - mean) * rstd * lg.y + lb.y;
                            o0 = o0 * sigmoidf_(o0); o1 = o1 * sigmoidf_(o1);
                            *(unsigned*)(AC + (size_t)(tb0 + hf * 16 + ii) * DM + AW + c0) = pk2(o0, o1);
                        }
                        __syncthreads();
                    }
                }
            }
        }
    }
    SEAM(2);

    for (int rep_ = 0; rep_ < (IN(3) ? 1 : 0); ++rep_) { DECL_PTRS;
        constexpr int KH_OFF = 0, KL_OFF = 64 * KROW;
        for (int it = blk; it < NB * NH * NBLK; it += G) {
            const int bh = it >> 6, own = it & 63, b = bh >> 3, hh = bh & 7;
            if (own == 0) continue;
            f32x2 kvv[8];
#pragma unroll
            for (int i = 0; i < 8; ++i) { const int p2 = tid + 512 * i; kvv[i] = *(const f32x2*)(KBAR + (size_t)bh * NBLK * HD + 2 * p2); }
#pragma unroll
            for (int i = 0; i < 8; ++i) { const int p2 = tid + 512 * i, jr = p2 >> 6, d = (p2 & 63) * 2; const f32x2 kv = kvv[i];
                const unsigned hw = pk2s(kv.x, kv.y); const unsigned lw = pk2s(kv.x - bf_lo(hw), kv.y - bf_hi(hw));
                *(LAS unsigned*)(lds + KH_OFF + jr * KROW + d * 2) = hw; *(LAS unsigned*)(lds + KL_OFF + jr * KROW + d * 2) = lw; }
            const int ql = own * 256 + wave * 32 + l31;
            bf16x8 qf[8]; load_q(qf, Q + (size_t)(b * S + ql) * AW + hh * HD, hi);
            __syncthreads();
            f32x16 g0, g1;
#pragma unroll
            for (int r = 0; r < 16; ++r) { g0[r] = 0.f; g1[r] = 0.f; }
            const LAS unsigned char* kp = lds + l31 * KROW + 16 * hi;
#pragma unroll
            for (int ks = 0; ks < 8; ++ks) {
                g0 = __builtin_amdgcn_mfma_f32_32x32x16_bf16(*(const LAS bf16x8*)(kp + KH_OFF + 32 * ks), qf[ks], g0, 0, 0, 0);
                g0 = __builtin_amdgcn_mfma_f32_32x32x16_bf16(*(const LAS bf16x8*)(kp + KL_OFF + 32 * ks), qf[ks], g0, 0, 0, 0);
            }
            if (own > 32) {
#pragma unroll
                for (int ks = 0; ks < 8; ++ks) {
                    g1 = __builtin_amdgcn_mfma_f32_32x32x16_bf16(*(const LAS bf16x8*)(kp + KH_OFF + 32 * KROW + 32 * ks), qf[ks], g1, 0, 0, 0);
                    g1 = __builtin_amdgcn_mfma_f32_32x32x16_bf16(*(const LAS bf16x8*)(kp + KL_OFF + 32 * KROW + 32 * ks), qf[ks], g1, 0, 0, 0);
                }
            }
            float v0 = -INFINITY, v1 = -INFINITY, v2 = -INFINITY; int i0 = 64, i1 = 64, i2 = 64;
#define TOP3_INS(val, idx) do { const float dv_ = (val); const int di_ = (idx); if (di_ < own && dv_ > v2) { if (dv_ > v1) { v2 = v1; i2 = i1; if (dv_ > v0) { v1 = v0; i1 = i0; v0 = dv_; i0 = di_; } else { v1 = dv_; i1 = di_; } } else { v2 = dv_; i2 = di_; } } } while (0)
#pragma unroll
            for (int r = 0; r < 16; ++r) TOP3_INS(g0[r], crow(r, hi));
            if (own > 32) {
#pragma unroll
                for (int r = 0; r < 16; ++r) TOP3_INS(g1[r], 32 + crow(r, hi));
            }
            const float pv0 = __shfl_xor(v0, 32), pv1 = __shfl_xor(v1, 32), pv2 = __shfl_xor(v2, 32); const int pi0 = __shfl_xor(i0, 32), pi1 = __shfl_xor(i1, 32), pi2 = __shfl_xor(i2, 32);
#define TOP3_MRG(val, idx) do { const float dv_ = (val); const int di_ = (idx); if (di_ < own) { \
                if (dv_ > v2 || (dv_ == v2 && di_ < i2)) { if (dv_ > v1 || (dv_ == v1 && di_ < i1)) { v2 = v1; i2 = i1; if (dv_ > v0 || (dv_ == v0 && di_ < i0)) { v1 = v0; i1 = i0; v0 = dv_; i0 = di_; } else { v1 = dv_; i1 = di_; } } else { v2 = dv_; i2 = di_; } } } } while (0)
            TOP3_MRG(pv0, pi0); TOP3_MRG(pv1, pi1); TOP3_MRG(pv2, pi2);
            const int nsel = own < 3 ? own : 3;
            LAS unsigned char* sel = lds + 2 * 64 * KROW;
            if (hi == 0) { const int qi = wave * 32 + l31; sel[qi] = (unsigned char)(nsel > 0 ? i0 : 255); sel[256 + qi] = (unsigned char)(nsel > 1 ? i1 : 255); sel[512 + qi] = (unsigned char)(nsel > 2 ? i2 : 255); }
            __syncthreads();
            for (int jl = wave; jl < own; jl += 8) {
                unsigned long long bm[12]; bool mt[12]; unsigned total = 0u;
#pragma unroll
                for (int sk = 0; sk < 12; ++sk) { mt[sk] = sel[(sk >> 2) * 256 + lane + 64 * (sk & 3)] == (unsigned char)jl; bm[sk] = __ballot(mt[sk]); total += (unsigned)__popcll(bm[sk]); }
                if (total == 0u) continue;
                unsigned basep = 0u; if (lane == 0) basep = atomicAdd(&CNT[bh * NBLK + jl], total);
                unsigned run = (unsigned)__builtin_amdgcn_readfirstlane((int)basep);
                const unsigned long long lt = (1ull << lane) - 1ull;
#pragma unroll
                for (int sk = 0; sk < 12; ++sk) {
                    if (mt[sk]) __hip_atomic_store(&LIST[(size_t)(bh * NBLK + jl) * S + run + (unsigned)__popcll(bm[sk] & lt)], (unsigned)((own * 256 + lane + 64 * (sk & 3)) | ((sk >> 2) << 14)), __ATOMIC_RELAXED, __HIP_MEMORY_SCOPE_AGENT);
                    run += (unsigned)__popcll(bm[sk]);
                }
            }
            __syncthreads();
        }
    }
    SEAM(3);

    for (int rep_ = 0; rep_ < (IN(4) ? 1 + ((REP_MASK >> 4) & 1) : 0); ++rep_) { DECL_PTRS;
        LAS unsigned* pf = (LAS unsigned*)(lds + CNT_OFF);
        LAS unsigned* wtot = (LAS unsigned*)(lds + RED_OFF);
        {
            const unsigned c0 = __hip_atomic_load(&CNT[2 * tid], __ATOMIC_RELAXED, __HIP_MEMORY_SCOPE_AGENT), c1 = __hip_atomic_load(&CNT[2 * tid + 1], __ATOMIC_RELAXED, __HIP_MEMORY_SCOPE_AGENT);
            const unsigned ua = (c0 + 31u) >> 5, ub = (c1 + 31u) >> 5, us = ua + ub;
            unsigned v = us;
#pragma unroll
            for (int o = 1; o < 64; o <<= 1) { const unsigned u = __shfl_up(v, o); if (lane >= o) v += u; }
            if (lane == 63) wtot[wave] = v;
            __syncthreads();
            unsigned off = 0u;
            for (int w = 0; w < wave; ++w) off += wtot[w];
            const unsigned excl = off + v - us;
            pf[2 * tid] = excl + ua; pf[2 * tid + 1] = excl + us;
            __syncthreads();
        }
        const unsigned total = pf[NB * NH * NBLK - 1];
        const unsigned glo = (unsigned)(((unsigned long long)total * (unsigned)blk) / (unsigned)G), ghi = (unsigned)(((unsigned long long)total * (unsigned)(blk + 1)) / (unsigned)G);
        int lo_ = 0, hi_ = NB * NH * NBLK - 1;
        while (lo_ < hi_) { const int mid = (lo_ + hi_) >> 1; if (pf[mid] > glo) hi_ = mid; else lo_ = mid + 1; }
        int bhj = __builtin_amdgcn_readfirstlane(lo_); unsigned g = glo;
        while (g < ghi) {
            const unsigned base = (unsigned)__builtin_amdgcn_readfirstlane((int)(bhj ? pf[bhj - 1] : 0u)), lend = (unsigned)__builtin_amdgcn_readfirstlane((int)pf[bhj]);
            const unsigned end = lend < ghi ? lend : ghi;
            const int cnt = __builtin_amdgcn_readfirstlane((int)__hip_atomic_load(&CNT[bhj], __ATOMIC_RELAXED, __HIP_MEMORY_SCOPE_AGENT));
            const int bh = bhj >> 6, j = bhj & 63, b = bh >> 3, hh = bh & 7;
            attn_stage(lds, K + (size_t)(b * S + j * 256) * AW + hh * HD, AW, VT + (size_t)(bh * HD) * S + j * 256, S, TB + hh * 2048, tid);
            __syncthreads();
            const float cbias = ((const LAS float*)(lds + TB_OFF))[2047];
            unsigned gg = g + (unsigned)wave;
            unsigned e1 = (unsigned)(S - 1), e2 = (unsigned)(S - 1); bool v1 = false, v2 = false;
            bf16x8 qn[8];
            if (gg < end) { const int ix = (int)(gg - base) * 32 + l31; v1 = ix < cnt; if (v1) e1 = __hip_atomic_load(&LIST[(size_t)bhj * S + ix], __ATOMIC_RELAXED, __HIP_MEMORY_SCOPE_AGENT); }
            if (gg + 8u < end) { const int ix = (int)(gg + 8u - base) * 32 + l31; v2 = ix < cnt; if (v2) e2 = __hip_atomic_load(&LIST[(size_t)bhj * S + ix], __ATOMIC_RELAXED, __HIP_MEMORY_SCOPE_AGENT); }
            if (gg < end) load_q(qn, Q + (size_t)(b * S + (int)(e1 & 0x3fff)) * AW + hh * HD, hi);
            for (; gg < end; gg += 8u) {
                const unsigned e = e1; const bool valid = v1;
                bf16x8 qf[8];
#pragma unroll
                for (int ks = 0; ks < 8; ++ks) qf[ks] = qn[ks];
                e1 = e2; v1 = v2; e2 = (unsigned)(S - 1); v2 = false;
                if (gg + 16u < end) { const int ix = (int)(gg + 16u - base) * 32 + l31; v2 = ix < cnt; if (v2) e2 = __hip_atomic_load(&LIST[(size_t)bhj * S + ix], __ATOMIC_RELAXED, __HIP_MEMORY_SCOPE_AGENT); }
                if (gg + 8u < end) load_q(qn, Q + (size_t)(b * S + (int)(e1 & 0x3fff)) * AW + hh * HD, hi);
                const int ql = e & 0x3fff, slot = e >> 14, qrow = b * S + ql, qrel = ql - j * 256;
                const bool fast = __all(qrel - 255 >= 1512);
                f32x16 O[4]; float m, l;
                attn_core<0>(lds, qf, qrel, SC, 4, fast, cbias, O, m, l, lane);
                store_o16(PO + ((size_t)slot * T + qrow) * AW + hh * HD, O, 1.0f / l, hi, valid);
                if (valid) {
                    if (hi == 0) __hip_atomic_store((unsigned long long*)PML + ((size_t)(qrow * NH + hh) * 3 + slot), ((unsigned long long)__float_as_uint(l) << 32) | (unsigned long long)__float_as_uint(m), __ATOMIC_RELAXED, __HIP_MEMORY_SCOPE_AGENT);
                }
            }
            __syncthreads();
            g = end; ++bhj;
            while (bhj < NB * NH * NBLK && (unsigned)__builtin_amdgcn_readfirstlane((int)pf[bhj]) == lend) ++bhj;
        }
    }
    SEAM(4);

    for (int rep_ = 0; rep_ < (IN(5) ? 1 + ((REP_MASK >> 5) & 1) : 0); ++rep_) { DECL_PTRS;
        for (int it = blk; it < NB * NH * NBLK; it += G) {
            const int bh = it >> 6, j = it & 63, b = bh >> 3, hh = bh & 7;
            attn_stage(lds, K + (size_t)(b * S + j * 256) * AW + hh * HD, AW, VT + (size_t)(bh * HD) * S + j * 256, S, TB + hh * 2048, tid);
            __syncthreads();
            const int qrel = wave * 32 + l31, qrow = b * S + j * 256 + qrel;
            f32x16 O[4]; float m, l;
            bf16x8 qf[8]; load_q(qf, Q + (size_t)qrow * AW + hh * HD, hi);
            unsigned long long pw[3];
#pragma unroll
            for (int s = 0; s < 3; ++s) { pw[s] = 0ull; if (s < (j < 3 ? j : 3)) pw[s] = __hip_atomic_load((unsigned long long*)PML + ((size_t)(qrow * NH + hh) * 3 + s), __ATOMIC_RELAXED, __HIP_MEMORY_SCOPE_AGENT); }
            attn_core<1>(lds, qf, qrel, SC, (wave >> 1) + 1, false, 0.f, O, m, l, lane);
            const int nsel = j < 3 ? j : 3;
            float M = m, ms[3], lsv[3];
#pragma unroll
            for (int s = 0; s < 3; ++s) { ms[s] = -1e30f; lsv[s] = 0.f; if (s < nsel) { ms[s] = __uint_as_float((unsigned)pw[s]); lsv[s] = __uint_as_float((unsigned)(pw[s] >> 32)); M = fmaxf(M, ms[s]); } }
            const float wown = ex2(m - M); float den = l * wown, wsl[3];
#pragma unroll
            for (int s = 0; s < 3; ++s) { wsl[s] = lsv[s] * ex2(ms[s] - M); den += wsl[s]; }
            const float inv = 1.0f / den;
            bf16* op = AC + (size_t)qrow * DM + hh * HD + 4 * hi;
#pragma unroll
            for (int hf = 0; hf < 2; ++hf) {
                v2u pp[3][2][4];
#pragma unroll
                for (int s = 0; s < 3; ++s) if (s < nsel) {
#pragma unroll
                    for (int d2 = 0; d2 < 2; ++d2)
#pragma unroll
                        for (int g4 = 0; g4 < 4; ++g4) pp[s][d2][g4] = *(const v2u*)(PO + ((size_t)s * T + qrow) * AW + hh * HD + 4 * hi + 32 * (2 * hf + d2) + 8 * g4);
                }
#pragma unroll
                for (int d2 = 0; d2 < 2; ++d2)
#pragma unroll
                    for (int g4 = 0; g4 < 4; ++g4) { const int dt = 2 * hf + d2;
                        float o0 = O[dt][4 * g4] * wown, o1 = O[dt][4 * g4 + 1] * wown, o2 = O[dt][4 * g4 + 2] * wown, o3 = O[dt][4 * g4 + 3] * wown;
#pragma unroll
                        for (int s = 0; s < 3; ++s) if (s < nsel) { const v2u p = pp[s][d2][g4];
                            o0 += wsl[s] * bf_lo(p.x); o1 += wsl[s] * bf_hi(p.x); o2 += wsl[s] * bf_lo(p.y); o3 += wsl[s] * bf_hi(p.y); }
                        v2u w; w.x = pk2(o0 * inv, o1 * inv); w.y = pk2(o2 * inv, o3 * inv); *(v2u*)(op + 32 * dt + 8 * g4) = w;
                    }
            }
            __syncthreads();
        }
    }
    SEAM(5);

#if DBG == 2
    { DECL_PTRS; for (size_t i = (size_t)blk * 512 + tid; i < (size_t)T * DM; i += (size_t)G * 512) out[i] = __uint_as_float(((unsigned)AC[i] << 16)); return; }
#endif
    for (int rep_ = 0; rep_ < (IN(6) ? 1 + ((REP_MASK >> 6) & 1) : 0); ++rep_) { DECL_PTRS;
        pg8::Gemm g{AC, WOUT_T, T, DM, DM}; pg8::StaticOrder So; So.init(T, DM, G, blk);
        pg8::EpiResBf16Ssq<0> E{x, NBUF, DM, SSQ1, nullptr};
        pg8::gemm_phase<pg8::EpiResBf16Ssq<0>, pg8::StaticOrder, true, true>(lds, g, So, E, tid);
    }
    SEAM2(6, 8);
#if DBG == 3
    return;
#endif
    for (int rep_ = 0; rep_ < (IN(8) ? 1 + ((REP_MASK >> 8) & 1) : 0); ++rep_) { DECL_PTRS;
        pg8::Gemm g{NBUF, WQ_T, T, XW, DM}; pg8::StaticOrder So; So.init(T, XW, G, blk);
        pg8::EpiBf16X<0, 1> E{QC, XW, 0, 0, -1, nullptr, 1, 1, SSQ1};
        pg8::gemm_phase<pg8::EpiBf16X<0, 1>, pg8::StaticOrder, true, true>(lds, g, So, E, tid);
    }
    for (int rep_ = 0; rep_ < (IN(9) ? 1 + ((REP_MASK >> 9) & 1) : 0); ++rep_) { DECL_PTRS;
        asm volatile("s_waitcnt vmcnt(0)" ::: "memory"); __syncthreads();
        pg8::StaticOrder So8; So8.init(T, XW, G, blk); pg8::Unit u8;
        for (int ui = 0; So8.next(ui >> 1, u8); ++ui) {
            const int tl = u8.pm, hc = 2 * u8.pn + (ui & 1), b = tl / (S / 256);
            attn_stage(lds, KC + (size_t)(b * NMEM) * XW + hc * HD, XW, VCT + (size_t)((b * XH + hc) * HD) * NMEM, NMEM, nullptr, tid);
            __syncthreads();
            const int qrow = tl * 256 + wave * 32 + l31;
            f32x16 O[4]; float m, l;
            bf16x8 qf[8]; load_q(qf, QC + (size_t)qrow * XW + hc * HD, hi);
            attn_core<2>(lds, qf, 0, SC, 4, false, 0.f, O, m, l, lane);
            store_o16(OC + (size_t)qrow * XW + hc * HD, O, 1.0f / l, hi, true);
            __syncthreads();
        }
    }
    SEAM(9);
#if DBG == 10
    return;
#endif
#if DBG == 7
    { DECL_PTRS; for (size_t i = (size_t)blk * 512 + tid; i < (size_t)T * DM; i += (size_t)G * 512) { const size_t t = i >> 11, c = i & 2047; out[i] = c < 512 ? __uint_as_float(((unsigned)QC[t * 512 + c] << 16)) : 0.f; } return; }
#endif
#if DBG == 8
    { DECL_PTRS; for (size_t i = (size_t)blk * 512 + tid; i < (size_t)T * DM; i += (size_t)G * 512) { const size_t t = i >> 11, c = i & 2047; out[i] = c < 512 ? __uint_as_float(((unsigned)OC[t * 512 + c] << 16)) : 0.f; } return; }
#endif
#if DBG == 5
    { DECL_PTRS; for (size_t i = (size_t)blk * 512 + tid; i < (size_t)T * DM; i += (size_t)G * 512) { const size_t t = i >> 11, c = i & 2047; out[i] = c < 512 ? __uint_as_float(((unsigned)OC[t * 512 + c] << 16)) : (c < 1024 ? __uint_as_float(((unsigned)QC[t * 512 + c - 512] << 16)) : 0.f); } return; }
#endif
    for (int rep_ = 0; rep_ < (IN(10) ? 1 + ((REP_MASK >> 10) & 1) : 0); ++rep_) { DECL_PTRS;
        pg8::Gemm g{OC, WO_T, T, DM, XW}; pg8::StaticOrder So; So.init(T, DM, G, blk);
        pg8::EpiResBf16Ssq<1> E{NBUF, NBUF, DM, SSQ2, nullptr};
        pg8::gemm_phase<pg8::EpiResBf16Ssq<1>, pg8::StaticOrder, true, true>(lds, g, So, E, tid);
    }
    SEAM2(10, 12);
#if DBG == 4
    return;
#endif
    for (int rep_ = 0; rep_ < (IN(12) ? 1 + ((REP_MASK >> 12) & 1) : 0); ++rep_) { DECL_PTRS;
        pg8::Gemm g{NBUF, W1_T, T, FF, DM}; pg8::StaticOrder So; So.init(T, FF, G, blk);
        pg8::EpiBf16X<2, 0> E{FB, FF, 0, 0, -1, nullptr, 1, 1, nullptr};
        pg8::gemm_phase<pg8::EpiBf16X<2, 0>, pg8::StaticOrder, true, true>(lds, g, So, E, tid);
    }
    SEAM(12);
    for (int rep_ = 0; rep_ < (IN(13) ? 1 + ((REP_MASK >> 13) & 1) : 0); ++rep_) { DECL_PTRS;
        pg8::Gemm g{FB, W2_T, T, DM, FF}; pg8::StaticOrder So; So.init(T, DM, G, blk);
        pg8::EpiResBf16Ssq<1, 1> E{NBUF, NBUF, DM, SSQ3, SSQ2};
        pg8::gemm_phase<pg8::EpiResBf16Ssq<1, 1>, pg8::StaticOrder, true, true>(lds, g, So, E, tid);
    }
    SEAM(13);
    for (int rep_ = 0; rep_ < (IN(14) ? 1 : 0); ++rep_) { DECL_PTRS;
        const int gw = blk * 8 + wave, NGW = G * 8;
        f32x4 gv[8];
#pragma unroll
        for (int jj = 0; jj < 8; ++jj) gv[jj] = ((const f32x4*)g_final)[lane + 64 * jj];
        for (int mrow = gw; mrow < T; mrow += NGW) {
            const float rstd = 1.0f / sqrtf(SSQ3[mrow] * (1.0f / DM) + EPS);
            const v2u* hr = (const v2u*)(NBUF + (size_t)mrow * DM) + lane; f32x4* o = (f32x4*)(out + (size_t)mrow * DM) + lane;
            v2u hv[8];
#pragma unroll
            for (int jj = 0; jj < 8; ++jj) hv[jj] = hr[64 * jj];
#pragma unroll
            for (int jj = 0; jj < 8; ++jj) o[64 * jj] = (f32x4){bf_lo(hv[jj].x) * rstd * gv[jj].x, bf_hi(hv[jj].x) * rstd * gv[jj].y, bf_lo(hv[jj].y) * rstd * gv[jj].z, bf_hi(hv[jj].y) * rstd * gv[jj].w};
        }
    }
#undef IN
#undef SEAM
}

extern "C" void kernel_launch(void* const* d_in, const int* in_sizes, int n_in, void* d_out, int out_size, void* d_ws, size_t ws_size, hipStream_t stream) {
    static int grid = 0;
    if (grid == 0) {
        if (n_in != 20 || out_size != T * DM || ws_size < WS_END) { fprintf(stderr, "kernel_launch: unexpected sizes n_in %d out %d ws %zu\n", n_in, out_size, ws_size); grid = -1; return; }
        int dev = 0, cus = 0, per_cu = 0;
        (void)hipGetDevice(&dev); (void)hipDeviceGetAttribute(&cus, hipDeviceAttributeMultiprocessorCount, dev);
        (void)hipFuncSetAttribute((const void*)fwd, hipFuncAttributeMaxDynamicSharedMemorySize, LDS_BYTES);
        (void)hipOccupancyMaxActiveBlocksPerMultiprocessor(&per_cu, (const void*)fwd, 512, LDS_BYTES);
        if (per_cu < 1) { fprintf(stderr, "kernel_launch: occupancy query says %d blocks per CU\n", per_cu); per_cu = 1; }
        grid = cus;
        (void)hipGetLastError();
    }
    if (grid < 0) return;
    if (hipMemsetAsync((char*)d_ws + WS_CTL, 0, 1048576, stream) != hipSuccess) { fprintf(stderr, "kernel_launch: memset failed\n"); return; }
    Args a{};
    for (int i = 0; i < 20; ++i) a.in[i] = (const float*)d_in[i];
    a.out = (float*)d_out; a.ws = (unsigned char*)d_ws;
#if MK_PER_PHASE
    for (int p = 0; p < NPHASE; ++p) { if (p == 7 || p == 11) continue; a.ph_lo = p; a.ph_hi = p + 1; hipLaunchKernelGGL(fwd, dim3(grid), dim3(512), LDS_BYTES, stream, a); }
#else
    a.ph_lo = 0; a.ph_hi = NPHASE;
    void* args[] = {&a};
    hipError_t e = hipLaunchCooperativeKernel((const void*)fwd, dim3(grid), dim3(512), args, LDS_BYTES, stream);
    if (e != hipSuccess) fprintf(stderr, "kernel_launch: cooperative launch failed: %s (grid %d)\n", hipGetErrorString(e), grid);
#endif
}
```

```cpp
#include <hip/hip_runtime.h>
#include <cstdio>
#include <cstdint>
namespace pg8 {
#define PG8_LAS __attribute__((address_space(3)))
typedef unsigned short bf16_t;
typedef short bf16x8 __attribute__((ext_vector_type(8)));
typedef float f32x4 __attribute__((ext_vector_type(4)));
typedef unsigned u32x4 __attribute__((ext_vector_type(4)));
constexpr int BM = 256, BK = 64, HALF = 128, HTB = HALF * BK * 2  , STAGE_BYTES = 8 * HTB, NXCD = 8, WGM = 8;

__host__ __device__ __forceinline__ int lds_byte(int r, int c) { const int st = (r >> 4) * 2 + (c >> 5), rr = r & 15, cc = c & 31, ob = rr * 64 + cc * 2; return st * 1024 + (ob ^ (((ob >> 9) & 1) << 5)); }
__host__ __device__ __forceinline__ void stage_rc(int b, int& R, int& C) { const int st = b / 1024, sb = b % 1024, swz = sb ^ (((sb >> 9) & 1) << 5); R = (st >> 1) * 16 + swz / 64; C = (st & 1) * 32 + (swz % 64) / 2; }
__host__ __device__ __forceinline__ int perm32(int rho) { const int n = rho >> 4, i = rho & 15; return 8 * (i >> 2) + 4 * n + (i & 3); }

struct Unit { int pm, pn; };
struct Gemm { const bf16_t* A; const bf16_t* Bt; int M, N, K; };

struct StaticOrder {
    int nM, nN, nwg, G, c;
    __host__ __device__ void init(int M, int N, int G_, int c_) { nM = M / BM; nN = N / BM; nwg = nM * nN; G = G_; c = c_; }
    __host__ __device__ bool next(int i, Unit& u) const {
        const long L = (long)i * G + c; if (L >= nwg) return false;
        int wgid = (int)L; { const int q = nwg / NXCD, r = nwg % NXCD, xcd = wgid % NXCD, off = wgid / NXCD; wgid = (xcd < r ? xcd * (q + 1) : r * (q + 1) + (xcd - r) * q) + off; }
        const int nig = WGM * nN, gid = wgid / nig, fm = gid * WGM, gsz = (nM - fm) < WGM ? (nM - fm) : WGM;
        u.pm = fm + ((wgid % nig) % gsz); u.pn = (wgid % nig) / gsz; return true;
    }
    __device__ __forceinline__ void a_ready(const Unit&) const {}
    __device__ __forceinline__ void done(const Unit&) const {}
};

__device__ __forceinline__ unsigned cvt_pk_bf16(float lo, float hi) { unsigned r; asm volatile("v_cvt_pk_bf16_f32 %0, %1, %2" : "=v"(r) : "v"(lo), "v"(hi)); return r; }
typedef float f32x2 __attribute__((ext_vector_type(2)));
__device__ __forceinline__ f32x2 gelu_pk(f32x2 v) {
    const f32x2 av = __builtin_elementwise_abs(v), d = av * 0.2316418882f + 1.0f;
    f32x2 t; t.x = __builtin_amdgcn_rcpf(d.x); t.y = __builtin_amdgcn_rcpf(d.y);
    f32x2 q = t * 0.5307027145f + (-0.7265760135f); q = q * t + 0.7107068705f; q = q * t + (-0.142248368f); q = q * t + 0.127414796f; q = q * t;
    const f32x2 s = (v * v) * (-0.72134752044f);
    f32x2 e; e.x = __builtin_amdgcn_exp2f(s.x); e.y = __builtin_amdgcn_exp2f(s.y);
    const f32x2 m = v * (q * e), r = v - m;
    f32x2 o; o.x = v.x < 0.f ? m.x : r.x; o.y = v.y < 0.f ? m.y : r.y; return o;
}


__device__ __forceinline__ unsigned short bf16_1(float v) { return (unsigned short)(cvt_pk_bf16(v, v) & 0xffffu); }
template <int ACT  , int RS = 0  > struct EpiBf16X {
    static constexpr bool PERM = true, AFTER_DRAIN = false;
    bf16_t* O; int ldc; int split_cols; size_t split_stride; int tr_tile; bf16_t* OT; int seqlen; int nheads; const float* ssq;
    __device__ __forceinline__ void operator()(const f32x4 (&acc)[2][2][4][2], const Unit& u, int wr, int wc, int fr, int fq) const {
        const int row0 = u.pm * BM + wr * 64 + fr; int colt = u.pn * BM; bf16_t* base = O; int t = 0;
        if (split_cols) { t = colt / split_cols; base += (size_t)t * split_stride; colt -= t * split_cols; }
        const int col0 = colt + wc * 32 + 8 * fq;
        if (RS == 0 && t == tr_tile) {
#pragma unroll
            for (int ai = 0; ai < 2; ++ai)
#pragma unroll
                for (int m = 0; m < 4; ++m) { const int row = row0 + ai * HALF + m * 16; const int b = row / seqlen, s = row - b * seqlen;
#pragma unroll
                    for (int bj = 0; bj < 2; ++bj)
#pragma unroll
                        for (int n = 0; n < 2; ++n)
#pragma unroll
                            for (int j = 0; j < 4; ++j) { const int col = col0 + bj * HALF + 4 * n + j; const int hh = col >> 7, d = col & 127;
                                OT[((size_t)(b * nheads + hh) * 128 + d) * (size_t)seqlen + s] = bf16_1(acc[ai][bj][m][n][j]); } }
        } else {
#pragma unroll
            for (int ai = 0; ai < 2; ++ai)
#pragma unroll
                for (int m = 0; m < 4; ++m) { bf16_t* rowp = base + (size_t)(row0 + ai * HALF + m * 16) * ldc + col0;
                    float rsc = 1.f;
                    if (RS) { const float r = 1.0f / sqrtf(ssq[row0 + ai * HALF + m * 16] * (1.0f / 2048.0f) + 1e-6f); rsc = (ACT == 2) ? r * r : r; }
#pragma unroll
                    for (int bj = 0; bj < 2; ++bj) { f32x4 v0 = acc[ai][bj][m][0], v1 = acc[ai][bj][m][1];
                        if (RS && ACT != 2) { v0 = v0 * rsc; v1 = v1 * rsc; }
                        if (ACT == 2) {
#pragma unroll
                            for (int j = 0; j < 4; ++j) { float a = v0[j] > 0.f ? v0[j] : 0.f; v0[j] = a * a * rsc; float b = v1[j] > 0.f ? v1[j] : 0.f; v1[j] = b * b * rsc; } }
                        u32x4 w; w.x = cvt_pk_bf16(v0[0], v0[1]); w.y = cvt_pk_bf16(v0[2], v0[3]); w.z = cvt_pk_bf16(v1[0], v1[1]); w.w = cvt_pk_bf16(v1[2], v1[3]);
                        *(u32x4*)(rowp + bj * HALF) = w; } }
        }
    }
};
struct EpiResNorm {
    static constexpr bool PERM = false, AFTER_DRAIN = false;
    const float* base; float* out; int ldc; const float* gain; bf16_t* HG; float* ssq;
    __device__ __forceinline__ void operator()(const f32x4 (&acc)[2][2][4][2], const Unit& u, int wr, int wc, int fr, int fq) const {
        const int row0 = u.pm * BM + wr * 64 + fr, col0 = u.pn * BM + wc * 32 + 4 * fq;
        f32x4 gv[2][2];
#pragma unroll
        for (int bj = 0; bj < 2; ++bj)
#pragma unroll
            for (int n = 0; n < 2; ++n) gv[bj][n] = *(const f32x4*)(gain + col0 + bj * HALF + n * 16);
#pragma unroll
        for (int ai = 0; ai < 2; ++ai)
#pragma unroll
            for (int m = 0; m < 4; ++m) { const int row = row0 + ai * HALF + m * 16; const size_t off = (size_t)row * ldc + col0; float sq = 0.f;
#pragma unroll
                for (int bj = 0; bj < 2; ++bj)
#pragma unroll
                    for (int n = 0; n < 2; ++n) { const f32x4 h = *(const f32x4*)(base + off + bj * HALF + n * 16) + acc[ai][bj][m][n]; *(f32x4*)(out + off + bj * HALF + n * 16) = h;
                        sq += (h[0] * h[0] + h[1] * h[1]) + (h[2] * h[2] + h[3] * h[3]);
                        const f32x4 hg = h * gv[bj][n]; unsigned w0 = cvt_pk_bf16(hg[0], hg[1]), w1 = cvt_pk_bf16(hg[2], hg[3]);
                        typedef unsigned u32x2v __attribute__((ext_vector_type(2))); u32x2v w; w.x = w0; w.y = w1; *(u32x2v*)(HG + off + bj * HALF + n * 16) = w; }
                sq += __shfl_xor(sq, 16); sq += __shfl_xor(sq, 32);
                if (fq == 0) unsafeAtomicAdd(ssq + row, sq); }
    }
};
template <int B16  , int RS2 = 0  > struct EpiResBf16Ssq {
    static constexpr bool PERM = true, AFTER_DRAIN = false;
    const void* base; bf16_t* HB; int ldc; float* ssq; const float* ssq_in;
    __device__ __forceinline__ void operator()(const f32x4 (&acc)[2][2][4][2], const Unit& u, int wr, int wc, int fr, int fq) const {
        const int row0 = u.pm * BM + wr * 64 + fr, col0 = u.pn * BM + wc * 32 + 8 * fq;
        float rq[2][4], sqv[2][4];
#pragma unroll
        for (int ai = 0; ai < 2; ++ai)
#pragma unroll
            for (int m = 0; m < 4; ++m) rq[ai][m] = RS2 ? ssq_in[row0 + ai * HALF + m * 16] : 0.f;
#pragma unroll
        for (int ai = 0; ai < 2; ++ai)
#pragma unroll
            for (int m = 0; m < 4; ++m) { const int row = row0 + ai * HALF + m * 16; const size_t off = (size_t)row * ldc + col0; float sq = 0.f;
                float rs2 = 1.f; if (RS2) rs2 = 1.0f / (rq[ai][m] * (1.0f / 2048.0f) + 1e-6f);
#pragma unroll
                for (int bj = 0; bj < 2; ++bj) { f32x4 b0, b1;
                    if (B16) { const u32x4 bw = *(const u32x4*)((const bf16_t*)base + off + bj * HALF);
                        b0 = (f32x4){__uint_as_float(bw.x << 16), __uint_as_float(bw.x & 0xffff0000u), __uint_as_float(bw.y << 16), __uint_as_float(bw.y & 0xffff0000u)};
                        b1 = (f32x4){__uint_as_float(bw.z << 16), __uint_as_float(bw.z & 0xffff0000u), __uint_as_float(bw.w << 16), __uint_as_float(bw.w & 0xffff0000u)}; }
                    else { b0 = *(const f32x4*)((const float*)base + off + bj * HALF); b1 = *(const f32x4*)((const float*)base + off + bj * HALF + 4); }
                    const f32x4 h0 = RS2 ? b0 + acc[ai][bj][m][0] * rs2 : b0 + acc[ai][bj][m][0], h1 = RS2 ? b1 + acc[ai][bj][m][1] * rs2 : b1 + acc[ai][bj][m][1];
                    sq += ((h0[0] * h0[0] + h0[1] * h0[1]) + (h0[2] * h0[2] + h0[3] * h0[3])) + ((h1[0] * h1[0] + h1[1] * h1[1]) + (h1[2] * h1[2] + h1[3] * h1[3]));
                    u32x4 w; w.x = cvt_pk_bf16(h0[0], h0[1]); w.y = cvt_pk_bf16(h0[2], h0[3]); w.z = cvt_pk_bf16(h1[0], h1[1]); w.w = cvt_pk_bf16(h1[2], h1[3]);
                    *(u32x4*)(HB + off + bj * HALF) = w; }
                sqv[ai][m] = sq; }
#pragma unroll
        for (int ai = 0; ai < 2; ++ai)
#pragma unroll
            for (int m = 0; m < 4; ++m) { float sq = sqv[ai][m]; sq += __shfl_xor(sq, 16); sq += __shfl_xor(sq, 32); if (fq == 0) unsafeAtomicAdd(ssq + row0 + ai * HALF + m * 16, sq); }
    }
};
struct EpiResF32 {
    static constexpr bool PERM = false, AFTER_DRAIN = false;
    const float* base; float* out; int ldc;
    __device__ __forceinline__ void operator()(const f32x4 (&acc)[2][2][4][2], const Unit& u, int wr, int wc, int fr, int fq) const {
        const int row0 = u.pm * BM + wr * 64 + fr, col0 = u.pn * BM + wc * 32 + 4 * fq;
#pragma unroll
        for (int ai = 0; ai < 2; ++ai)
#pragma unroll
            for (int m = 0; m < 4; ++m) { const size_t off = (size_t)(row0 + ai * HALF + m * 16) * ldc + col0;
#pragma unroll
                for (int bj = 0; bj < 2; ++bj)
#pragma unroll
                    for (int n = 0; n < 2; ++n) { const f32x4 bs = *(const f32x4*)(base + off + bj * HALF + n * 16); *(f32x4*)(out + off + bj * HALF + n * 16) = bs + acc[ai][bj][m][n]; } }
    }
};

template <class Epi, class Sched, bool ALIGN_EPI = false, bool SP2 = false>
__device__ __forceinline__ void gemm_phase(PG8_LAS unsigned char* lds, const Gemm g, const Sched& S, const Epi& E, const int tid) {
    const int wid = __builtin_amdgcn_readfirstlane(tid >> 6), lane = tid & 63, wr = wid >> 2, wc = wid & 3, fr = lane & 15, fq = lane >> 4;
    const int K = g.K, nt = K / BK;
    unsigned voffA[2], voffB[2];
#pragma unroll
    for (int i = 0; i < 2; ++i) { int R, C; stage_rc(tid * 16 + i * 8192, R, C); const int Rb = Epi::PERM ? ((R & ~31) + perm32(R & 31)) : R;
        voffA[i] = (unsigned)(R * K + C) * 2u; voffB[i] = (unsigned)(Rb * K + C) * 2u; }
    const size_t kstep = (size_t)(BK * 2);
    const size_t hstep = (size_t)HALF * K * 2;
    const size_t tstep = 2 * hstep;
    const unsigned ldsw = (unsigned)wid * 1024u;
    const int aoff = lds_byte(wr * 64 + fr, fq * 8), boff = lds_byte(wc * 32 + fr, fq * 8);
#define PG8_SA(b, h) (((b) * 2 + (h)) * HTB)
#define PG8_SB(b, h) ((4 + (b) * 2 + (h)) * HTB)
#define PG8_STAGE(bufoff, gbase, voff) do { _Pragma("unroll") for (int _i = 0; _i < 2; ++_i) \
        __builtin_amdgcn_global_load_lds((const unsigned*)((const char*)(gbase) + (voff)[_i]), (PG8_LAS unsigned*)(lds + (bufoff) + ldsw + _i * 8192), 16, 0, 0); } while (0)
#define PG8_LDA(dst, b, h) do { _Pragma("unroll") for (int m = 0; m < 4; ++m) _Pragma("unroll") for (int k = 0; k < 2; ++k) dst[m][k] = *(const PG8_LAS bf16x8*)(lds + PG8_SA(b, h) + aoff + m * 2048 + k * 1024); } while (0)
#define PG8_LDB(dst, b, h) do { _Pragma("unroll") for (int n = 0; n < 2; ++n) _Pragma("unroll") for (int k = 0; k < 2; ++k) dst[n][k] = *(const PG8_LAS bf16x8*)(lds + PG8_SB(b, h) + boff + n * 2048 + k * 1024); } while (0)
#define PG8_MMA(ai, bj, At, Bt) do { __builtin_amdgcn_s_setprio(1); _Pragma("unroll") for (int m = 0; m < 4; ++m) _Pragma("unroll") for (int n = 0; n < 2; ++n) _Pragma("unroll") for (int k = 0; k < 2; ++k) \
        acc[ai][bj][m][n] = __builtin_amdgcn_mfma_f32_16x16x32_bf16(Bt[n][k], At[m][k], acc[ai][bj][m][n], 0, 0, 0); __builtin_amdgcn_s_setprio(0); } while (0)
#define PG8_WAIT_V(n) asm volatile("s_waitcnt vmcnt(" #n ")" ::: "memory")
#define PG8_WAIT_L(n) asm volatile("s_waitcnt lgkmcnt(" #n ")" ::: "memory")
#define PG8_BAR __builtin_amdgcn_s_barrier()
#define PG8_SCHED __builtin_amdgcn_sched_barrier(0)
    Unit cur, nxt; int ui = 0;
    if (!S.next(0, cur)) return;
    f32x4 acc[2][2][4][2];
#pragma unroll
    for (int a = 0; a < 2; ++a)
#pragma unroll
        for (int b = 0; b < 2; ++b)
#pragma unroll
            for (int m = 0; m < 4; ++m)
#pragma unroll
                for (int n = 0; n < 2; ++n) acc[a][b][m][n] = (f32x4){0.f, 0.f, 0.f, 0.f};
    bf16x8 At[4][2], B0[2][2], B1[2][2];
    const char* cA = (const char*)g.A + (size_t)cur.pm * tstep; const char* cB = (const char*)g.Bt + (size_t)cur.pn * tstep;
    S.a_ready(cur);
    if constexpr (SP2) {
        PG8_STAGE(PG8_SB(0, 0), cB, voffB); PG8_STAGE(PG8_SB(0, 1), cB + hstep, voffB); PG8_STAGE(PG8_SA(0, 0), cA, voffA); PG8_STAGE(PG8_SA(0, 1), cA + hstep, voffA);
        if (wr == 1) PG8_BAR;
        PG8_WAIT_V(2); PG8_BAR;
        PG8_STAGE(PG8_SB(1, 0), cB + kstep, voffB); PG8_STAGE(PG8_SA(1, 0), cA + kstep, voffA); PG8_STAGE(PG8_SB(1, 1), cB + hstep + kstep, voffB);
        PG8_WAIT_V(6); PG8_BAR;
    } else {
        PG8_STAGE(PG8_SB(0, 0), cB, voffB); PG8_STAGE(PG8_SA(0, 0), cA, voffA); PG8_STAGE(PG8_SB(0, 1), cB + hstep, voffB); PG8_STAGE(PG8_SA(0, 1), cA + hstep, voffA);
        if (wr == 1) PG8_BAR;
        PG8_WAIT_V(4); PG8_BAR;
        PG8_STAGE(PG8_SB(1, 0), cB + kstep, voffB); PG8_STAGE(PG8_SA(1, 0), cA + kstep, voffA); PG8_STAGE(PG8_SB(1, 1), cB + hstep + kstep, voffB);
        PG8_WAIT_V(6); PG8_BAR;
    }
    for (;;) {
        const bool has_next = S.next(ui + 1, nxt);
        const char* nA = has_next ? (const char*)g.A + (size_t)nxt.pm * tstep : cA; const char* nB = has_next ? (const char*)g.Bt + (size_t)nxt.pn * tstep : cB;
        for (int t = 0; t < nt; t += 2) {
            const bool last = (t == nt - 2);
            const char* a1 = cA + (size_t)(t + 1) * kstep;
            const char* a2 = last ? nA : cA + (size_t)(t + 2) * kstep; const char* b2 = last ? nB : cB + (size_t)(t + 2) * kstep;
            const char* a3 = a2 + kstep; const char* b3 = b2 + kstep;
            if (last && has_next) S.a_ready(nxt);
            if constexpr (SP2) {
            PG8_LDB(B0, 0, 0); PG8_LDB(B1, 0, 1); PG8_SCHED; PG8_LDA(At, 0, 0); PG8_STAGE(PG8_SA(1, 1), a1 + hstep, voffA);
            PG8_WAIT_V(8); PG8_WAIT_L(0); PG8_BAR; PG8_MMA(0, 0, At, B0); PG8_MMA(0, 1, At, B1); PG8_BAR; PG8_SCHED;
            PG8_LDA(At, 0, 1); PG8_STAGE(PG8_SB(0, 0), b2, voffB); PG8_STAGE(PG8_SB(0, 1), b2 + hstep, voffB); PG8_STAGE(PG8_SA(0, 0), a2, voffA);
            PG8_WAIT_V(8); PG8_WAIT_L(0); PG8_BAR; PG8_MMA(1, 0, At, B0); PG8_MMA(1, 1, At, B1); PG8_BAR; PG8_SCHED;
            PG8_LDB(B0, 1, 0); PG8_LDB(B1, 1, 1); PG8_SCHED; PG8_LDA(At, 1, 0); PG8_STAGE(PG8_SA(0, 1), a2 + hstep, voffA);
            PG8_WAIT_V(8); PG8_WAIT_L(0); PG8_BAR; PG8_MMA(0, 0, At, B0); PG8_MMA(0, 1, At, B1); PG8_BAR; PG8_SCHED;
            PG8_LDA(At, 1, 1); PG8_STAGE(PG8_SB(1, 0), b3, voffB); PG8_STAGE(PG8_SB(1, 1), b3 + hstep, voffB); PG8_STAGE(PG8_SA(1, 0), a3, voffA);
            PG8_WAIT_V(8); PG8_WAIT_L(0); PG8_BAR; PG8_MMA(1, 0, At, B0); PG8_MMA(1, 1, At, B1); PG8_BAR; PG8_SCHED;
            } else {
            PG8_LDB(B0, 0, 0); PG8_SCHED; PG8_LDA(At, 0, 0); PG8_STAGE(PG8_SA(1, 1), a1 + hstep, voffA);
            PG8_WAIT_L(8); PG8_BAR; PG8_WAIT_L(0); PG8_MMA(0, 0, At, B0); PG8_BAR; PG8_SCHED;
            PG8_LDB(B1, 0, 1); PG8_STAGE(PG8_SB(0, 0), b2, voffB);
            PG8_BAR; PG8_WAIT_L(0); PG8_MMA(0, 1, At, B1); PG8_BAR;
            PG8_LDA(At, 0, 1); PG8_STAGE(PG8_SA(0, 0), a2, voffA);
            PG8_BAR; PG8_WAIT_L(0); PG8_MMA(1, 0, At, B0); PG8_BAR; PG8_SCHED;
            PG8_STAGE(PG8_SB(0, 1), b2 + hstep, voffB);
            PG8_WAIT_V(6); PG8_BAR; PG8_MMA(1, 1, At, B1); PG8_BAR;
            PG8_LDB(B0, 1, 0); PG8_SCHED; PG8_LDA(At, 1, 0); PG8_STAGE(PG8_SA(0, 1), a2 + hstep, voffA);
            PG8_WAIT_L(8); PG8_BAR; PG8_WAIT_L(0); PG8_MMA(0, 0, At, B0); PG8_BAR; PG8_SCHED;
            PG8_LDB(B1, 1, 1); PG8_STAGE(PG8_SB(1, 0), b3, voffB);
            PG8_BAR; PG8_WAIT_L(0); PG8_MMA(0, 1, At, B1); PG8_BAR;
            PG8_LDA(At, 1, 1); PG8_STAGE(PG8_SA(1, 0), a3, voffA);
            PG8_BAR; PG8_WAIT_L(0); PG8_MMA(1, 0, At, B0); PG8_BAR; PG8_SCHED;
            PG8_STAGE(PG8_SB(1, 1), b3 + hstep, voffB);
            PG8_WAIT_V(6); PG8_BAR; PG8_MMA(1, 1, At, B1); PG8_BAR;
            }
        }
        if constexpr (ALIGN_EPI) { if (wr == 0) PG8_BAR; }
        if constexpr (!Epi::AFTER_DRAIN) { E(acc, cur, wr, wc, fr, fq); S.done(cur); }
        if (!has_next) break;
#pragma unroll
        for (int a = 0; a < 2; ++a)
#pragma unroll
            for (int b = 0; b < 2; ++b)
#pragma unroll
                for (int m = 0; m < 4; ++m)
#pragma unroll
                    for (int n = 0; n < 2; ++n) acc[a][b][m][n] = (f32x4){0.f, 0.f, 0.f, 0.f};
        cur = nxt; cA = nA; cB = nB; ++ui;
        if constexpr (ALIGN_EPI) { if (wr == 1) PG8_BAR; }
    }
    PG8_WAIT_V(0);
    if constexpr (!ALIGN_EPI) { if (wr == 0) PG8_BAR; }
    PG8_BAR;
    if constexpr (Epi::AFTER_DRAIN) { E.fused(acc, cur, wr, wc, fr, fq, lds, wid, lane); S.done(cur); }
#undef PG8_SA
#undef PG8_SB
#undef PG8_STAGE
#undef PG8_LDA
#undef PG8_LDB
#undef PG8_MMA
#undef PG8_WAIT_V
#undef PG8_WAIT_L
#undef PG8_BAR
#undef PG8_SCHED
}
}

#include <hip/hip_cooperative_groups.h>
namespace cg = cooperative_groups;
#define LAS __attribute__((address_space(3)))
typedef unsigned short bf16;
typedef unsigned v4u __attribute__((ext_vector_type(4)));
typedef unsigned v2u __attribute__((ext_vector_type(2)));
typedef float f32x4 __attribute__((ext_vector_type(4)));
typedef float f32x2 __attribute__((ext_vector_type(2)));
typedef float f32x16 __attribute__((ext_vector_type(16)));
typedef short bf16x8 __attribute__((ext_vector_type(8)));

#ifndef MK_PER_PHASE
#define MK_PER_PHASE 0
#endif
constexpr int NB = 2, S = 16384, DM = 2048, T = NB * S, NH = 8, HD = 128, AW = 1024, CC = 1024, INW = 5120, FF = 8192, NMEM = 256, XH = 4, XW = 512, CONVK = 31, NBLK = 64;
constexpr float EPS = 1e-6f, LOG2E = 1.4426950408889634f;
constexpr int NPHASE = 15;
constexpr size_t MiB = 1u << 20;
constexpr size_t WS_CTL = 0; constexpr int CW_BAR = 4096;
constexpr size_t WS_WIN = 2 * MiB, WS_WOUT = 22 * MiB, WS_WQ = 30 * MiB, WS_WKV = 32 * MiB, WS_WO = 36 * MiB, WS_W1 = 38 * MiB, WS_W2 = 70 * MiB;
constexpr size_t WS_KBAR = 102 * MiB, WS_TB = 103 * MiB, WS_MN = 104 * MiB, WS_KC = 106 * MiB, WS_VCT = 107 * MiB;
constexpr size_t WS_NB = 112 * MiB;
constexpr size_t WS_Q = 240 * MiB, WS_K = 304 * MiB, WS_VT = 368 * MiB, WS_UV = 432 * MiB, WS_UG = 496 * MiB;
constexpr size_t WS_AC = 560 * MiB;
constexpr size_t WS_F = 240 * MiB;
constexpr size_t WS_QC = 240 * MiB, WS_OC = 272 * MiB;
constexpr size_t WS_PO = 752 * MiB;
constexpr size_t WS_PML = 944 * MiB;
constexpr size_t WS_LIST = 952 * MiB;
constexpr size_t WS_END = 1016 * MiB;
constexpr int LDS_BYTES = 152064;
constexpr int KS_OFF = 0, KROW = 272, VS_OFF = 256 * 272, VROW = 528  , TB_OFF = VS_OFF + 128 * 528, RED_OFF = TB_OFF + 8192, CNT_OFF = RED_OFF + 2048, PT_OFF = CNT_OFF + 4096, ST_OFF = PT_OFF + 192;
static_assert(PT_OFF + 256 <= LDS_BYTES, "LDS map");

__device__ __forceinline__ float bf_lo(unsigned w) { return __uint_as_float(w << 16); }
__device__ __forceinline__ float bf_hi(unsigned w) { return __uint_as_float(w & 0xffff0000u); }
typedef __bf16 bf16x2_t __attribute__((ext_vector_type(2)));
__device__ __forceinline__ unsigned pk2(float lo, float hi) { return pg8::cvt_pk_bf16(lo, hi); }
__device__ __forceinline__ unsigned pk2s(float lo, float hi) { f32x2 v = {lo, hi}; bf16x2_t b = __builtin_convertvector(v, bf16x2_t); return __builtin_bit_cast(unsigned, b); }
__device__ __forceinline__ float ex2(float x) { return __builtin_amdgcn_exp2f(x); }
__device__ __forceinline__ float wave_sum(float v) {
#pragma unroll
    for (int o = 1; o < 64; o <<= 1) v += __shfl_xor(v, o);
    return v;
}
__device__ __forceinline__ float sigmoidf_(float x) { return 1.0f / (1.0f + __expf(-x)); }

__device__ __forceinline__ void p0_transpose_item(const float* W, int K, int N, bf16* WT, int row_off, LAS float* scr, int item, int lane, const float* gk = nullptr) {
    const int nblk = N / 32, kb = item / nblk, nb = item % nblk, k0 = 64 * kb, n0 = 32 * nb;
    float wv[32];
#pragma unroll
    for (int i = 0; i < 32; ++i) { const int kk = 2 * i + (lane >> 5); wv[i] = W[(size_t)(k0 + kk) * N + n0 + (lane & 31)]; }
    if (gk) {
#pragma unroll
        for (int i = 0; i < 32; ++i) wv[i] *= gk[k0 + 2 * i + (lane >> 5)];
    }
#pragma unroll
    for (int i = 0; i < 32; ++i) { const int kk = 2 * i + (lane >> 5); scr[kk * 33 + (lane & 31)] = wv[i]; }
    asm volatile("s_waitcnt lgkmcnt(0)" ::: "memory");
    const int c = lane & 7;
#pragma unroll
    for (int j = 0; j < 4; ++j) { const int n = (lane >> 3) + 8 * j; const LAS float* s = scr + (8 * c) * 33 + n;
        v4u o; o.x = pk2(s[0 * 33], s[1 * 33]); o.y = pk2(s[2 * 33], s[3 * 33]); o.z = pk2(s[4 * 33], s[5 * 33]); o.w = pk2(s[6 * 33], s[7 * 33]);
        *(v4u*)(WT + (size_t)(row_off + n0 + n) * K + k0 + 8 * c) = o; }
    asm volatile("s_waitcnt lgkmcnt(0)" ::: "memory");
}
__device__ __forceinline__ void rms_row_bf16(const float* xrow, const float* g, bf16* orow, int lane) {
    const f32x4* xr = (const f32x4*)xrow + lane; f32x4 v[8]; float s = 0.f;
#pragma unroll
    for (int j = 0; j < 8; ++j) { v[j] = xr[64 * j]; s += (v[j].x * v[j].x + v[j].y * v[j].y) + (v[j].z * v[j].z + v[j].w * v[j].w); }
    const float rstd = 1.0f / sqrtf(wave_sum(s) * (1.0f / DM) + EPS);
    const f32x4* gr = (const f32x4*)g + lane; v2u* o8 = (v2u*)orow + lane;
#pragma unroll
    for (int j = 0; j < 8; ++j) { const f32x4 gv = gr[64 * j]; v2u w; w.x = pk2(v[j].x * rstd * gv.x, v[j].y * rstd * gv.y); w.y = pk2(v[j].z * rstd * gv.z, v[j].w * rstd * gv.w); o8[64 * j] = w; }
}
__device__ __forceinline__ void rms_row_f32(const float* xrow, const float* g, float* orow, int lane) {
    const f32x4* xr = (const f32x4*)xrow + lane; f32x4 v[8]; float s = 0.f;
#pragma unroll
    for (int j = 0; j < 8; ++j) { v[j] = xr[64 * j]; s += (v[j].x * v[j].x + v[j].y * v[j].y) + (v[j].z * v[j].z + v[j].w * v[j].w); }
    const float rstd = 1.0f / sqrtf(wave_sum(s) * (1.0f / DM) + EPS);
    const f32x4* gr = (const f32x4*)g + lane; f32x4* o = (f32x4*)orow + lane;
#pragma unroll
    for (int j = 0; j < 8; ++j) { const f32x4 gv = gr[64 * j]; o[64 * j] = v[j] * rstd * gv; }
}

__device__ __forceinline__ int crow(int r, int hi) { return (r & 3) + 8 * (r >> 2) + 4 * hi; }
__device__ __forceinline__ void attn_stage(LAS unsigned char* lds, const bf16* Kg, unsigned kstride, const bf16* VTg, unsigned vstride, const float* tbg, int tid) {
    const unsigned ko = (unsigned)(tid >> 4) * (kstride * 2u) + (unsigned)(tid & 15) * 16u, vo = (unsigned)(tid >> 5) * (vstride * 2u) + (unsigned)(tid & 31) * 16u;
    const unsigned kl = (unsigned)(tid >> 4) * KROW + (unsigned)(tid & 15) * 16u, vl = (unsigned)(tid >> 5) * VROW + (unsigned)(tid & 31) * 16u;
    v4u kx[8], vx[8];
#pragma unroll
    for (int p = 0; p < 8; ++p) kx[p] = *(const v4u*)((const unsigned char*)Kg + (size_t)p * 32 * kstride * 2 + ko);
#pragma unroll
    for (int p = 0; p < 8; ++p) vx[p] = *(const v4u*)((const unsigned char*)VTg + (size_t)p * 16 * vstride * 2 + vo);
#pragma unroll
    for (int p = 0; p < 8; ++p) *(LAS v4u*)(lds + KS_OFF + p * 32 * KROW + kl) = kx[p];
    { const unsigned c = (unsigned)(tid & 31), vl2 = (unsigned)(tid >> 5) * VROW + (c >> 1) * 32u + (c & 1u) * 8u;
#pragma unroll
      for (int p = 0; p < 8; ++p) { v2u a2, b2; a2.x = vx[p].x; a2.y = vx[p].y; b2.x = vx[p].z; b2.y = vx[p].w;
        *(LAS v2u*)(lds + VS_OFF + p * 16 * VROW + vl2) = a2; *(LAS v2u*)(lds + VS_OFF + p * 16 * VROW + vl2 + 16) = b2; } }
    if (tbg) { const f32x4 x = ((const f32x4*)tbg)[tid]; ((LAS f32x4*)(lds + TB_OFF))[tid] = x; }
}
__device__ __forceinline__ void load_q(bf16x8 (&qf)[8], const bf16* qp, int hi) {
#pragma unroll
    for (int ks = 0; ks < 8; ++ks) qf[ks] = *(const bf16x8*)(qp + 16 * ks + 8 * hi);
}
__device__ __forceinline__ void store_o16(bf16* rowbase, const f32x16 (&O)[4], float scale, int hi, bool doit) {
#pragma unroll
    for (int dt = 0; dt < 4; ++dt)
#pragma unroll
        for (int gp = 0; gp < 2; ++gp) {
            const int ga = 2 * gp, gb = 2 * gp + 1;
            const unsigned ax = pk2(O[dt][4 * ga] * scale, O[dt][4 * ga + 1] * scale), ay = pk2(O[dt][4 * ga + 2] * scale, O[dt][4 * ga + 3] * scale);
            const unsigned bx = pk2(O[dt][4 * gb] * scale, O[dt][4 * gb + 1] * scale), by = pk2(O[dt][4 * gb + 2] * scale, O[dt][4 * gb + 3] * scale);
            const v2u r1 = __builtin_amdgcn_permlane32_swap(ax, bx, false, false), r2 = __builtin_amdgcn_permlane32_swap(ay, by, false, false);
            v4u w; w.x = r1.x; w.y = r2.x; w.z = r1.y; w.w = r2.y;
            if (doit) *(v4u*)(rowbase + 32 * dt + 8 * (hi ? gb : ga)) = w;
        }
}
template <int MODE>
__device__ __forceinline__ void attn_core(LAS unsigned char* lds, const bf16x8 (&qf)[8], int qrel, float sc, int nchunks, bool fast, float cbias, f32x16 (&O)[4], float& m, float& l, int lane) {
    const int l31 = lane & 31, hi = lane >> 5;
#pragma unroll
    for (int dt = 0; dt < 4; ++dt)
#pragma unroll
        for (int r = 0; r < 16; ++r) O[dt][r] = 0.f;
    m = -1e30f; l = 0.f;
    const LAS float* tb = (const LAS float*)(lds + TB_OFF);
#pragma unroll 1
    for (int c = 0; c < nchunks; ++c) {
        f32x16 s0, s1;
#pragma unroll
        for (int r = 0; r < 16; ++r) { s0[r] = 0.f; s1[r] = 0.f; }
        const LAS unsigned char* kp = lds + KS_OFF + (64 * c + l31) * KROW + 16 * hi;
#pragma unroll
        for (int h2 = 0; h2 < 2; ++h2) {
            bf16x8 ka[4], kb[4];
#pragma unroll
            for (int ks = 0; ks < 4; ++ks) { ka[ks] = *(const LAS bf16x8*)(kp + 32 * (4 * h2 + ks)); kb[ks] = *(const LAS bf16x8*)(kp + 32 * KROW + 32 * (4 * h2 + ks)); }
#pragma unroll
            for (int ks = 0; ks < 4; ++ks) {
                s0 = __builtin_amdgcn_mfma_f32_32x32x16_bf16(ka[ks], qf[4 * h2 + ks], s0, 0, 0, 0);
                s1 = __builtin_amdgcn_mfma_f32_32x32x16_bf16(kb[ks], qf[4 * h2 + ks], s1, 0, 0, 0);
            }
        }
        float mx = -INFINITY;
#pragma unroll
        for (int r = 0; r < 16; ++r) {
            const int d0 = qrel - (64 * c + crow(r, hi)), d1 = d0 - 32;
            float t0 = s0[r] * sc, t1 = s1[r] * sc;
            if (MODE == 0) { if (fast) { t0 += cbias; t1 += cbias; } else { t0 += tb[d0 < 2047 ? d0 : 2047]; t1 += tb[d1 < 2047 ? d1 : 2047]; } }
            if (MODE == 1) { t0 = d0 >= 0 ? t0 + tb[d0 > 0 ? d0 : 0] : -INFINITY; t1 = d1 >= 0 ? t1 + tb[d1 > 0 ? d1 : 0] : -INFINITY; }
            s0[r] = t0; s1[r] = t1; mx = fmaxf(mx, fmaxf(t0, t1));
        }
        mx = fmaxf(mx, __shfl_xor(mx, 32));
        const float mn = fmaxf(m, mx), alpha = ex2(m - mn); m = mn;
        float ls = 0.f;
#pragma unroll
        for (int r = 0; r < 16; ++r) { s0[r] = ex2(s0[r] - mn); s1[r] = ex2(s1[r] - mn); ls += s0[r] + s1[r]; }
        l = l * alpha + ls;
        if (c > 0) {
#pragma unroll
            for (int dt = 0; dt < 4; ++dt)
#pragma unroll
                for (int r = 0; r < 16; ++r) O[dt][r] *= alpha;
        }
#pragma unroll
        for (int kt2 = 0; kt2 < 2; ++kt2) {
            bf16x8 pb[2];
#pragma unroll
            for (int sp = 0; sp < 2; ++sp) {
                v4u pw;
                if (kt2 == 0) { pw.x = pk2s(s0[8 * sp + 0], s0[8 * sp + 1]); pw.y = pk2s(s0[8 * sp + 2], s0[8 * sp + 3]); pw.z = pk2s(s0[8 * sp + 4], s0[8 * sp + 5]); pw.w = pk2s(s0[8 * sp + 6], s0[8 * sp + 7]); }
                else          { pw.x = pk2s(s1[8 * sp + 0], s1[8 * sp + 1]); pw.y = pk2s(s1[8 * sp + 2], s1[8 * sp + 3]); pw.z = pk2s(s1[8 * sp + 4], s1[8 * sp + 5]); pw.w = pk2s(s1[8 * sp + 6], s1[8 * sp + 7]); }
                pb[sp] = __builtin_bit_cast(bf16x8, pw);
            }
            const LAS unsigned char* vp = lds + VS_OFF + l31 * VROW + (64 * c + 32 * kt2) * 2 + 16 * hi;
            bf16x8 va[2][4];
#pragma unroll
            for (int sp = 0; sp < 2; ++sp)
#pragma unroll
                for (int dt = 0; dt < 4; ++dt) va[sp][dt] = *(const LAS bf16x8*)(vp + sp * 32 + dt * 32 * VROW);
#pragma unroll
            for (int sp = 0; sp < 2; ++sp)
#pragma unroll
                for (int dt = 0; dt < 4; ++dt) O[dt] = __builtin_amdgcn_mfma_f32_32x32x16_bf16(va[sp][dt], pb[sp], O[dt], 0, 0, 0);
        }
    }
    l += __shfl_xor(l, 32);
}

#define XB_TMO      128
#define XB_XCNT(j)  (256  + 64 * (j))
#define XB_XSUB(j)  (1280 + 64 * (j))
#define XB_XGEN(j)  (2304 + 64 * (j))
#define XB_TOP      3328
#define XB_TOPGEN   3392
#define XCD_BAR_WORDS 3456
#define XB_SPIN_CAP (1u << 18)

__device__ __forceinline__ unsigned xb_ld(unsigned* p)              { return __hip_atomic_load(p, __ATOMIC_RELAXED, __HIP_MEMORY_SCOPE_AGENT); }
__device__ __forceinline__ unsigned xb_add(unsigned* p, unsigned v) { return __hip_atomic_fetch_add(p, v, __ATOMIC_RELAXED, __HIP_MEMORY_SCOPE_AGENT); }
__device__ __forceinline__ unsigned xb_xcc_id() { return (unsigned)__builtin_amdgcn_s_getreg((3 << 11) | 20) & 0xFu; }
#define XB_SPIN(cond, bar) do { unsigned _sp = 0; while (cond) { __builtin_amdgcn_s_sleep(1); \
    if ((++_sp & 255u) == 0u) { if (xb_ld(&(bar)[XB_TMO])) break; if (_sp > XB_SPIN_CAP) { atomicAdd(&(bar)[XB_TMO], 1u); break; } } } } while (0)

struct XcdBarrier {
    unsigned* bar; unsigned x;
    volatile LAS unsigned* st;
};

__device__ __forceinline__ XcdBarrier xcd_barrier_post(unsigned* bar, volatile LAS unsigned* st, int tid) {
    XcdBarrier b; b.bar = bar; b.x = xb_xcc_id(); b.st = st;
    if (tid == 0) (void)xb_add(&bar[XB_XCNT(b.x)], 1u);
    return b;
}
__device__ __forceinline__ void xcd_barrier_complete(unsigned* bar, unsigned x, unsigned& nloc, unsigned& nx) {
    const unsigned G = gridDim.x * gridDim.y * gridDim.z;
    unsigned sum, cnt, mine, sp = 0u;
    for (;;) {
        sum = 0u; cnt = 0u; mine = 0u;
#pragma unroll
        for (unsigned j = 0; j < 16; ++j) { const unsigned c = xb_ld(&bar[XB_XCNT(j)]); sum += c; cnt += (c > 0u) ? 1u : 0u; mine = (j == x) ? c : mine; }
        if (sum == G) break;
        __builtin_amdgcn_s_sleep(1);
        if ((++sp & 255u) == 0u) { if (xb_ld(&bar[XB_TMO])) break; if (sp > XB_SPIN_CAP) { atomicAdd(&bar[XB_TMO], 1u); break; } }
    }
    nloc = mine > 0u ? mine : 1u; nx = cnt > 0u ? cnt : 1u;
}

__device__ __forceinline__ void xcd_barrier(const XcdBarrier& b, int tid) {
    asm volatile("s_waitcnt vmcnt(0)" ::: "memory");
    __syncthreads();
    if (tid == 0) {
        unsigned* bar = b.bar;
        __builtin_amdgcn_s_waitcnt(0);
        unsigned nloc = b.st[0], nx = b.st[1];
        if (nloc == 0u) { xcd_barrier_complete(bar, b.x, nloc, nx); b.st[0] = nloc; b.st[1] = nx; }
        const unsigned old = xb_add(&bar[XB_XSUB(b.x)], 1u);
        const unsigned gen = old / nloc;
        if (old + 1u == (gen + 1u) * nloc) {
            __builtin_amdgcn_fence(__ATOMIC_RELEASE, "agent");
            asm volatile("s_waitcnt vmcnt(0)" ::: "memory");
            const unsigned og = xb_add(&bar[XB_TOP], 1u);
            const unsigned tg = og / nx;
            if (og + 1u == (tg + 1u) * nx) xb_add(&bar[XB_TOPGEN], 1u);
            else XB_SPIN(xb_ld(&bar[XB_TOPGEN]) == tg, bar);
            __builtin_amdgcn_fence(__ATOMIC_ACQUIRE, "agent");
            xb_add(&bar[XB_XGEN(b.x)], 1u);
            asm volatile("s_waitcnt vmcnt(0)" ::: "memory");
        } else {
            XB_SPIN(xb_ld(&bar[XB_XGEN(b.x)]) == gen, bar);
            __builtin_amdgcn_fence(__ATOMIC_ACQUIRE, "agent");
            asm volatile("s_waitcnt vmcnt(0)" ::: "memory");
        }
    }
    __syncthreads();
}

struct Args { const float* in[20]; float* out; unsigned char* ws; int ph_lo, ph_hi; };

__global__ void __launch_bounds__(512, 2) fwd(Args a) {
    extern __shared__ __attribute__((aligned(16))) unsigned char lds_raw[];
    LAS unsigned char* lds = (LAS unsigned char*)lds_raw;
    const int wave = __builtin_amdgcn_readfirstlane((int)threadIdx.x >> 6);
    const int G = gridDim.x, blk = blockIdx.x;
    const int lo = a.ph_lo, hiP = a.ph_hi;
    LAS unsigned long long* ptab = (LAS unsigned long long*)(lds + PT_OFF);
    if (threadIdx.x == 0) {
#pragma unroll
        for (int i = 0; i < 20; ++i) ptab[i] = (unsigned long long)a.in[i];
        ptab[20] = (unsigned long long)a.out; ptab[21] = (unsigned long long)a.ws;
        ((LAS unsigned*)(lds + ST_OFF))[0] = 0u; ((LAS unsigned*)(lds + ST_OFF))[1] = 0u;
    }
    __syncthreads();
    if (a.ph_hi - a.ph_lo > 1) {
        cg::this_grid().sync();
        const int lane_ = (int)__builtin_amdgcn_mbcnt_hi(~0u, __builtin_amdgcn_mbcnt_lo(~0u, 0u));
        (void)xcd_barrier_post((unsigned*)(a.ws + WS_CTL) + CW_BAR, (volatile LAS unsigned*)(lds + ST_OFF), wave * 64 + lane_);
    }
#define LDP(i) ((unsigned char*)(__attribute__((address_space(1))) unsigned char*)(((unsigned long long)(unsigned)__builtin_amdgcn_readfirstlane((int)(unsigned)(ptab[i] >> 32)) << 32) | (unsigned long long)(unsigned)__builtin_amdgcn_readfirstlane((int)(unsigned)ptab[i])))
#define DECL_PTRS \
    const int lane = (int)__builtin_amdgcn_mbcnt_hi(~0u, __builtin_amdgcn_mbcnt_lo(~0u, 0u)), tid = wave * 64 + lane, l31 = lane & 31, hi = lane >> 5; (void)tid; (void)l31; (void)hi; \
    const float* const x = (const float*)LDP(0); (void)x; \
    const float* const mem = (const float*)LDP(1); (void)mem; \
    const float* const g_mix = (const float*)LDP(2); (void)g_mix; \
    const float* const w_in = (const float*)LDP(3); (void)w_in; \
    const float* const conv_w = (const float*)LDP(4); (void)conv_w; \
    const float* const conv_b = (const float*)LDP(5); (void)conv_b; \
    const float* const ln_g = (const float*)LDP(6); (void)ln_g; \
    const float* const ln_b = (const float*)LDP(7); (void)ln_b; \
    const float* const w_out = (const float*)LDP(8); (void)w_out; \
    const float* const rel_bias = (const float*)LDP(9); (void)rel_bias; \
    const float* const g_cross = (const float*)LDP(10); (void)g_cross; \
    const float* const g_mem = (const float*)LDP(11); (void)g_mem; \
    const float* const wq_c = (const float*)LDP(12); (void)wq_c; \
    const float* const wk_c = (const float*)LDP(13); (void)wk_c; \
    const float* const wv_c = (const float*)LDP(14); (void)wv_c; \
    const float* const wo_c = (const float*)LDP(15); (void)wo_c; \
    const float* const g_mlp = (const float*)LDP(16); (void)g_mlp; \
    const float* const w1 = (const float*)LDP(17); (void)w1; \
    const float* const w2 = (const float*)LDP(18); (void)w2; \
    const float* const g_final = (const float*)LDP(19); (void)g_final; \
    float* const out = (float*)LDP(20); (void)out; unsigned char* const ws = LDP(21); (void)ws; \
    unsigned* const CNT = (unsigned*)(ws + WS_CTL); (void)CNT; float* const SSQ1 = (float*)(ws + WS_CTL + 262144); (void)SSQ1; float* const SSQ2 = (float*)(ws + WS_CTL + 524288); (void)SSQ2; float* const SSQ3 = (float*)(ws + WS_CTL + 786432); (void)SSQ3; \
    bf16* const WIN_T = (bf16*)(ws + WS_WIN); (void)WIN_T; \
    bf16* const WOUT_T = (bf16*)(ws + WS_WOUT); (void)WOUT_T; \
    bf16* const WQ_T = (bf16*)(ws + WS_WQ); (void)WQ_T; \
    bf16* const WKV_T = (bf16*)(ws + WS_WKV); (void)WKV_T; \
    bf16* const WO_T = (bf16*)(ws + WS_WO); (void)WO_T; \
    bf16* const W1_T = (bf16*)(ws + WS_W1); (void)W1_T; \
    bf16* const W2_T = (bf16*)(ws + WS_W2); (void)W2_T; \
    float* const KBAR = (float*)(ws + WS_KBAR); (void)KBAR; \
    float* const TB = (float*)(ws + WS_TB); (void)TB; \
    bf16* const MN = (bf16*)(ws + WS_MN); (void)MN; \
    bf16* const KC = (bf16*)(ws + WS_KC); (void)KC; \
    bf16* const VCT = (bf16*)(ws + WS_VCT); (void)VCT; \
    bf16* const NBUF = (bf16*)(ws + WS_NB); (void)NBUF; \
    bf16* const Q = (bf16*)(ws + WS_Q); (void)Q; \
    bf16* const K = (bf16*)(ws + WS_K); (void)K; \
    bf16* const VT = (bf16*)(ws + WS_VT); (void)VT; \
    bf16* const UV = (bf16*)(ws + WS_UV); (void)UV; \
    bf16* const UG = (bf16*)(ws + WS_UG); (void)UG; \
    bf16* const AC = (bf16*)(ws + WS_AC); (void)AC; \
    bf16* const FB = (bf16*)(ws + WS_F); (void)FB; \
    bf16* const QC = (bf16*)(ws + WS_QC); (void)QC; \
    bf16* const OC = (bf16*)(ws + WS_OC); (void)OC; \
    bf16* const PO = (bf16*)(ws + WS_PO); (void)PO; \
    float* const PML = (float*)(ws + WS_PML); (void)PML; \
    unsigned* const LIST = (unsigned*)(ws + WS_LIST); (void)LIST; \
    do {} while (0)
    const float SC = 0.08838834764831845f * LOG2E;
#ifndef DBG
#define DBG 0
#endif
#ifndef REP_MASK
#define REP_MASK 0
#endif
#ifndef PH_MASK
#define PH_MASK 0x7fff
#endif
#define IN(k) (((PH_MASK >> (k)) & 1) && lo <= (k) && (k) < hiP)
#define SEAM2(k, kn) do { if (IN(k) && IN(kn)) { const int lane_ = (int)__builtin_amdgcn_mbcnt_hi(~0u, __builtin_amdgcn_mbcnt_lo(~0u, 0u)); \
        XcdBarrier b_; b_.bar = (unsigned*)(LDP(21) + WS_CTL) + CW_BAR; b_.x = xb_xcc_id(); b_.st = (volatile LAS unsigned*)(lds + ST_OFF); xcd_barrier(b_, wave * 64 + lane_); } } while (0)
#define SEAM(k) SEAM2(k, (k) + 1)
#define GRID_BAR() do { const int lane_ = (int)__builtin_amdgcn_mbcnt_hi(~0u, __builtin_amdgcn_mbcnt_lo(~0u, 0u)); \
        XcdBarrier b_; b_.bar = (unsigned*)(LDP(21) + WS_CTL) + CW_BAR; b_.x = xb_xcc_id(); b_.st = (volatile LAS unsigned*)(lds + ST_OFF); xcd_barrier(b_, wave * 64 + lane_); } while (0)

    for (int rep_ = 0; rep_ < (IN(0) ? 1 + ((REP_MASK >> 0) & 1) : 0); ++rep_) { DECL_PTRS;
        LAS float* scr = (LAS float*)(lds + wave * 16384);
        const int gw = blk * 8 + wave, NGW = G * 8;
        constexpr int I_IN = (DM / 64) * (INW / 32), I_OUT = (DM / 64) * (DM / 32), I_X = (DM / 64) * (XW / 32), I_O = (XW / 64) * (DM / 32), I_1 = (DM / 64) * (FF / 32), I_2 = (FF / 64) * (DM / 32);
        constexpr int NITEMS = I_IN + I_OUT + 3 * I_X + I_O + I_1 + I_2;
        const bool early = (G > 16) && (hiP - lo > 1);
        for (int it = gw; it < 2 * I_X; it += NGW) { if (it < I_X) p0_transpose_item(wk_c, DM, XW, WKV_T, 0, scr, it, lane); else p0_transpose_item(wv_c, DM, XW, WKV_T, XW, scr, it - I_X, lane); }
        for (int mrow = gw; mrow < NB * NMEM; mrow += NGW) rms_row_bf16(mem + (size_t)mrow * DM, g_mem, MN + (size_t)mrow * DM, lane);
        for (int i = blk * 512 + tid; i < NH * 2048; i += G * 512) {
            const int hh = i >> 11, d = i & 2047; int bucket = d;
            if (d >= 16) { const int lg = 16 + (int)(logf((float)d / 16.0f) / 4.852030263919617f * 16.0f); bucket = lg < 31 ? lg : 31; }
            TB[i] = rel_bias[bucket * NH + hh] * LOG2E;
        }
        if (early) { GRID_BAR(); }
        if (early && blk < 8) {
            pg8::Gemm g{MN, WKV_T, NB * NMEM, 2 * XW, DM}; pg8::StaticOrder So; So.init(NB * NMEM, 2 * XW, 8, blk);
            pg8::EpiBf16X<0> E{KC, XW, XW, (size_t)NB * NMEM * XW, 1, VCT, NMEM, XH, nullptr};
            pg8::gemm_phase<pg8::EpiBf16X<0>, pg8::StaticOrder, true, true>(lds, g, So, E, tid);
        } else {
        const int nb0 = early ? 8 : 0, gwb = (blk - nb0) * 8 + wave, NGWB = (G - nb0) * 8;
        constexpr int NREST = I_IN + I_OUT + I_X + I_O + I_1 + I_2;
        for (int it = gwb; it < NREST; it += NGWB) {
            int r = it;
            if (r < I_IN) { p0_transpose_item(w_in, DM, INW, WIN_T, 0, scr, r, lane); continue; } r -= I_IN;
            if (r < I_OUT) { p0_transpose_item(w_out, DM, DM, WOUT_T, 0, scr, r, lane); continue; } r -= I_OUT;
            if (r < I_X) { p0_transpose_item(wq_c, DM, XW, WQ_T, 0, scr, r, lane, g_cross); continue; } r -= I_X;
            if (r < I_O) { p0_transpose_item(wo_c, XW, DM, WO_T, 0, scr, r, lane); continue; } r -= I_O;
            if (r < I_1) { p0_transpose_item(w1, DM, FF, W1_T, 0, scr, r, lane, g_mlp); continue; } r -= I_1;
            p0_transpose_item(w2, FF, DM, W2_T, 0, scr, r, lane);
        }
        for (int mrow = gwb; mrow < T; mrow += 2 * NGWB) {
            const int r2 = mrow + NGWB;
            const f32x4* xa = (const f32x4*)(x + (size_t)mrow * DM) + lane; const f32x4* xb = (const f32x4*)(x + (size_t)(r2 < T ? r2 : mrow) * DM) + lane;
            f32x4 va[8], vb[8]; float sa = 0.f, sb = 0.f;
#pragma unroll
            for (int jj = 0; jj < 8; ++jj) { va[jj] = xa[64 * jj]; vb[jj] = xb[64 * jj]; }
#pragma unroll
            for (int jj = 0; jj < 8; ++jj) { sa += (va[jj].x * va[jj].x + va[jj].y * va[jj].y) + (va[jj].z * va[jj].z + va[jj].w * va[jj].w); sb += (vb[jj].x * vb[jj].x + vb[jj].y * vb[jj].y) + (vb[jj].z * vb[jj].z + vb[jj].w * vb[jj].w); }
            const float ra = 1.0f / sqrtf(wave_sum(sa) * (1.0f / DM) + EPS), rb = 1.0f / sqrtf(wave_sum(sb) * (1.0f / DM) + EPS);
            const f32x4* gr = (const f32x4*)g_mix + lane; v2u* oa = (v2u*)(NBUF + (size_t)mrow * DM) + lane; v2u* ob = (v2u*)(NBUF + (size_t)(r2 < T ? r2 : mrow) * DM) + lane;
#pragma unroll
            for (int jj = 0; jj < 8; ++jj) { const f32x4 gv = gr[64 * jj]; v2u w; w.x = pk2(va[jj].x * ra * gv.x, va[jj].y * ra * gv.y); w.y = pk2(va[jj].z * ra * gv.z, va[jj].w * ra * gv.w); oa[64 * jj] = w;
                if (r2 < T) { v2u w2; w2.x = pk2(vb[jj].x * rb * gv.x, vb[jj].y * rb * gv.y); w2.y = pk2(vb[jj].z * rb * gv.z, vb[jj].w * rb * gv.w); ob[64 * jj] = w2; } }
        }
        }
        __syncthreads();
    }
    SEAM(0);

    for (int rep_ = 0; rep_ < (IN(1) ? 1 + ((REP_MASK >> 1) & 1) : 0); ++rep_) { DECL_PTRS;
        { pg8::Gemm g{NBUF, WIN_T, T, INW, DM}; pg8::StaticOrder So; So.init(T, INW, G, blk);
          pg8::EpiBf16X<0> E{Q, AW, AW, (size_t)T * AW, 2, VT, S, NH, nullptr};
          pg8::gemm_phase<pg8::EpiBf16X<0>, pg8::StaticOrder, true, true>(lds, g, So, E, tid); }
        if (!((G > 16) && (hiP - lo > 1)))
        { pg8::Gemm g{MN, WKV_T, NB * NMEM, 2 * XW, DM}; pg8::StaticOrder So; So.init(NB * NMEM, 2 * XW, G, blk);
          pg8::EpiBf16X<0> E{KC, XW, XW, (size_t)NB * NMEM * XW, 1, VCT, NMEM, XH, nullptr};
          pg8::gemm_phase<pg8::EpiBf16X<0>, pg8::StaticOrder, true, true>(lds, g, So, E, tid); }
    }
    SEAM(1);

#if DBG == 9
    { DECL_PTRS; for (size_t i = (size_t)blk * 512 + tid; i < (size_t)T * DM; i += (size_t)G * 512) { out[i] = i < 262144 ? __uint_as_float(((unsigned)KC[i] << 16)) : (i < 524288 ? __uint_as_float(((unsigned)VCT[i - 262144] << 16)) : 0.f); } return; }
#endif
#if DBG == 1
    { DECL_PTRS; for (size_t i = (size_t)blk * 512 + tid; i < (size_t)T * DM; i += (size_t)G * 512) { const size_t t = i >> 11, c = i & 2047, e = t * 1024 + (c & 1023);
        const unsigned short v = c < 1024 ? (unsigned short)(Q[e] ^ UV[e]) : (unsigned short)(K[e] ^ UG[e] ^ VT[e]); out[i] = __uint_as_float(((unsigned)v << 16)) ; } return; }
#endif
    for (int rep_ = 0; rep_ < (IN(2) ? 1 + ((REP_MASK >> 2) & 1) : 0); ++rep_) { DECL_PTRS;
        for (int it = blk; it < 256; it += G) {
            const int b = it >> 7, j = (it >> 1) & 63, chh = it & 1, cp = tid & 255, rh = tid >> 8;
            const bf16* kp = K + (size_t)(b * S + j * 256 + rh * 128) * AW + chh * 512 + 2 * cp;
            float s0 = 0.f, s1 = 0.f;
#pragma unroll 8
            for (int r = 0; r < 128; ++r) { const unsigned w = *(const unsigned*)(kp + (size_t)r * AW); s0 += bf_lo(w); s1 += bf_hi(w); }
            LAS f32x2* red = (LAS f32x2*)lds;
            if (rh == 1) red[cp] = (f32x2){s0, s1};
            __syncthreads();
            if (rh == 0) { const f32x2 o = red[cp]; const int col = chh * 512 + 2 * cp, hh = col >> 7, d = col & 127;
                *(f32x2*)(KBAR + ((size_t)((b * NH + hh) * NBLK + j)) * HD + d) = (f32x2){(s0 + o.x) * (1.0f / 256.0f), (s1 + o.y) * (1.0f / 256.0f)}; }
            __syncthreads();
        }
        for (int seg = blk; seg < T / 128; seg += G) {
            const int t0 = seg * 128, c0 = 2 * tid;
            float w0[CONVK], w1r[CONVK];
#pragma unroll
            for (int k = 0; k < CONVK; ++k) { const f32x2 wv = *(const f32x2*)(conv_w + k * CC + c0); w0[k] = wv.x; w1r[k] = wv.y; }
            const f32x2 cb = *(const f32x2*)(conv_b + c0), lg = *(const f32x2*)(ln_g + c0), lb = *(const f32x2*)(ln_b + c0);
            float r0[32], r1[32];
#pragma unroll
            for (int i = 0; i < 32; ++i) { r0[i] = 0.f; r1[i] = 0.f; }
            LAS f32x2* red = (LAS f32x2*)(lds + RED_OFF);
#pragma unroll 1
            for (int ch = -1; ch < 4; ++ch) {
                const int tb0 = t0 + ch * 32;
                const bool zero = (ch < 0) && ((t0 & (S - 1)) == 0);
#pragma unroll
                for (int hf = 0; hf < 2; ++hf) {
                    float y0[16], y1[16];
#pragma unroll
                    for (int ii = 0; ii < 16; ++ii) {
                        const int i = hf * 16 + ii;
                        float h0 = 0.f, h1 = 0.f;
                        if (!zero) { const size_t off = (size_t)(tb0 + i) * CC + c0; const unsigned vv = *(const unsigned*)(UV + off), gg = *(const unsigned*)(UG + off);
                            h0 = bf_lo(vv) * sigmoidf_(bf_lo(gg)); h1 = bf_hi(vv) * sigmoidf_(bf_hi(gg)); }
                        r0[i] = h0; r1[i] = h1;
                        float a0 = cb.x, a1 = cb.y;
                        if (ch >= 0) {
#pragma unroll
                            for (int k = 0; k < CONVK; ++k) { a0 += r0[(i - 30 + k) & 31] * w0[k]; a1 += r1[(i - 30 + k) & 31] * w1r[k]; }
                        }
                        y0[ii] = a0; y1[ii] = a1;
                    }
                    if (ch >= 0) {
#pragma unroll
                        for (int ii = 0; ii < 16; ++ii) { const float s1 = wave_sum(y0[ii] + y1[ii]), s2 = wave_sum(y0[ii] * y0[ii] + y1[ii] * y1[ii]); if (lane == 0) red[ii * 8 + wave] = (f32x2){s1, s2}; }
                        __syncthreads();
#pragma unroll
                        for (int ii = 0; ii < 16; ++ii) {
                            float s1 = 0.f, s2 = 0.f;
#pragma unroll
                            for (int w = 0; w < 4; ++w) { const f32x4 p = ((const LAS f32x4*)red)[ii * 4 + w]; s1 += p.x + p.z; s2 += p.y + p.w; }
                            const float mean = s1 * (1.0f / CC), var = fmaxf(s2 * (1.0f / CC) - mean * mean, 0.f), rstd = 1.0f / sqrtf(var + EPS);
                            float o0 = (y0[ii] - mean) * rstd * lg.x + lb.x, o1 = (y1[ii] - mean) * rstd * lg.y + lb.y;
                            o0 = o0 * sigmoidf_(o0); o1 = o1 * sigmoidf_(o1);
                            *(unsigned*)(AC + (size_t)(tb0 + hf * 16 + ii) * DM + AW + c0) = pk2(o0, o1);
                        }
                        __syncthreads();
                    }
                }
            }
        }
    }
    SEAM(2);

    for (int rep_ = 0; rep_ < (IN(3) ? 1 : 0); ++rep_) { DECL_PTRS;
        constexpr int KH_OFF = 0, KL_OFF = 64 * KROW;
        for (int it = blk; it < NB * NH * NBLK; it += G) {
            const int bh = it >> 6, own = it & 63, b = bh >> 3, hh = bh & 7;
            if (own == 0) continue;
            f32x2 kvv[8];
#pragma unroll
            for (int i = 0; i < 8; ++i) { const int p2 = tid + 512 * i; kvv[i] = *(const f32x2*)(KBAR + (size_t)bh * NBLK * HD + 2 * p2); }
#pragma unroll
            for (int i = 0; i < 8; ++i) { const int p2 = tid + 512 * i, jr = p2 >> 6, d = (p2 & 63) * 2; const f32x2 kv = kvv[i];
                const unsigned hw = pk2s(kv.x, kv.y); const unsigned lw = pk2s(kv.x - bf_lo(hw), kv.y - bf_hi(hw));
                *(LAS unsigned*)(lds + KH_OFF + jr * KROW + d * 2) = hw; *(LAS unsigned*)(lds + KL_OFF + jr * KROW + d * 2) = lw; }
            const int ql = own * 256 + wave * 32 + l31;
            bf16x8 qf[8]; load_q(qf, Q + (size_t)(b * S + ql) * AW + hh * HD, hi);
            __syncthreads();
            f32x16 g0, g1;
#pragma unroll
            for (int r = 0; r < 16; ++r) { g0[r] = 0.f; g1[r] = 0.f; }
            const LAS unsigned char* kp = lds + l31 * KROW + 16 * hi;
#pragma unroll
            for (int ks = 0; ks < 8; ++ks) {
                g0 = __builtin_amdgcn_mfma_f32_32x32x16_bf16(*(const LAS bf16x8*)(kp + KH_OFF + 32 * ks), qf[ks], g0, 0, 0, 0);
                g0 = __builtin_amdgcn_mfma_f32_32x32x16_bf16(*(const LAS bf16x8*)(kp + KL_OFF + 32 * ks), qf[ks], g0, 0, 0, 0);
            }
            if (own > 32) {
#pragma unroll
                for (int ks = 0; ks < 8; ++ks) {
                    g1 = __builtin_amdgcn_mfma_f32_32x32x16_bf16(*(const LAS bf16x8*)(kp + KH_OFF + 32 * KROW + 32 * ks), qf[ks], g1, 0, 0, 0);
                    g1 = __builtin_amdgcn_mfma_f32_32x32x16_bf16(*(const LAS bf16x8*)(kp + KL_OFF + 32 * KROW + 32 * ks), qf[ks], g1, 0, 0, 0);
                }
            }
            float v0 = -INFINITY, v1 = -INFINITY, v2 = -INFINITY; int i0 = 64, i1 = 64, i2 = 64;
#define TOP3_INS(val, idx) do { const float dv_ = (val); const int di_ = (idx); if (di_ < own && dv_ > v2) { if (dv_ > v1) { v2 = v1; i2 = i1; if (dv_ > v0) { v1 = v0; i1 = i0; v0 = dv_; i0 = di_; } else { v1 = dv_; i1 = di_; } } else { v2 = dv_; i2 = di_; } } } while (0)
#pragma unroll
            for (int r = 0; r < 16; ++r) TOP3_INS(g0[r], crow(r, hi));
            if (own > 32) {
#pragma unroll
                for (int r = 0; r < 16; ++r) TOP3_INS(g1[r], 32 + crow(r, hi));
            }
            const float pv0 = __shfl_xor(v0, 32), pv1 = __shfl_xor(v1, 32), pv2 = __shfl_xor(v2, 32); const int pi0 = __shfl_xor(i0, 32), pi1 = __shfl_xor(i1, 32), pi2 = __shfl_xor(i2, 32);
#define TOP3_MRG(val, idx) do { const float dv_ = (val); const int di_ = (idx); if (di_ < own) { \
                if (dv_ > v2 || (dv_ == v2 && di_ < i2)) { if (dv_ > v1 || (dv_ == v1 && di_ < i1)) { v2 = v1; i2 = i1; if (dv_ > v0 || (dv_ == v0 && di_ < i0)) { v1 = v0; i1 = i0; v0 = dv_; i0 = di_; } else { v1 = dv_; i1 = di_; } } else { v2 = dv_; i2 = di_; } } } } while (0)
            TOP3_MRG(pv0, pi0); TOP3_MRG(pv1, pi1); TOP3_MRG(pv2, pi2);
            const int nsel = own < 3 ? own : 3;
            LAS unsigned char* sel = lds + 2 * 64 * KROW;
            if (hi == 0) { const int qi = wave * 32 + l31; sel[qi] = (unsigned char)(nsel > 0 ? i0 : 255); sel[256 + qi] = (unsigned char)(nsel > 1 ? i1 : 255); sel[512 + qi] = (unsigned char)(nsel > 2 ? i2 : 255); }
            __syncthreads();
            for (int jl = wave; jl < own; jl += 8) {
                unsigned long long bm[12]; bool mt[12]; unsigned total = 0u;
#pragma unroll
                for (int sk = 0; sk < 12; ++sk) { mt[sk] = sel[(sk >> 2) * 256 + lane + 64 * (sk & 3)] == (unsigned char)jl; bm[sk] = __ballot(mt[sk]); total += (unsigned)__popcll(bm[sk]); }
                if (total == 0u) continue;
                unsigned basep = 0u; if (lane == 0) basep = atomicAdd(&CNT[bh * NBLK + jl], total);
                unsigned run = (unsigned)__builtin_amdgcn_readfirstlane((int)basep);
                const unsigned long long lt = (1ull << lane) - 1ull;
#pragma unroll
                for (int sk = 0; sk < 12; ++sk) {
                    if (mt[sk]) __hip_atomic_store(&LIST[(size_t)(bh * NBLK + jl) * S + run + (unsigned)__popcll(bm[sk] & lt)], (unsigned)((own * 256 + lane + 64 * (sk & 3)) | ((sk >> 2) << 14)), __ATOMIC_RELAXED, __HIP_MEMORY_SCOPE_AGENT);
                    run += (unsigned)__popcll(bm[sk]);
                }
            }
            __syncthreads();
        }
    }
    SEAM(3);

    for (int rep_ = 0; rep_ < (IN(4) ? 1 + ((REP_MASK >> 4) & 1) : 0); ++rep_) { DECL_PTRS;
        LAS unsigned* pf = (LAS unsigned*)(lds + CNT_OFF);
        LAS unsigned* wtot = (LAS unsigned*)(lds + RED_OFF);
        {
            const unsigned c0 = __hip_atomic_load(&CNT[2 * tid], __ATOMIC_RELAXED, __HIP_MEMORY_SCOPE_AGENT), c1 = __hip_atomic_load(&CNT[2 * tid + 1], __ATOMIC_RELAXED, __HIP_MEMORY_SCOPE_AGENT);
            const unsigned ua = (c0 + 31u) >> 5, ub = (c1 + 31u) >> 5, us = ua + ub;
            unsigned v = us;
#pragma unroll
            for (int o = 1; o < 64; o <<= 1) { const unsigned u = __shfl_up(v, o); if (lane >= o) v += u; }
            if (lane == 63) wtot[wave] = v;
            __syncthreads();
            unsigned off = 0u;
            for (int w = 0; w < wave; ++w) off += wtot[w];
            const unsigned excl = off + v - us;
            pf[2 * tid] = excl + ua; pf[2 * tid + 1] = excl + us;
            __syncthreads();
        }
        const unsigned total = pf[NB * NH * NBLK - 1];
        const unsigned glo = (unsigned)(((unsigned long long)total * (unsigned)blk) / (unsigned)G), ghi = (unsigned)(((unsigned long long)total * (unsigned)(blk + 1)) / (unsigned)G);
        int lo_ = 0, hi_ = NB * NH * NBLK - 1;
        while (lo_ < hi_) { const int mid = (lo_ + hi_) >> 1; if (pf[mid] > glo) hi_ = mid; else lo_ = mid + 1; }
        int bhj = __builtin_amdgcn_readfirstlane(lo_); unsigned g = glo; int last_hh = -1;
        while (g < ghi) {
            const unsigned base = (unsigned)__builtin_amdgcn_readfirstlane((int)(bhj ? pf[bhj - 1] : 0u)), lend = (unsigned)__builtin_amdgcn_readfirstlane((int)pf[bhj]);
            const unsigned end = lend < ghi ? lend : ghi;
            const int cnt = __builtin_amdgcn_readfirstlane((int)__hip_atomic_load(&CNT[bhj], __ATOMIC_RELAXED, __HIP_MEMORY_SCOPE_AGENT));
            const int bh = bhj >> 6, j = bhj & 63, b = bh >> 3, hh = bh & 7;
            attn_stage(lds, K + (size_t)(b * S + j * 256) * AW + hh * HD, AW, VT + (size_t)(bh * HD) * S + j * 256, S, hh != last_hh ? TB + hh * 2048 : nullptr, tid); last_hh = hh;
            __syncthreads();
            const float cbias = ((const LAS float*)(lds + TB_OFF))[2047];
            unsigned gg = g + (unsigned)wave;
            unsigned e1 = (unsigned)(S - 1), e2 = (unsigned)(S - 1); bool v1 = false, v2 = false;
            bf16x8 qn[8];
            if (gg < end) { const int ix = (int)(gg - base) * 32 + l31; v1 = ix < cnt; if (v1) e1 = __hip_atomic_load(&LIST[(size_t)bhj * S + ix], __ATOMIC_RELAXED, __HIP_MEMORY_SCOPE_AGENT); }
            if (gg + 8u < end) { const int ix = (int)(gg + 8u - base) * 32 + l31; v2 = ix < cnt; if (v2) e2 = __hip_atomic_load(&LIST[(size_t)bhj * S + ix], __ATOMIC_RELAXED, __HIP_MEMORY_SCOPE_AGENT); }
            if (gg < end) load_q(qn, Q + (size_t)(b * S + (int)(e1 & 0x3fff)) * AW + hh * HD, hi);
            for (; gg < end; gg += 8u) {
                const unsigned e = e1; const bool valid = v1;
                bf16x8 qf[8];
#pragma unroll
                for (int ks = 0; ks < 8; ++ks) qf[ks] = qn[ks];
                e1 = e2; v1 = v2; e2 = (unsigned)(S - 1); v2 = false;
                if (gg + 16u < end) { const int ix = (int)(gg + 16u - base) * 32 + l31; v2 = ix < cnt; if (v2) e2 = __hip_atomic_load(&LIST[(size_t)bhj * S + ix], __ATOMIC_RELAXED, __HIP_MEMORY_SCOPE_AGENT); }
                if (gg + 8u < end) load_q(qn, Q + (size_t)(b * S + (int)(e1 & 0x3fff)) * AW + hh * HD, hi);
                const int ql = e & 0x3fff, slot = e >> 14, qrow = b * S + ql, qrel = ql - j * 256;
                const bool fast = __all(qrel - 255 >= 1512);
                f32x16 O[4]; float m, l;
                attn_core<0>(lds, qf, qrel, SC, 4, fast, cbias, O, m, l, lane);
                store_o16(PO + ((size_t)slot * T + qrow) * AW + hh * HD, O, 1.0f / l, hi, valid);
                if (valid) {
                    if (hi == 0) __hip_atomic_store((unsigned long long*)PML + ((size_t)(qrow * NH + hh) * 3 + slot), ((unsigned long long)__float_as_uint(l) << 32) | (unsigned long long)__float_as_uint(m), __ATOMIC_RELAXED, __HIP_MEMORY_SCOPE_AGENT);
                }
            }
            __syncthreads();
            g = end; ++bhj;
            while (bhj < NB * NH * NBLK && (unsigned)__builtin_amdgcn_readfirstlane((int)pf[bhj]) == lend) ++bhj;
        }
    }
    SEAM(4);

    for (int rep_ = 0; rep_ < (IN(5) ? 1 + ((REP_MASK >> 5) & 1) : 0); ++rep_) { DECL_PTRS;
        for (int it = blk; it < NB * NH * NBLK; it += G) {
            const int bh = it >> 6, j = it & 63, b = bh >> 3, hh = bh & 7;
            attn_stage(lds, K + (size_t)(b * S + j * 256) * AW + hh * HD, AW, VT + (size_t)(bh * HD) * S + j * 256, S, TB + hh * 2048, tid);
            __syncthreads();
            const int qrel = wave * 32 + l31, qrow = b * S + j * 256 + qrel;
            f32x16 O[4]; float m, l;
            bf16x8 qf[8]; load_q(qf, Q + (size_t)qrow * AW + hh * HD, hi);
            unsigned long long pw[3];
#pragma unroll
            for (int s = 0; s < 3; ++s) { pw[s] = 0ull; if (s < (j < 3 ? j : 3)) pw[s] = __hip_atomic_load((unsigned long long*)PML + ((size_t)(qrow * NH + hh) * 3 + s), __ATOMIC_RELAXED, __HIP_MEMORY_SCOPE_AGENT); }
            attn_core<1>(lds, qf, qrel, SC, (wave >> 1) + 1, false, 0.f, O, m, l, lane);
            const int nsel = j < 3 ? j : 3;
            float M = m, ms[3], lsv[3];
#pragma unroll
            for (int s = 0; s < 3; ++s) { ms[s] = -1e30f; lsv[s] = 0.f; if (s < nsel) { ms[s] = __uint_as_float((unsigned)pw[s]); lsv[s] = __uint_as_float((unsigned)(pw[s] >> 32)); M = fmaxf(M, ms[s]); } }
            const float wown = ex2(m - M); float den = l * wown, wsl[3];
#pragma unroll
            for (int s = 0; s < 3; ++s) { wsl[s] = lsv[s] * ex2(ms[s] - M); den += wsl[s]; }
            const float inv = 1.0f / den;
            bf16* op = AC + (size_t)qrow * DM + hh * HD + 4 * hi;
#pragma unroll
            for (int hf = 0; hf < 2; ++hf) {
                v2u pp[3][2][4];
#pragma unroll
                for (int s = 0; s < 3; ++s) if (s < nsel) {
#pragma unroll
                    for (int d2 = 0; d2 < 2; ++d2)
#pragma unroll
                        for (int g4 = 0; g4 < 4; ++g4) pp[s][d2][g4] = *(const v2u*)(PO + ((size_t)s * T + qrow) * AW + hh * HD + 4 * hi + 32 * (2 * hf + d2) + 8 * g4);
                }
#pragma unroll
                for (int d2 = 0; d2 < 2; ++d2)
#pragma unroll
                    for (int g4 = 0; g4 < 4; ++g4) { const int dt = 2 * hf + d2;
                        float o0 = O[dt][4 * g4] * wown, o1 = O[dt][4 * g4 + 1] * wown, o2 = O[dt][4 * g4 + 2] * wown, o3 = O[dt][4 * g4 + 3] * wown;
#pragma unroll
                        for (int s = 0; s < 3; ++s) if (s < nsel) { const v2u p = pp[s][d2][g4];
                            o0 += wsl[s] * bf_lo(p.x); o1 += wsl[s] * bf_hi(p.x); o2 += wsl[s] * bf_lo(p.y); o3 += wsl[s] * bf_hi(p.y); }
                        v2u w; w.x = pk2(o0 * inv, o1 * inv); w.y = pk2(o2 * inv, o3 * inv); *(v2u*)(op + 32 * dt + 8 * g4) = w;
                    }
            }
            __syncthreads();
        }
    }
    SEAM(5);

#if DBG == 2
    { DECL_PTRS; for (size_t i = (size_t)blk * 512 + tid; i < (size_t)T * DM; i += (size_t)G * 512) out[i] = __uint_as_float(((unsigned)AC[i] << 16)); return; }
#endif
    for (int rep_ = 0; rep_ < (IN(6) ? 1 + ((REP_MASK >> 6) & 1) : 0); ++rep_) { DECL_PTRS;
        pg8::Gemm g{AC, WOUT_T, T, DM, DM}; pg8::StaticOrder So; So.init(T, DM, G, blk);
        pg8::EpiResBf16Ssq<0> E{x, NBUF, DM, SSQ1, nullptr};
        pg8::gemm_phase<pg8::EpiResBf16Ssq<0>, pg8::StaticOrder, true, true>(lds, g, So, E, tid);
    }
    SEAM2(6, 8);
#if DBG == 3
    return;
#endif
    for (int rep_ = 0; rep_ < (IN(8) ? 1 + ((REP_MASK >> 8) & 1) : 0); ++rep_) { DECL_PTRS;
        pg8::Gemm g{NBUF, WQ_T, T, XW, DM}; pg8::StaticOrder So; So.init(T, XW, G, blk);
        pg8::EpiBf16X<0, 1> E{QC, XW, 0, 0, -1, nullptr, 1, 1, SSQ1};
        pg8::gemm_phase<pg8::EpiBf16X<0, 1>, pg8::StaticOrder, true, true>(lds, g, So, E, tid);
    }
    for (int rep_ = 0; rep_ < (IN(9) ? 1 + ((REP_MASK >> 9) & 1) : 0); ++rep_) { DECL_PTRS;
        asm volatile("s_waitcnt vmcnt(0)" ::: "memory"); __syncthreads();
        pg8::StaticOrder So8; So8.init(T, XW, G, blk); pg8::Unit u8;
        for (int ui = 0; So8.next(ui >> 1, u8); ++ui) {
            const int tl = u8.pm, hc = 2 * u8.pn + (ui & 1), b = tl / (S / 256);
            attn_stage(lds, KC + (size_t)(b * NMEM) * XW + hc * HD, XW, VCT + (size_t)((b * XH + hc) * HD) * NMEM, NMEM, nullptr, tid);
            __syncthreads();
            const int qrow = tl * 256 + wave * 32 + l31;
            f32x16 O[4]; float m, l;
            bf16x8 qf[8]; load_q(qf, QC + (size_t)qrow * XW + hc * HD, hi);
            attn_core<2>(lds, qf, 0, SC, 4, false, 0.f, O, m, l, lane);
            store_o16(OC + (size_t)qrow * XW + hc * HD, O, 1.0f / l, hi, true);
            __syncthreads();
        }
    }
    SEAM(9);
#if DBG == 10
    return;
#endif
#if DBG == 7
    { DECL_PTRS; for (size_t i = (size_t)blk * 512 + tid; i < (size_t)T * DM; i += (size_t)G * 512) { const size_t t = i >> 11, c = i & 2047; out[i] = c < 512 ? __uint_as_float(((unsigned)QC[t * 512 + c] << 16)) : 0.f; } return; }
#endif
#if DBG == 8
    { DECL_PTRS; for (size_t i = (size_t)blk * 512 + tid; i < (size_t)T * DM; i += (size_t)G * 512) { const size_t t = i >> 11, c = i & 2047; out[i] = c < 512 ? __uint_as_float(((unsigned)OC[t * 512 + c] << 16)) : 0.f; } return; }
#endif
#if DBG == 5
    { DECL_PTRS; for (size_t i = (size_t)blk * 512 + tid; i < (size_t)T * DM; i += (size_t)G * 512) { const size_t t = i >> 11, c = i & 2047; out[i] = c < 512 ? __uint_as_float(((unsigned)OC[t * 512 + c] << 16)) : (c < 1024 ? __uint_as_float(((unsigned)QC[t * 512 + c - 512] << 16)) : 0.f); } return; }
#endif
    for (int rep_ = 0; rep_ < (IN(10) ? 1 + ((REP_MASK >> 10) & 1) : 0); ++rep_) { DECL_PTRS;
        pg8::Gemm g{OC, WO_T, T, DM, XW}; pg8::StaticOrder So; So.init(T, DM, G, blk);
        pg8::EpiResBf16Ssq<1> E{NBUF, NBUF, DM, SSQ2, nullptr};
        pg8::gemm_phase<pg8::EpiResBf16Ssq<1>, pg8::StaticOrder, true, true>(lds, g, So, E, tid);
    }
    SEAM2(10, 12);
#if DBG == 4
    return;
#endif
    for (int rep_ = 0; rep_ < (IN(12) ? 1 + ((REP_MASK >> 12) & 1) : 0); ++rep_) { DECL_PTRS;
        pg8::Gemm g{NBUF, W1_T, T, FF, DM}; pg8::StaticOrder So; So.init(T, FF, G, blk);
        pg8::EpiBf16X<2, 0> E{FB, FF, 0, 0, -1, nullptr, 1, 1, nullptr};
        pg8::gemm_phase<pg8::EpiBf16X<2, 0>, pg8::StaticOrder, true, true>(lds, g, So, E, tid);
    }
    SEAM(12);
    for (int rep_ = 0; rep_ < (IN(13) ? 1 + ((REP_MASK >> 13) & 1) : 0); ++rep_) { DECL_PTRS;
        pg8::Gemm g{FB, W2_T, T, DM, FF}; pg8::StaticOrder So; So.init(T, DM, G, blk);
        pg8::EpiResBf16Ssq<1, 1> E{NBUF, NBUF, DM, SSQ3, SSQ2};
        pg8::gemm_phase<pg8::EpiResBf16Ssq<1, 1>, pg8::StaticOrder, true, true>(lds, g, So, E, tid);
    }
    SEAM(13);
    for (int rep_ = 0; rep_ < (IN(14) ? 1 : 0); ++rep_) { DECL_PTRS;
        const int gw = blk * 8 + wave, NGW = G * 8;
        f32x4 gv[8];
#pragma unroll
        for (int jj = 0; jj < 8; ++jj) gv[jj] = ((const f32x4*)g_final)[lane + 64 * jj];
        for (int mrow = gw; mrow < T; mrow += NGW) {
            const float rstd = 1.0f / sqrtf(SSQ3[mrow] * (1.0f / DM) + EPS);
            const v2u* hr = (const v2u*)(NBUF + (size_t)mrow * DM) + lane; f32x4* o = (f32x4*)(out + (size_t)mrow * DM) + lane;
            v2u hv[8];
#pragma unroll
            for (int jj = 0; jj < 8; ++jj) hv[jj] = hr[64 * jj];
#pragma unroll
            for (int jj = 0; jj < 8; ++jj) o[64 * jj] = (f32x4){bf_lo(hv[jj].x) * rstd * gv[jj].x, bf_hi(hv[jj].x) * rstd * gv[jj].y, bf_lo(hv[jj].y) * rstd * gv[jj].z, bf_hi(hv[jj].y) * rstd * gv[jj].w};
        }
    }
#undef IN
#undef SEAM
}

extern "C" void kernel_launch(void* const* d_in, const int* in_sizes, int n_in, void* d_out, int out_size, void* d_ws, size_t ws_size, hipStream_t stream) {
    static int grid = 0;
    if (grid == 0) {
        if (n_in != 20 || out_size != T * DM || ws_size < WS_END) { fprintf(stderr, "kernel_launch: unexpected sizes n_in %d out %d ws %zu\n", n_in, out_size, ws_size); grid = -1; return; }
        int dev = 0, cus = 0, per_cu = 0;
        (void)hipGetDevice(&dev); (void)hipDeviceGetAttribute(&cus, hipDeviceAttributeMultiprocessorCount, dev);
        (void)hipFuncSetAttribute((const void*)fwd, hipFuncAttributeMaxDynamicSharedMemorySize, LDS_BYTES);
        (void)hipOccupancyMaxActiveBlocksPerMultiprocessor(&per_cu, (const void*)fwd, 512, LDS_BYTES);
        if (per_cu < 1) { fprintf(stderr, "kernel_launch: occupancy query says %d blocks per CU\n", per_cu); per_cu = 1; }
        grid = cus;
        (void)hipGetLastError();
    }
    if (grid < 0) return;
    if (hipMemsetAsync((char*)d_ws + WS_CTL, 0, 1048576, stream) != hipSuccess) { fprintf(stderr, "kernel_launch: memset failed\n"); return; }
    Args a{};
    for (int i = 0; i < 20; ++i) a.in[i] = (const float*)d_in[i];
    a.out = (float*)d_out; a.ws = (unsigned char*)d_ws;
#if MK_PER_PHASE
    for (int p = 0; p < NPHASE; ++p) { if (p == 7 || p == 11) continue; a.ph_lo = p; a.ph_hi = p + 1; hipLaunchKernelGGL(fwd, dim3(grid), dim3(512), LDS_BYTES, stream, a); }
#else
    a.ph_lo = 0; a.ph_hi = NPHASE;
    void* args[] = {&a};
    hipError_t e = hipLaunchCooperativeKernel((const void*)fwd, dim3(grid), dim3(512), args, LDS_BYTES, stream);
    if (e != hipSuccess) fprintf(stderr, "kernel_launch: cooperative launch failed: %s (grid %d)\n", hipGetErrorString(e), grid);
#endif
}
```

```cpp
#include <hip/hip_runtime.h>
#include <cstdio>
#include <cstdint>
namespace pg8 {
#define PG8_LAS __attribute__((address_space(3)))
typedef unsigned short bf16_t;
typedef short bf16x8 __attribute__((ext_vector_type(8)));
typedef float f32x4 __attribute__((ext_vector_type(4)));
typedef unsigned u32x4 __attribute__((ext_vector_type(4)));
constexpr int BM = 256, BK = 64, HALF = 128, HTB = HALF * BK * 2  , STAGE_BYTES = 8 * HTB, NXCD = 8, WGM = 8;

__host__ __device__ __forceinline__ int lds_byte(int r, int c) { const int st = (r >> 4) * 2 + (c >> 5), rr = r & 15, cc = c & 31, ob = rr * 64 + cc * 2; return st * 1024 + (ob ^ (((ob >> 9) & 1) << 5)); }
__host__ __device__ __forceinline__ void stage_rc(int b, int& R, int& C) { const int st = b / 1024, sb = b % 1024, swz = sb ^ (((sb >> 9) & 1) << 5); R = (st >> 1) * 16 + swz / 64; C = (st & 1) * 32 + (swz % 64) / 2; }
__host__ __device__ __forceinline__ int perm32(int rho) { const int n = rho >> 4, i = rho & 15; return 8 * (i >> 2) + 4 * n + (i & 3); }

struct Unit { int pm, pn; };
struct Gemm { const bf16_t* A; const bf16_t* Bt; int M, N, K; };

struct StaticOrder {
    int nM, nN, nwg, G, c;
    __host__ __device__ void init(int M, int N, int G_, int c_) { nM = M / BM; nN = N / BM; nwg = nM * nN; G = G_; c = c_; }
    __host__ __device__ bool next(int i, Unit& u) const {
        const long L = (long)i * G + c; if (L >= nwg) return false;
        int wgid = (int)L; { const int q = nwg / NXCD, r = nwg % NXCD, xcd = wgid % NXCD, off = wgid / NXCD; wgid = (xcd < r ? xcd * (q + 1) : r * (q + 1) + (xcd - r) * q) + off; }
        const int nig = WGM * nN, gid = wgid / nig, fm = gid * WGM, gsz = (nM - fm) < WGM ? (nM - fm) : WGM;
        u.pm = fm + ((wgid % nig) % gsz); u.pn = (wgid % nig) / gsz; return true;
    }
    __device__ __forceinline__ void a_ready(const Unit&) const {}
    __device__ __forceinline__ void done(const Unit&) const {}
};

__device__ __forceinline__ unsigned cvt_pk_bf16(float lo, float hi) { unsigned r; asm volatile("v_cvt_pk_bf16_f32 %0, %1, %2" : "=v"(r) : "v"(lo), "v"(hi)); return r; }
typedef float f32x2 __attribute__((ext_vector_type(2)));
__device__ __forceinline__ f32x2 gelu_pk(f32x2 v) {
    const f32x2 av = __builtin_elementwise_abs(v), d = av * 0.2316418882f + 1.0f;
    f32x2 t; t.x = __builtin_amdgcn_rcpf(d.x); t.y = __builtin_amdgcn_rcpf(d.y);
    f32x2 q = t * 0.5307027145f + (-0.7265760135f); q = q * t + 0.7107068705f; q = q * t + (-0.142248368f); q = q * t + 0.127414796f; q = q * t;
    const f32x2 s = (v * v) * (-0.72134752044f);
    f32x2 e; e.x = __builtin_amdgcn_exp2f(s.x); e.y = __builtin_amdgcn_exp2f(s.y);
    const f32x2 m = v * (q * e), r = v - m;
    f32x2 o; o.x = v.x < 0.f ? m.x : r.x; o.y = v.y < 0.f ? m.y : r.y; return o;
}


__device__ __forceinline__ unsigned short bf16_1(float v) { return (unsigned short)(cvt_pk_bf16(v, v) & 0xffffu); }
template <int ACT  , int RS = 0  > struct EpiBf16X {
    static constexpr bool PERM = true, AFTER_DRAIN = false;
    bf16_t* O; int ldc; int split_cols; size_t split_stride; int tr_tile; bf16_t* OT; int seqlen; int nheads; const float* ssq;
    __device__ __forceinline__ void operator()(const f32x4 (&acc)[2][2][4][2], const Unit& u, int wr, int wc, int fr, int fq) const {
        const int row0 = u.pm * BM + wr * 64 + fr; int colt = u.pn * BM; bf16_t* base = O; int t = 0;
        if (split_cols) { t = colt / split_cols; base += (size_t)t * split_stride; colt -= t * split_cols; }
        const int col0 = colt + wc * 32 + 8 * fq;
        if (RS == 0 && t == tr_tile) {
#pragma unroll
            for (int ai = 0; ai < 2; ++ai)
#pragma unroll
                for (int m = 0; m < 4; ++m) { const int row = row0 + ai * HALF + m * 16; const int b = row / seqlen, s = row - b * seqlen;
#pragma unroll
                    for (int bj = 0; bj < 2; ++bj)
#pragma unroll
                        for (int n = 0; n < 2; ++n)
#pragma unroll
                            for (int j = 0; j < 4; ++j) { const int col = col0 + bj * HALF + 4 * n + j; const int hh = col >> 7, d = col & 127;
                                OT[((size_t)(b * nheads + hh) * 128 + d) * (size_t)seqlen + s] = bf16_1(acc[ai][bj][m][n][j]); } }
        } else {
#pragma unroll
            for (int ai = 0; ai < 2; ++ai)
#pragma unroll
                for (int m = 0; m < 4; ++m) { bf16_t* rowp = base + (size_t)(row0 + ai * HALF + m * 16) * ldc + col0;
                    float rsc = 1.f;
                    if (RS) { const float r = 1.0f / sqrtf(ssq[row0 + ai * HALF + m * 16] * (1.0f / 2048.0f) + 1e-6f); rsc = (ACT == 2) ? r * r : r; }
#pragma unroll
                    for (int bj = 0; bj < 2; ++bj) { f32x4 v0 = acc[ai][bj][m][0], v1 = acc[ai][bj][m][1];
                        if (RS && ACT != 2) { v0 = v0 * rsc; v1 = v1 * rsc; }
                        if (ACT == 2) {
#pragma unroll
                            for (int j = 0; j < 4; ++j) { float a = v0[j] > 0.f ? v0[j] : 0.f; v0[j] = a * a * rsc; float b = v1[j] > 0.f ? v1[j] : 0.f; v1[j] = b * b * rsc; } }
                        u32x4 w; w.x = cvt_pk_bf16(v0[0], v0[1]); w.y = cvt_pk_bf16(v0[2], v0[3]); w.z = cvt_pk_bf16(v1[0], v1[1]); w.w = cvt_pk_bf16(v1[2], v1[3]);
                        *(u32x4*)(rowp + bj * HALF) = w; } }
        }
    }
};
struct EpiResNorm {
    static constexpr bool PERM = false, AFTER_DRAIN = false;
    const float* base; float* out; int ldc; const float* gain; bf16_t* HG; float* ssq;
    __device__ __forceinline__ void operator()(const f32x4 (&acc)[2][2][4][2], const Unit& u, int wr, int wc, int fr, int fq) const {
        const int row0 = u.pm * BM + wr * 64 + fr, col0 = u.pn * BM + wc * 32 + 4 * fq;
        f32x4 gv[2][2];
#pragma unroll
        for (int bj = 0; bj < 2; ++bj)
#pragma unroll
            for (int n = 0; n < 2; ++n) gv[bj][n] = *(const f32x4*)(gain + col0 + bj * HALF + n * 16);
#pragma unroll
        for (int ai = 0; ai < 2; ++ai)
#pragma unroll
            for (int m = 0; m < 4; ++m) { const int row = row0 + ai * HALF + m * 16; const size_t off = (size_t)row * ldc + col0; float sq = 0.f;
#pragma unroll
                for (int bj = 0; bj < 2; ++bj)
#pragma unroll
                    for (int n = 0; n < 2; ++n) { const f32x4 h = *(const f32x4*)(base + off + bj * HALF + n * 16) + acc[ai][bj][m][n]; *(f32x4*)(out + off + bj * HALF + n * 16) = h;
                        sq += (h[0] * h[0] + h[1] * h[1]) + (h[2] * h[2] + h[3] * h[3]);
                        const f32x4 hg = h * gv[bj][n]; unsigned w0 = cvt_pk_bf16(hg[0], hg[1]), w1 = cvt_pk_bf16(hg[2], hg[3]);
                        typedef unsigned u32x2v __attribute__((ext_vector_type(2))); u32x2v w; w.x = w0; w.y = w1; *(u32x2v*)(HG + off + bj * HALF + n * 16) = w; }
                sq += __shfl_xor(sq, 16); sq += __shfl_xor(sq, 32);
                if (fq == 0) unsafeAtomicAdd(ssq + row, sq); }
    }
};
template <int B16  , int RS2 = 0  > struct EpiResBf16Ssq {
    static constexpr bool PERM = true, AFTER_DRAIN = false;
    const void* base; bf16_t* HB; int ldc; float* ssq; const float* ssq_in;
    __device__ __forceinline__ void operator()(const f32x4 (&acc)[2][2][4][2], const Unit& u, int wr, int wc, int fr, int fq) const {
        const int row0 = u.pm * BM + wr * 64 + fr, col0 = u.pn * BM + wc * 32 + 8 * fq;
        float rq[2][4], sqv[2][4];
#pragma unroll
        for (int ai = 0; ai < 2; ++ai)
#pragma unroll
            for (int m = 0; m < 4; ++m) rq[ai][m] = RS2 ? ssq_in[row0 + ai * HALF + m * 16] : 0.f;
#pragma unroll
        for (int ai = 0; ai < 2; ++ai)
#pragma unroll
            for (int m = 0; m < 4; ++m) { const int row = row0 + ai * HALF + m * 16; const size_t off = (size_t)row * ldc + col0; float sq = 0.f;
                float rs2 = 1.f; if (RS2) rs2 = 1.0f / (rq[ai][m] * (1.0f / 2048.0f) + 1e-6f);
#pragma unroll
                for (int bj = 0; bj < 2; ++bj) { f32x4 b0, b1;
                    if (B16) { const u32x4 bw = *(const u32x4*)((const bf16_t*)base + off + bj * HALF);
                        b0 = (f32x4){__uint_as_float(bw.x << 16), __uint_as_float(bw.x & 0xffff0000u), __uint_as_float(bw.y << 16), __uint_as_float(bw.y & 0xffff0000u)};
                        b1 = (f32x4){__uint_as_float(bw.z << 16), __uint_as_float(bw.z & 0xffff0000u), __uint_as_float(bw.w << 16), __uint_as_float(bw.w & 0xffff0000u)}; }
                    else { b0 = *(const f32x4*)((const float*)base + off + bj * HALF); b1 = *(const f32x4*)((const float*)base + off + bj * HALF + 4); }
                    const f32x4 h0 = RS2 ? b0 + acc[ai][bj][m][0] * rs2 : b0 + acc[ai][bj][m][0], h1 = RS2 ? b1 + acc[ai][bj][m][1] * rs2 : b1 + acc[ai][bj][m][1];
                    sq += ((h0[0] * h0[0] + h0[1] * h0[1]) + (h0[2] * h0[2] + h0[3] * h0[3])) + ((h1[0] * h1[0] + h1[1] * h1[1]) + (h1[2] * h1[2] + h1[3] * h1[3]));
                    u32x4 w; w.x = cvt_pk_bf16(h0[0], h0[1]); w.y = cvt_pk_bf16(h0[2], h0[3]); w.z = cvt_pk_bf16(h1[0], h1[1]); w.w = cvt_pk_bf16(h1[2], h1[3]);
                    *(u32x4*)(HB + off + bj * HALF) = w; }
                sqv[ai][m] = sq; }
#pragma unroll
        for (int ai = 0; ai < 2; ++ai)
#pragma unroll
            for (int m = 0; m < 4; ++m) { float sq = sqv[ai][m]; sq += __shfl_xor(sq, 16); sq += __shfl_xor(sq, 32); if (fq == 0) unsafeAtomicAdd(ssq + row0 + ai * HALF + m * 16, sq); }
    }
};
struct EpiResF32 {
    static constexpr bool PERM = false, AFTER_DRAIN = false;
    const float* base; float* out; int ldc;
    __device__ __forceinline__ void operator()(const f32x4 (&acc)[2][2][4][2], const Unit& u, int wr, int wc, int fr, int fq) const {
        const int row0 = u.pm * BM + wr * 64 + fr, col0 = u.pn * BM + wc * 32 + 4 * fq;
#pragma unroll
        for (int ai = 0; ai < 2; ++ai)
#pragma unroll
            for (int m = 0; m < 4; ++m) { const size_t off = (size_t)(row0 + ai * HALF + m * 16) * ldc + col0;
#pragma unroll
                for (int bj = 0; bj < 2; ++bj)
#pragma unroll
                    for (int n = 0; n < 2; ++n) { const f32x4 bs = *(const f32x4*)(base + off + bj * HALF + n * 16); *(f32x4*)(out + off + bj * HALF + n * 16) = bs + acc[ai][bj][m][n]; } }
    }
};

template <class Epi, class Sched, bool ALIGN_EPI = false, bool SP2 = false>
__device__ __forceinline__ void gemm_phase(PG8_LAS unsigned char* lds, const Gemm g, const Sched& S, const Epi& E, const int tid) {
    const int wid = __builtin_amdgcn_readfirstlane(tid >> 6), lane = tid & 63, wr = wid >> 2, wc = wid & 3, fr = lane & 15, fq = lane >> 4;
    const int K = g.K, nt = K / BK;
    unsigned voffA[2], voffB[2];
#pragma unroll
    for (int i = 0; i < 2; ++i) { int R, C; stage_rc(tid * 16 + i * 8192, R, C); const int Rb = Epi::PERM ? ((R & ~31) + perm32(R & 31)) : R;
        voffA[i] = (unsigned)(R * K + C) * 2u; voffB[i] = (unsigned)(Rb * K + C) * 2u; }
    const size_t kstep = (size_t)(BK * 2);
    const size_t hstep = (size_t)HALF * K * 2;
    const size_t tstep = 2 * hstep;
    const unsigned ldsw = (unsigned)wid * 1024u;
    const int aoff = lds_byte(wr * 64 + fr, fq * 8), boff = lds_byte(wc * 32 + fr, fq * 8);
#define PG8_SA(b, h) (((b) * 2 + (h)) * HTB)
#define PG8_SB(b, h) ((4 + (b) * 2 + (h)) * HTB)
#define PG8_STAGE(bufoff, gbase, voff) do { _Pragma("unroll") for (int _i = 0; _i < 2; ++_i) \
        __builtin_amdgcn_global_load_lds((const unsigned*)((const char*)(gbase) + (voff)[_i]), (PG8_LAS unsigned*)(lds + (bufoff) + ldsw + _i * 8192), 16, 0, 0); } while (0)
#define PG8_LDA(dst, b, h) do { _Pragma("unroll") for (int m = 0; m < 4; ++m) _Pragma("unroll") for (int k = 0; k < 2; ++k) dst[m][k] = *(const PG8_LAS bf16x8*)(lds + PG8_SA(b, h) + aoff + m * 2048 + k * 1024); } while (0)
#define PG8_LDB(dst, b, h) do { _Pragma("unroll") for (int n = 0; n < 2; ++n) _Pragma("unroll") for (int k = 0; k < 2; ++k) dst[n][k] = *(const PG8_LAS bf16x8*)(lds + PG8_SB(b, h) + boff + n * 2048 + k * 1024); } while (0)
#define PG8_MMA(ai, bj, At, Bt) do { __builtin_amdgcn_s_setprio(1); _Pragma("unroll") for (int m = 0; m < 4; ++m) _Pragma("unroll") for (int n = 0; n < 2; ++n) _Pragma("unroll") for (int k = 0; k < 2; ++k) \
        acc[ai][bj][m][n] = __builtin_amdgcn_mfma_f32_16x16x32_bf16(Bt[n][k], At[m][k], acc[ai][bj][m][n], 0, 0, 0); __builtin_amdgcn_s_setprio(0); } while (0)
#define PG8_WAIT_V(n) asm volatile("s_waitcnt vmcnt(" #n ")" ::: "memory")
#define PG8_WAIT_L(n) asm volatile("s_waitcnt lgkmcnt(" #n ")" ::: "memory")
#define PG8_BAR __builtin_amdgcn_s_barrier()
#define PG8_SCHED __builtin_amdgcn_sched_barrier(0)
    Unit cur, nxt; int ui = 0;
    if (!S.next(0, cur)) return;
    f32x4 acc[2][2][4][2];
#pragma unroll
    for (int a = 0; a < 2; ++a)
#pragma unroll
        for (int b = 0; b < 2; ++b)
#pragma unroll
            for (int m = 0; m < 4; ++m)
#pragma unroll
                for (int n = 0; n < 2; ++n) acc[a][b][m][n] = (f32x4){0.f, 0.f, 0.f, 0.f};
    bf16x8 At[4][2], B0[2][2], B1[2][2];
    const char* cA = (const char*)g.A + (size_t)cur.pm * tstep; const char* cB = (const char*)g.Bt + (size_t)cur.pn * tstep;
    S.a_ready(cur);
    if constexpr (SP2) {
        PG8_STAGE(PG8_SB(0, 0), cB, voffB); PG8_STAGE(PG8_SB(0, 1), cB + hstep, voffB); PG8_STAGE(PG8_SA(0, 0), cA, voffA); PG8_STAGE(PG8_SA(0, 1), cA + hstep, voffA);
        if (wr == 1) PG8_BAR;
        PG8_WAIT_V(2); PG8_BAR;
        PG8_STAGE(PG8_SB(1, 0), cB + kstep, voffB); PG8_STAGE(PG8_SA(1, 0), cA + kstep, voffA); PG8_STAGE(PG8_SB(1, 1), cB + hstep + kstep, voffB);
        PG8_WAIT_V(6); PG8_BAR;
    } else {
        PG8_STAGE(PG8_SB(0, 0), cB, voffB); PG8_STAGE(PG8_SA(0, 0), cA, voffA); PG8_STAGE(PG8_SB(0, 1), cB + hstep, voffB); PG8_STAGE(PG8_SA(0, 1), cA + hstep, voffA);
        if (wr == 1) PG8_BAR;
        PG8_WAIT_V(4); PG8_BAR;
        PG8_STAGE(PG8_SB(1, 0), cB + kstep, voffB); PG8_STAGE(PG8_SA(1, 0), cA + kstep, voffA); PG8_STAGE(PG8_SB(1, 1), cB + hstep + kstep, voffB);
        PG8_WAIT_V(6); PG8_BAR;
    }
    for (;;) {
        const bool has_next = S.next(ui + 1, nxt);
        const char* nA = has_next ? (const char*)g.A + (size_t)nxt.pm * tstep : cA; const char* nB = has_next ? (const char*)g.Bt + (size_t)nxt.pn * tstep : cB;
        for (int t = 0; t < nt; t += 2) {
            const bool last = (t == nt - 2);
            const char* a1 = cA + (size_t)(t + 1) * kstep;
            const char* a2 = last ? nA : cA + (size_t)(t + 2) * kstep; const char* b2 = last ? nB : cB + (size_t)(t + 2) * kstep;
            const char* a3 = a2 + kstep; const char* b3 = b2 + kstep;
            if (last && has_next) S.a_ready(nxt);
            if constexpr (SP2) {
            PG8_LDB(B0, 0, 0); PG8_LDB(B1, 0, 1); PG8_SCHED; PG8_LDA(At, 0, 0); PG8_STAGE(PG8_SA(1, 1), a1 + hstep, voffA);
            PG8_WAIT_V(8); PG8_WAIT_L(0); PG8_BAR; PG8_MMA(0, 0, At, B0); PG8_MMA(0, 1, At, B1); PG8_BAR; PG8_SCHED;
            PG8_LDA(At, 0, 1); PG8_STAGE(PG8_SB(0, 0), b2, voffB); PG8_STAGE(PG8_SB(0, 1), b2 + hstep, voffB); PG8_STAGE(PG8_SA(0, 0), a2, voffA);
            PG8_WAIT_V(8); PG8_WAIT_L(0); PG8_BAR; PG8_MMA(1, 0, At, B0); PG8_MMA(1, 1, At, B1); PG8_BAR; PG8_SCHED;
            PG8_LDB(B0, 1, 0); PG8_LDB(B1, 1, 1); PG8_SCHED; PG8_LDA(At, 1, 0); PG8_STAGE(PG8_SA(0, 1), a2 + hstep, voffA);
            PG8_WAIT_V(8); PG8_WAIT_L(0); PG8_BAR; PG8_MMA(0, 0, At, B0); PG8_MMA(0, 1, At, B1); PG8_BAR; PG8_SCHED;
            PG8_LDA(At, 1, 1); PG8_STAGE(PG8_SB(1, 0), b3, voffB); PG8_STAGE(PG8_SB(1, 1), b3 + hstep, voffB); PG8_STAGE(PG8_SA(1, 0), a3, voffA);
            PG8_WAIT_V(8); PG8_WAIT_L(0); PG8_BAR; PG8_MMA(1, 0, At, B0); PG8_MMA(1, 1, At, B1); PG8_BAR; PG8_SCHED;
            } else {
            PG8_LDB(B0, 0, 0); PG8_SCHED; PG8_LDA(At, 0, 0); PG8_STAGE(PG8_SA(1, 1), a1 + hstep, voffA);
            PG8_WAIT_L(8); PG8_BAR; PG8_WAIT_L(0); PG8_MMA(0, 0, At, B0); PG8_BAR; PG8_SCHED;
            PG8_LDB(B1, 0, 1); PG8_STAGE(PG8_SB(0, 0), b2, voffB);
            PG8_BAR; PG8_WAIT_L(0); PG8_MMA(0, 1, At, B1); PG8_BAR;
            PG8_LDA(At, 0, 1); PG8_STAGE(PG8_SA(0, 0), a2, voffA);
            PG8_BAR; PG8_WAIT_L(0); PG8_MMA(1, 0, At, B0); PG8_BAR; PG8_SCHED;
            PG8_STAGE(PG8_SB(0, 1), b2 + hstep, voffB);
            PG8_WAIT_V(6); PG8_BAR; PG8_MMA(1, 1, At, B1); PG8_BAR;
            PG8_LDB(B0, 1, 0); PG8_SCHED; PG8_LDA(At, 1, 0); PG8_STAGE(PG8_SA(0, 1), a2 + hstep, voffA);
            PG8_WAIT_L(8); PG8_BAR; PG8_WAIT_L(0); PG8_MMA(0, 0, At, B0); PG8_BAR; PG8_SCHED;
            PG8_LDB(B1, 1, 1); PG8_STAGE(PG8_SB(1, 0), b3, voffB);
            PG8_BAR; PG8_WAIT_L(0); PG8_MMA(0, 1, At, B1); PG8_BAR;
            PG8_LDA(At, 1, 1); PG8_STAGE(PG8_SA(1, 0), a3, voffA);
            PG8_BAR; PG8_WAIT_L(0); PG8_MMA(1, 0, At, B0); PG8_BAR; PG8_SCHED;
            PG8_STAGE(PG8_SB(1, 1), b3 + hstep, voffB);
            PG8_WAIT_V(6); PG8_BAR; PG8_MMA(1, 1, At, B1); PG8_BAR;
            }
        }
        if constexpr (ALIGN_EPI) { if (wr == 0) PG8_BAR; }
        if constexpr (!Epi::AFTER_DRAIN) { E(acc, cur, wr, wc, fr, fq); S.done(cur); }
        if (!has_next) break;
#pragma unroll
        for (int a = 0; a < 2; ++a)
#pragma unroll
            for (int b = 0; b < 2; ++b)
#pragma unroll
                for (int m = 0; m < 4; ++m)
#pragma unroll
                    for (int n = 0; n < 2; ++n) acc[a][b][m][n] = (f32x4){0.f, 0.f, 0.f, 0.f};
        cur = nxt; cA = nA; cB = nB; ++ui;
        if constexpr (ALIGN_EPI) { if (wr == 1) PG8_BAR; }
    }
    PG8_WAIT_V(0);
    if constexpr (!ALIGN_EPI) { if (wr == 0) PG8_BAR; }
    PG8_BAR;
    if constexpr (Epi::AFTER_DRAIN) { E.fused(acc, cur, wr, wc, fr, fq, lds, wid, lane); S.done(cur); }
#undef PG8_SA
#undef PG8_SB
#undef PG8_STAGE
#undef PG8_LDA
#undef PG8_LDB
#undef PG8_MMA
#undef PG8_WAIT_V
#undef PG8_WAIT_L
#undef PG8_BAR
#undef PG8_SCHED
}
}

#include <hip/hip_cooperative_groups.h>
namespace cg = cooperative_groups;
#define LAS __attribute__((address_space(3)))
typedef unsigned short bf16;
typedef unsigned v4u __attribute__((ext_vector_type(4)));
typedef unsigned v2u __attribute__((ext_vector_type(2)));
typedef float f32x4 __attribute__((ext_vector_type(4)));
typedef float f32x2 __attribute__((ext_vector_type(2)));
typedef float f32x16 __attribute__((ext_vector_type(16)));
typedef short bf16x8 __attribute__((ext_vector_type(8)));

#ifndef MK_PER_PHASE
#define MK_PER_PHASE 0
#endif
constexpr int NB = 2, S = 16384, DM = 2048, T = NB * S, NH = 8, HD = 128, AW = 1024, CC = 1024, INW = 5120, FF = 8192, NMEM = 256, XH = 4, XW = 512, CONVK = 31, NBLK = 64;
constexpr float EPS = 1e-6f, LOG2E = 1.4426950408889634f;
constexpr int NPHASE = 15;
constexpr size_t MiB = 1u << 20;
constexpr size_t WS_CTL = 0; constexpr int CW_BAR = 4096;
constexpr size_t WS_WIN = 2 * MiB, WS_WOUT = 22 * MiB, WS_WQ = 30 * MiB, WS_WKV = 32 * MiB, WS_WO = 36 * MiB, WS_W1 = 38 * MiB, WS_W2 = 70 * MiB;
constexpr size_t WS_KBAR = 102 * MiB, WS_TB = 103 * MiB, WS_MN = 104 * MiB, WS_KC = 106 * MiB, WS_VCT = 107 * MiB;
constexpr size_t WS_NB = 112 * MiB;
constexpr size_t WS_Q = 240 * MiB, WS_K = 304 * MiB, WS_VT = 368 * MiB, WS_UV = 432 * MiB, WS_UG = 496 * MiB;
constexpr size_t WS_AC = 560 * MiB;
constexpr size_t WS_F = 240 * MiB;
constexpr size_t WS_QC = 240 * MiB, WS_OC = 272 * MiB;
constexpr size_t WS_PO = 752 * MiB;
constexpr size_t WS_PML = 944 * MiB;
constexpr size_t WS_LIST = 952 * MiB;
constexpr size_t WS_END = 1016 * MiB;
constexpr int LDS_BYTES = 152064;
constexpr int KS_OFF = 0, KROW = 272, VS_OFF = 256 * 272, VROW = 528  , TB_OFF = VS_OFF + 128 * 528, RED_OFF = TB_OFF + 8192, CNT_OFF = RED_OFF + 2048, PT_OFF = CNT_OFF + 4096, ST_OFF = PT_OFF + 192;
static_assert(PT_OFF + 256 <= LDS_BYTES, "LDS map");

__device__ __forceinline__ float bf_lo(unsigned w) { return __uint_as_float(w << 16); }
__device__ __forceinline__ float bf_hi(unsigned w) { return __uint_as_float(w & 0xffff0000u); }
typedef __bf16 bf16x2_t __attribute__((ext_vector_type(2)));
__device__ __forceinline__ unsigned pk2(float lo, float hi) { return pg8::cvt_pk_bf16(lo, hi); }
__device__ __forceinline__ unsigned pk2s(float lo, float hi) { f32x2 v = {lo, hi}; bf16x2_t b = __builtin_convertvector(v, bf16x2_t); return __builtin_bit_cast(unsigned, b); }
__device__ __forceinline__ float ex2(float x) { return __builtin_amdgcn_exp2f(x); }
__device__ __forceinline__ float wave_sum(float v) {
#pragma unroll
    for (int o = 1; o < 64; o <<= 1) v += __shfl_xor(v, o);
    return v;
}
__device__ __forceinline__ float sigmoidf_(float x) { return 1.0f / (1.0f + __expf(-x)); }

__device__ __forceinline__ void p0_transpose_item(const float* W, int K, int N, bf16* WT, int row_off, LAS float* scr, int item, int lane, const float* gk = nullptr) {
    const int nblk = N / 32, kb = item / nblk, nb = item % nblk, k0 = 64 * kb, n0 = 32 * nb;
    float wv[32];
#pragma unroll
    for (int i = 0; i < 32; ++i) { const int kk = 2 * i + (lane >> 5); wv[i] = W[(size_t)(k0 + kk) * N + n0 + (lane & 31)]; }
    if (gk) {
#pragma unroll
        for (int i = 0; i < 32; ++i) wv[i] *= gk[k0 + 2 * i + (lane >> 5)];
    }
#pragma unroll
    for (int i = 0; i < 32; ++i) { const int kk = 2 * i + (lane >> 5); scr[kk * 33 + (lane & 31)] = wv[i]; }
    asm volatile("s_waitcnt lgkmcnt(0)" ::: "memory");
    const int c = lane & 7;
#pragma unroll
    for (int j = 0; j < 4; ++j) { const int n = (lane >> 3) + 8 * j; const LAS float* s = scr + (8 * c) * 33 + n;
        v4u o; o.x = pk2(s[0 * 33], s[1 * 33]); o.y = pk2(s[2 * 33], s[3 * 33]); o.z = pk2(s[4 * 33], s[5 * 33]); o.w = pk2(s[6 * 33], s[7 * 33]);
        *(v4u*)(WT + (size_t)(row_off + n0 + n) * K + k0 + 8 * c) = o; }
    asm volatile("s_waitcnt lgkmcnt(0)" ::: "memory");
}
__device__ __forceinline__ void rms_row_bf16(const float* xrow, const float* g, bf16* orow, int lane) {
    const f32x4* xr = (const f32x4*)xrow + lane; f32x4 v[8]; float s = 0.f;
#pragma unroll
    for (int j = 0; j < 8; ++j) { v[j] = xr[64 * j]; s += (v[j].x * v[j].x + v[j].y * v[j].y) + (v[j].z * v[j].z + v[j].w * v[j].w); }
    const float rstd = 1.0f / sqrtf(wave_sum(s) * (1.0f / DM) + EPS);
    const f32x4* gr = (const f32x4*)g + lane; v2u* o8 = (v2u*)orow + lane;
#pragma unroll
    for (int j = 0; j < 8; ++j) { const f32x4 gv = gr[64 * j]; v2u w; w.x = pk2(v[j].x * rstd * gv.x, v[j].y * rstd * gv.y); w.y = pk2(v[j].z * rstd * gv.z, v[j].w * rstd * gv.w); o8[64 * j] = w; }
}
__device__ __forceinline__ void rms_row_f32(const float* xrow, const float* g, float* orow, int lane) {
    const f32x4* xr = (const f32x4*)xrow + lane; f32x4 v[8]; float s = 0.f;
#pragma unroll
    for (int j = 0; j < 8; ++j) { v[j] = xr[64 * j]; s += (v[j].x * v[j].x + v[j].y * v[j].y) + (v[j].z * v[j].z + v[j].w * v[j].w); }
    const float rstd = 1.0f / sqrtf(wave_sum(s) * (1.0f / DM) + EPS);
    const f32x4* gr = (const f32x4*)g + lane; f32x4* o = (f32x4*)orow + lane;
#pragma unroll
    for (int j = 0; j < 8; ++j) { const f32x4 gv = gr[64 * j]; o[64 * j] = v[j] * rstd * gv; }
}

__device__ __forceinline__ int crow(int r, int hi) { return (r & 3) + 8 * (r >> 2) + 4 * hi; }
__device__ __forceinline__ void attn_stage(LAS unsigned char* lds, const bf16* Kg, unsigned kstride, const bf16* VTg, unsigned vstride, const float* tbg, int tid) {
    const unsigned ko = (unsigned)(tid >> 4) * (kstride * 2u) + (unsigned)(tid & 15) * 16u, vo = (unsigned)(tid >> 5) * (vstride * 2u) + (unsigned)(tid & 31) * 16u;
    const unsigned kl = (unsigned)(tid >> 4) * KROW + (unsigned)(tid & 15) * 16u, vl = (unsigned)(tid >> 5) * VROW + (unsigned)(tid & 31) * 16u;
    v4u kx[8], vx[8];
#pragma unroll
    for (int p = 0; p < 8; ++p) kx[p] = *(const v4u*)((const unsigned char*)Kg + (size_t)p * 32 * kstride * 2 + ko);
#pragma unroll
    for (int p = 0; p < 8; ++p) vx[p] = *(const v4u*)((const unsigned char*)VTg + (size_t)p * 16 * vstride * 2 + vo);
#pragma unroll
    for (int p = 0; p < 8; ++p) *(LAS v4u*)(lds + KS_OFF + p * 32 * KROW + kl) = kx[p];
    { const unsigned c = (unsigned)(tid & 31), vl2 = (unsigned)(tid >> 5) * VROW + (c >> 1) * 32u + (c & 1u) * 8u;
#pragma unroll
      for (int p = 0; p < 8; ++p) { v2u a2, b2; a2.x = vx[p].x; a2.y = vx[p].y; b2.x = vx[p].z; b2.y = vx[p].w;
        *(LAS v2u*)(lds + VS_OFF + p * 16 * VROW + vl2) = a2; *(LAS v2u*)(lds + VS_OFF + p * 16 * VROW + vl2 + 16) = b2; } }
    if (tbg) { const f32x4 x = ((const f32x4*)tbg)[tid]; ((LAS f32x4*)(lds + TB_OFF))[tid] = x; }
}
__device__ __forceinline__ void load_q(bf16x8 (&qf)[8], const bf16* qp, int hi) {
#pragma unroll
    for (int ks = 0; ks < 8; ++ks) qf[ks] = *(const bf16x8*)(qp + 16 * ks + 8 * hi);
}
__device__ __forceinline__ void store_o16(bf16* rowbase, const f32x16 (&O)[4], float scale, int hi, bool doit) {
#pragma unroll
    for (int dt = 0; dt < 4; ++dt)
#pragma unroll
        for (int gp = 0; gp < 2; ++gp) {
            const int ga = 2 * gp, gb = 2 * gp + 1;
            const unsigned ax = pk2(O[dt][4 * ga] * scale, O[dt][4 * ga + 1] * scale), ay = pk2(O[dt][4 * ga + 2] * scale, O[dt][4 * ga + 3] * scale);
            const unsigned bx = pk2(O[dt][4 * gb] * scale, O[dt][4 * gb + 1] * scale), by = pk2(O[dt][4 * gb + 2] * scale, O[dt][4 * gb + 3] * scale);
            const v2u r1 = __builtin_amdgcn_permlane32_swap(ax, bx, false, false), r2 = __builtin_amdgcn_permlane32_swap(ay, by, false, false);
            v4u w; w.x = r1.x; w.y = r2.x; w.z = r1.y; w.w = r2.y;
            if (doit) *(v4u*)(rowbase + 32 * dt + 8 * (hi ? gb : ga)) = w;
        }
}
template <int MODE>
__device__ __forceinline__ void attn_core(LAS unsigned char* lds, const bf16x8 (&qf)[8], int qrel, float sc, int nchunks, bool fast, float cbias, f32x16 (&O)[4], float& m, float& l, int lane) {
    const int l31 = lane & 31, hi = lane >> 5;
#pragma unroll
    for (int dt = 0; dt < 4; ++dt)
#pragma unroll
        for (int r = 0; r < 16; ++r) O[dt][r] = 0.f;
    m = -1e30f; l = 0.f;
    const LAS float* tb = (const LAS float*)(lds + TB_OFF);
#pragma unroll 1
    for (int c = 0; c < nchunks; ++c) {
        f32x16 s0, s1;
#pragma unroll
        for (int r = 0; r < 16; ++r) { s0[r] = 0.f; s1[r] = 0.f; }
        const LAS unsigned char* kp = lds + KS_OFF + (64 * c + l31) * KROW + 16 * hi;
#pragma unroll
        for (int h2 = 0; h2 < 2; ++h2) {
            bf16x8 ka[4], kb[4];
#pragma unroll
            for (int ks = 0; ks < 4; ++ks) { ka[ks] = *(const LAS bf16x8*)(kp + 32 * (4 * h2 + ks)); kb[ks] = *(const LAS bf16x8*)(kp + 32 * KROW + 32 * (4 * h2 + ks)); }
#pragma unroll
            for (int ks = 0; ks < 4; ++ks) {
                s0 = __builtin_amdgcn_mfma_f32_32x32x16_bf16(ka[ks], qf[4 * h2 + ks], s0, 0, 0, 0);
                s1 = __builtin_amdgcn_mfma_f32_32x32x16_bf16(kb[ks], qf[4 * h2 + ks], s1, 0, 0, 0);
            }
        }
        float mx = -INFINITY;
#pragma unroll
        for (int r = 0; r < 16; ++r) {
            const int d0 = qrel - (64 * c + crow(r, hi)), d1 = d0 - 32;
            float t0 = s0[r] * sc, t1 = s1[r] * sc;
            if (MODE == 0) { if (fast) { t0 += cbias; t1 += cbias; } else { t0 += tb[d0 < 2047 ? d0 : 2047]; t1 += tb[d1 < 2047 ? d1 : 2047]; } }
            if (MODE == 1) { t0 = d0 >= 0 ? t0 + tb[d0 > 0 ? d0 : 0] : -INFINITY; t1 = d1 >= 0 ? t1 + tb[d1 > 0 ? d1 : 0] : -INFINITY; }
            s0[r] = t0; s1[r] = t1; mx = fmaxf(mx, fmaxf(t0, t1));
        }
        mx = fmaxf(mx, __shfl_xor(mx, 32));
        const float mn = fmaxf(m, mx), alpha = ex2(m - mn); m = mn;
        float ls = 0.f;
#pragma unroll
        for (int r = 0; r < 16; ++r) { s0[r] = ex2(s0[r] - mn); s1[r] = ex2(s1[r] - mn); ls += s0[r] + s1[r]; }
        l = l * alpha + ls;
        if (c > 0) {
#pragma unroll
            for (int dt = 0; dt < 4; ++dt)
#pragma unroll
                for (int r = 0; r < 16; ++r) O[dt][r] *= alpha;
        }
#pragma unroll
        for (int kt2 = 0; kt2 < 2; ++kt2) {
            bf16x8 pb[2];
#pragma unroll
            for (int sp = 0; sp < 2; ++sp) {
                v4u pw;
                if (kt2 == 0) { pw.x = pk2s(s0[8 * sp + 0], s0[8 * sp + 1]); pw.y = pk2s(s0[8 * sp + 2], s0[8 * sp + 3]); pw.z = pk2s(s0[8 * sp + 4], s0[8 * sp + 5]); pw.w = pk2s(s0[8 * sp + 6], s0[8 * sp + 7]); }
                else          { pw.x = pk2s(s1[8 * sp + 0], s1[8 * sp + 1]); pw.y = pk2s(s1[8 * sp + 2], s1[8 * sp + 3]); pw.z = pk2s(s1[8 * sp + 4], s1[8 * sp + 5]); pw.w = pk2s(s1[8 * sp + 6], s1[8 * sp + 7]); }
                pb[sp] = __builtin_bit_cast(bf16x8, pw);
            }
            const LAS unsigned char* vp = lds + VS_OFF + l31 * VROW + (64 * c + 32 * kt2) * 2 + 16 * hi;
            bf16x8 va[2][4];
#pragma unroll
            for (int sp = 0; sp < 2; ++sp)
#pragma unroll
                for (int dt = 0; dt < 4; ++dt) va[sp][dt] = *(const LAS bf16x8*)(vp + sp * 32 + dt * 32 * VROW);
#pragma unroll
            for (int sp = 0; sp < 2; ++sp)
#pragma unroll
                for (int dt = 0; dt < 4; ++dt) O[dt] = __builtin_amdgcn_mfma_f32_32x32x16_bf16(va[sp][dt], pb[sp], O[dt], 0, 0, 0);
        }
    }
    l += __shfl_xor(l, 32);
}

#define XB_TMO      128
#define XB_XCNT(j)  (256  + 64 * (j))
#define XB_XSUB(j)  (1280 + 64 * (j))
#define XB_XGEN(j)  (2304 + 64 * (j))
#define XB_TOP      3328
#define XB_TOPGEN   3392
#define XCD_BAR_WORDS 3456
#define XB_SPIN_CAP (1u << 18)

__device__ __forceinline__ unsigned xb_ld(unsigned* p)              { return __hip_atomic_load(p, __ATOMIC_RELAXED, __HIP_MEMORY_SCOPE_AGENT); }
__device__ __forceinline__ unsigned xb_add(unsigned* p, unsigned v) { return __hip_atomic_fetch_add(p, v, __ATOMIC_RELAXED, __HIP_MEMORY_SCOPE_AGENT); }
__device__ __forceinline__ unsigned xb_xcc_id() { return (unsigned)__builtin_amdgcn_s_getreg((3 << 11) | 20) & 0xFu; }
#define XB_SPIN(cond, bar) do { unsigned _sp = 0; while (cond) { __builtin_amdgcn_s_sleep(1); \
    if ((++_sp & 255u) == 0u) { if (xb_ld(&(bar)[XB_TMO])) break; if (_sp > XB_SPIN_CAP) { atomicAdd(&(bar)[XB_TMO], 1u); break; } } } } while (0)

struct XcdBarrier {
    unsigned* bar; unsigned x;
    volatile LAS unsigned* st;
};

__device__ __forceinline__ XcdBarrier xcd_barrier_post(unsigned* bar, volatile LAS unsigned* st, int tid) {
    XcdBarrier b; b.bar = bar; b.x = xb_xcc_id(); b.st = st;
    if (tid == 0) (void)xb_add(&bar[XB_XCNT(b.x)], 1u);
    return b;
}
__device__ __forceinline__ void xcd_barrier_complete(unsigned* bar, unsigned x, unsigned& nloc, unsigned& nx) {
    const unsigned G = gridDim.x * gridDim.y * gridDim.z;
    unsigned sum, cnt, mine, sp = 0u;
    for (;;) {
        sum = 0u; cnt = 0u; mine = 0u;
#pragma unroll
        for (unsigned j = 0; j < 16; ++j) { const unsigned c = xb_ld(&bar[XB_XCNT(j)]); sum += c; cnt += (c > 0u) ? 1u : 0u; mine = (j == x) ? c : mine; }
        if (sum == G) break;
        __builtin_amdgcn_s_sleep(1);
        if ((++sp & 255u) == 0u) { if (xb_ld(&bar[XB_TMO])) break; if (sp > XB_SPIN_CAP) { atomicAdd(&bar[XB_TMO], 1u); break; } }
    }
    nloc = mine > 0u ? mine : 1u; nx = cnt > 0u ? cnt : 1u;
}

__device__ __forceinline__ void xcd_barrier(const XcdBarrier& b, int tid) {
    asm volatile("s_waitcnt vmcnt(0)" ::: "memory");
    __syncthreads();
    if (tid == 0) {
        unsigned* bar = b.bar;
        __builtin_amdgcn_s_waitcnt(0);
        unsigned nloc = b.st[0], nx = b.st[1];
        if (nloc == 0u) { xcd_barrier_complete(bar, b.x, nloc, nx); b.st[0] = nloc; b.st[1] = nx; }
        const unsigned old = xb_add(&bar[XB_XSUB(b.x)], 1u);
        const unsigned gen = old / nloc;
        if (old + 1u == (gen + 1u) * nloc) {
            __builtin_amdgcn_fence(__ATOMIC_RELEASE, "agent");
            asm volatile("s_waitcnt vmcnt(0)" ::: "memory");
            const unsigned og = xb_add(&bar[XB_TOP], 1u);
            const unsigned tg = og / nx;
            if (og + 1u == (tg + 1u) * nx) xb_add(&bar[XB_TOPGEN], 1u);
            else XB_SPIN(xb_ld(&bar[XB_TOPGEN]) == tg, bar);
            __builtin_amdgcn_fence(__ATOMIC_ACQUIRE, "agent");
            xb_add(&bar[XB_XGEN(b.x)], 1u);
            asm volatile("s_waitcnt vmcnt(0)" ::: "memory");
        } else {
            XB_SPIN(xb_ld(&bar[XB_XGEN(b.x)]) == gen, bar);
            __builtin_amdgcn_fence(__ATOMIC_ACQUIRE, "agent");
            asm volatile("s_waitcnt vmcnt(0)" ::: "memory");
        }
    }
    __syncthreads();
}

struct Args { const float* in[20]; float* out; unsigned char* ws; int ph_lo, ph_hi; };

__global__ void __launch_bounds__(512, 2) fwd(Args a) {
    extern __shared__ __attribute__((aligned(16))) unsigned char lds_raw[];
    LAS unsigned char* lds = (LAS unsigned char*)lds_raw;
    const int wave = __builtin_amdgcn_readfirstlane((int)threadIdx.x >> 6);
    const int G = gridDim.x, blk = blockIdx.x;
    const int lo = a.ph_lo, hiP = a.ph_hi;
    LAS unsigned long long* ptab = (LAS unsigned long long*)(lds + PT_OFF);
    if (threadIdx.x == 0) {
#pragma unroll
        for (int i = 0; i < 20; ++i) ptab[i] = (unsigned long long)a.in[i];
        ptab[20] = (unsigned long long)a.out; ptab[21] = (unsigned long long)a.ws;
        ((LAS unsigned*)(lds + ST_OFF))[0] = 0u; ((LAS unsigned*)(lds + ST_OFF))[1] = 0u;
    }
    __syncthreads();
    if (a.ph_hi - a.ph_lo > 1) {
        cg::this_grid().sync();
        const int lane_ = (int)__builtin_amdgcn_mbcnt_hi(~0u, __builtin_amdgcn_mbcnt_lo(~0u, 0u));
        (void)xcd_barrier_post((unsigned*)(a.ws + WS_CTL) + CW_BAR, (volatile LAS unsigned*)(lds + ST_OFF), wave * 64 + lane_);
    }
#define LDP(i) ((unsigned char*)(__attribute__((address_space(1))) unsigned char*)(((unsigned long long)(unsigned)__builtin_amdgcn_readfirstlane((int)(unsigned)(ptab[i] >> 32)) << 32) | (unsigned long long)(unsigned)__builtin_amdgcn_readfirstlane((int)(unsigned)ptab[i])))
#define DECL_PTRS \
    const int lane = (int)__builtin_amdgcn_mbcnt_hi(~0u, __builtin_amdgcn_mbcnt_lo(~0u, 0u)), tid = wave * 64 + lane, l31 = lane & 31, hi = lane >> 5; (void)tid; (void)l31; (void)hi; \
    const float* const x = (const float*)LDP(0); (void)x; \
    const float* const mem = (const float*)LDP(1); (void)mem; \
    const float* const g_mix = (const float*)LDP(2); (void)g_mix; \
    const float* const w_in = (const float*)LDP(3); (void)w_in; \
    const float* const conv_w = (const float*)LDP(4); (void)conv_w; \
    const float* const conv_b = (const float*)LDP(5); (void)conv_b; \
    const float* const ln_g = (const float*)LDP(6); (void)ln_g; \
    const float* const ln_b = (const float*)LDP(7); (void)ln_b; \
    const float* const w_out = (const float*)LDP(8); (void)w_out; \
    const float* const rel_bias = (const float*)LDP(9); (void)rel_bias; \
    const float* const g_cross = (const float*)LDP(10); (void)g_cross; \
    const float* const g_mem = (const float*)LDP(11); (void)g_mem; \
    const float* const wq_c = (const float*)LDP(12); (void)wq_c; \
    const float* const wk_c = (const float*)LDP(13); (void)wk_c; \
    const float* const wv_c = (const float*)LDP(14); (void)wv_c; \
    const float* const wo_c = (const float*)LDP(15); (void)wo_c; \
    const float* const g_mlp = (const float*)LDP(16); (void)g_mlp; \
    const float* const w1 = (const float*)LDP(17); (void)w1; \
    const float* const w2 = (const float*)LDP(18); (void)w2; \
    const float* const g_final = (const float*)LDP(19); (void)g_final; \
    float* const out = (float*)LDP(20); (void)out; unsigned char* const ws = LDP(21); (void)ws; \
    unsigned* const CNT = (unsigned*)(ws + WS_CTL); (void)CNT; float* const SSQ1 = (float*)(ws + WS_CTL + 262144); (void)SSQ1; float* const SSQ2 = (float*)(ws + WS_CTL + 524288); (void)SSQ2; float* const SSQ3 = (float*)(ws + WS_CTL + 786432); (void)SSQ3; \
    bf16* const WIN_T = (bf16*)(ws + WS_WIN); (void)WIN_T; \
    bf16* const WOUT_T = (bf16*)(ws + WS_WOUT); (void)WOUT_T; \
    bf16* const WQ_T = (bf16*)(ws + WS_WQ); (void)WQ_T; \
    bf16* const WKV_T = (bf16*)(ws + WS_WKV); (void)WKV_T; \
    bf16* const WO_T = (bf16*)(ws + WS_WO); (void)WO_T; \
    bf16* const W1_T = (bf16*)(ws + WS_W1); (void)W1_T; \
    bf16* const W2_T = (bf16*)(ws + WS_W2); (void)W2_T; \
    float* const KBAR = (float*)(ws + WS_KBAR); (void)KBAR; \
    float* const TB = (float*)(ws + WS_TB); (void)TB; \
    bf16* const MN = (bf16*)(ws + WS_MN); (void)MN; \
    bf16* const KC = (bf16*)(ws + WS_KC); (void)KC; \
    bf16* const VCT = (bf16*)(ws + WS_VCT); (void)VCT; \
    bf16* const NBUF = (bf16*)(ws + WS_NB); (void)NBUF; \
    bf16* const Q = (bf16*)(ws + WS_Q); (void)Q; \
    bf16* const K = (bf16*)(ws + WS_K); (void)K; \
    bf16* const VT = (bf16*)(ws + WS_VT); (void)VT; \
    bf16* const UV = (bf16*)(ws + WS_UV); (void)UV; \
    bf16* const UG = (bf16*)(ws + WS_UG); (void)UG; \
    bf16* const AC = (bf16*)(ws + WS_AC); (void)AC; \
    bf16* const FB = (bf16*)(ws + WS_F); (void)FB; \
    bf16* const QC = (bf16*)(ws + WS_QC); (void)QC; \
    bf16* const OC = (bf16*)(ws + WS_OC); (void)OC; \
    bf16* const PO = (bf16*)(ws + WS_PO); (void)PO; \
    float* const PML = (float*)(ws + WS_PML); (void)PML; \
    unsigned* const LIST = (unsigned*)(ws + WS_LIST); (void)LIST; \
    do {} while (0)
    const float SC = 0.08838834764831845f * LOG2E;
#ifndef DBG
#define DBG 0
#endif
#ifndef REP_MASK
#define REP_MASK 0
#endif
#ifndef PH_MASK
#define PH_MASK 0x7fff
#endif
#define IN(k) (((PH_MASK >> (k)) & 1) && lo <= (k) && (k) < hiP)
#define SEAM2(k, kn) do { if (IN(k) && IN(kn)) { const int lane_ = (int)__builtin_amdgcn_mbcnt_hi(~0u, __builtin_amdgcn_mbcnt_lo(~0u, 0u)); \
        XcdBarrier b_; b_.bar = (unsigned*)(LDP(21) + WS_CTL) + CW_BAR; b_.x = xb_xcc_id(); b_.st = (volatile LAS unsigned*)(lds + ST_OFF); xcd_barrier(b_, wave * 64 + lane_); } } while (0)
#define SEAM(k) SEAM2(k, (k) + 1)
#define GRID_BAR() do { const int lane_ = (int)__builtin_amdgcn_mbcnt_hi(~0u, __builtin_amdgcn_mbcnt_lo(~0u, 0u)); \
        XcdBarrier b_; b_.bar = (unsigned*)(LDP(21) + WS_CTL) + CW_BAR; b_.x = xb_xcc_id(); b_.st = (volatile LAS unsigned*)(lds + ST_OFF); xcd_barrier(b_, wave * 64 + lane_); } while (0)

    for (int rep_ = 0; rep_ < (IN(0) ? 1 + ((REP_MASK >> 0) & 1) : 0); ++rep_) { DECL_PTRS;
        LAS float* scr = (LAS float*)(lds + wave * 16384);
        const int gw = blk * 8 + wave, NGW = G * 8;
        constexpr int I_IN = (DM / 64) * (INW / 32), I_OUT = (DM / 64) * (DM / 32), I_X = (DM / 64) * (XW / 32), I_O = (XW / 64) * (DM / 32), I_1 = (DM / 64) * (FF / 32), I_2 = (FF / 64) * (DM / 32);
        constexpr int NITEMS = I_IN + I_OUT + 3 * I_X + I_O + I_1 + I_2;
        const bool early = (G > 16) && (hiP - lo > 1);
        for (int it = gw; it < 2 * I_X; it += NGW) { if (it < I_X) p0_transpose_item(wk_c, DM, XW, WKV_T, 0, scr, it, lane); else p0_transpose_item(wv_c, DM, XW, WKV_T, XW, scr, it - I_X, lane); }
        for (int mrow = gw; mrow < NB * NMEM; mrow += NGW) rms_row_bf16(mem + (size_t)mrow * DM, g_mem, MN + (size_t)mrow * DM, lane);
        for (int i = blk * 512 + tid; i < NH * 2048; i += G * 512) {
            const int hh = i >> 11, d = i & 2047; int bucket = d;
            if (d >= 16) { const int lg = 16 + (int)(logf((float)d / 16.0f) / 4.852030263919617f * 16.0f); bucket = lg < 31 ? lg : 31; }
            TB[i] = rel_bias[bucket * NH + hh] * LOG2E;
        }
        if (early) { GRID_BAR(); }
        if (early && blk < 8) {
            pg8::Gemm g{MN, WKV_T, NB * NMEM, 2 * XW, DM}; pg8::StaticOrder So; So.init(NB * NMEM, 2 * XW, 8, blk);
            pg8::EpiBf16X<0> E{KC, XW, XW, (size_t)NB * NMEM * XW, 1, VCT, NMEM, XH, nullptr};
            pg8::gemm_phase<pg8::EpiBf16X<0>, pg8::StaticOrder, true, true>(lds, g, So, E, tid);
        } else {
        const int nb0 = early ? 8 : 0, gwb = (blk - nb0) * 8 + wave, NGWB = (G - nb0) * 8;
        constexpr int NREST = I_IN + I_OUT + I_X + I_O + I_1 + I_2;
        for (int it = gwb; it < NREST; it += NGWB) {
            int r = it;
            if (r < I_IN) { p0_transpose_item(w_in, DM, INW, WIN_T, 0, scr, r, lane); continue; } r -= I_IN;
            if (r < I_OUT) { p0_transpose_item(w_out, DM, DM, WOUT_T, 0, scr, r, lane); continue; } r -= I_OUT;
            if (r < I_X) { p0_transpose_item(wq_c, DM, XW, WQ_T, 0, scr, r, lane, g_cross); continue; } r -= I_X;
            if (r < I_O) { p0_transpose_item(wo_c, XW, DM, WO_T, 0, scr, r, lane); continue; } r -= I_O;
            if (r < I_1) { p0_transpose_item(w1, DM, FF, W1_T, 0, scr, r, lane, g_mlp); continue; } r -= I_1;
            p0_transpose_item(w2, FF, DM, W2_T, 0, scr, r, lane);
        }
        for (int mrow = gwb; mrow < T; mrow += 2 * NGWB) {
            const int r2 = mrow + NGWB;
            const f32x4* xa = (const f32x4*)(x + (size_t)mrow * DM) + lane; const f32x4* xb = (const f32x4*)(x + (size_t)(r2 < T ? r2 : mrow) * DM) + lane;
            f32x4 va[8], vb[8]; float sa = 0.f, sb = 0.f;
#pragma unroll
            for (int jj = 0; jj < 8; ++jj) { va[jj] = xa[64 * jj]; vb[jj] = xb[64 * jj]; }
#pragma unroll
            for (int jj = 0; jj < 8; ++jj) { sa += (va[jj].x * va[jj].x + va[jj].y * va[jj].y) + (va[jj].z * va[jj].z + va[jj].w * va[jj].w); sb += (vb[jj].x * vb[jj].x + vb[jj].y * vb[jj].y) + (vb[jj].z * vb[jj].z + vb[jj].w * vb[jj].w); }
            const float ra = 1.0f / sqrtf(wave_sum(sa) * (1.0f / DM) + EPS), rb = 1.0f / sqrtf(wave_sum(sb) * (1.0f / DM) + EPS);
            const f32x4* gr = (const f32x4*)g_mix + lane; v2u* oa = (v2u*)(NBUF + (size_t)mrow * DM) + lane; v2u* ob = (v2u*)(NBUF + (size_t)(r2 < T ? r2 : mrow) * DM) + lane;
#pragma unroll
            for (int jj = 0; jj < 8; ++jj) { const f32x4 gv = gr[64 * jj]; v2u w; w.x = pk2(va[jj].x * ra * gv.x, va[jj].y * ra * gv.y); w.y = pk2(va[jj].z * ra * gv.z, va[jj].w * ra * gv.w); oa[64 * jj] = w;
                if (r2 < T) { v2u w2; w2.x = pk2(vb[jj].x * rb * gv.x, vb[jj].y * rb * gv.y); w2.y = pk2(vb[jj].z * rb * gv.z, vb[jj].w * rb * gv.w); ob[64 * jj] = w2; } }
        }
        }
        __syncthreads();
    }
    SEAM(0);

    for (int rep_ = 0; rep_ < (IN(1) ? 1 + ((REP_MASK >> 1) & 1) : 0); ++rep_) { DECL_PTRS;
        { pg8::Gemm g{NBUF, WIN_T, T, INW, DM}; pg8::StaticOrder So; So.init(T, INW, G, blk);
          pg8::EpiBf16X<0> E{Q, AW, AW, (size_t)T * AW, 2, VT, S, NH, nullptr};
          pg8::gemm_phase<pg8::EpiBf16X<0>, pg8::StaticOrder, true, true>(lds, g, So, E, tid); }
        if (!((G > 16) && (hiP - lo > 1)))
        { pg8::Gemm g{MN, WKV_T, NB * NMEM, 2 * XW, DM}; pg8::StaticOrder So; So.init(NB * NMEM, 2 * XW, G, blk);
          pg8::EpiBf16X<0> E{KC, XW, XW, (size_t)NB * NMEM * XW, 1, VCT, NMEM, XH, nullptr};
          pg8::gemm_phase<pg8::EpiBf16X<0>, pg8::StaticOrder, true, true>(lds, g, So, E, tid); }
    }
    SEAM(1);

#if DBG == 9
    { DECL_PTRS; for (size_t i = (size_t)blk * 512 + tid; i < (size_t)T * DM; i += (size_t)G * 512) { out[i] = i < 262144 ? __uint_as_float(((unsigned)KC[i] << 16)) : (i < 524288 ? __uint_as_float(((unsigned)VCT[i - 262144] << 16)) : 0.f); } return; }
#endif
#if DBG == 1
    { DECL_PTRS; for (size_t i = (size_t)blk * 512 + tid; i < (size_t)T * DM; i += (size_t)G * 512) { const size_t t = i >> 11, c = i & 2047, e = t * 1024 + (c & 1023);
        const unsigned short v = c < 1024 ? (unsigned short)(Q[e] ^ UV[e]) : (unsigned short)(K[e] ^ UG[e] ^ VT[e]); out[i] = __uint_as_float(((unsigned)v << 16)) ; } return; }
#endif
    for (int rep_ = 0; rep_ < (IN(2) ? 1 + ((REP_MASK >> 2) & 1) : 0); ++rep_) { DECL_PTRS;
        for (int it = blk; it < 256; it += G) {
            const int b = it >> 7, j = (it >> 1) & 63, chh = it & 1, cp = tid & 255, rh = tid >> 8;
            const bf16* kp = K + (size_t)(b * S + j * 256 + rh * 128) * AW + chh * 512 + 2 * cp;
            float s0 = 0.f, s1 = 0.f;
#pragma unroll 8
            for (int r = 0; r < 128; ++r) { const unsigned w = *(const unsigned*)(kp + (size_t)r * AW); s0 += bf_lo(w); s1 += bf_hi(w); }
            LAS f32x2* red = (LAS f32x2*)lds;
            if (rh == 1) red[cp] = (f32x2){s0, s1};
            __syncthreads();
            if (rh == 0) { const f32x2 o = red[cp]; const int col = chh * 512 + 2 * cp, hh = col >> 7, d = col & 127;
                *(f32x2*)(KBAR + ((size_t)((b * NH + hh) * NBLK + j)) * HD + d) = (f32x2){(s0 + o.x) * (1.0f / 256.0f), (s1 + o.y) * (1.0f / 256.0f)}; }
            __syncthreads();
        }
        for (int seg = blk; seg < T / 128; seg += G) {
            const int t0 = seg * 128, c0 = 2 * tid;
            float w0[CONVK], w1r[CONVK];
#pragma unroll
            for (int k = 0; k < CONVK; ++k) { const f32x2 wv = *(const f32x2*)(conv_w + k * CC + c0); w0[k] = wv.x; w1r[k] = wv.y; }
            const f32x2 cb = *(const f32x2*)(conv_b + c0), lg = *(const f32x2*)(ln_g + c0), lb = *(const f32x2*)(ln_b + c0);
            float r0[32], r1[32];
#pragma unroll
            for (int i = 0; i < 32; ++i) { r0[i] = 0.f; r1[i] = 0.f; }
            LAS f32x2* red = (LAS f32x2*)(lds + RED_OFF);
#pragma unroll 1
            for (int ch = -1; ch < 4; ++ch) {
                const int tb0 = t0 + ch * 32;
                const bool zero = (ch < 0) && ((t0 & (S - 1)) == 0);
#pragma unroll
                for (int hf = 0; hf < 2; ++hf) {
                    float y0[16], y1[16];
#pragma unroll
                    for (int ii = 0; ii < 16; ++ii) {
                        const int i = hf * 16 + ii;
                        float h0 = 0.f, h1 = 0.f;
                        if (!zero) { const size_t off = (size_t)(tb0 + i) * CC + c0; const unsigned vv = *(const unsigned*)(UV + off), gg = *(const unsigned*)(UG + off);
                            h0 = bf_lo(vv) * sigmoidf_(bf_lo(gg)); h1 = bf_hi(vv) * sigmoidf_(bf_hi(gg)); }
                        r0[i] = h0; r1[i] = h1;
                        float a0 = cb.x, a1 = cb.y;
                        if (ch >= 0) {
#pragma unroll
                            for (int k = 0; k < CONVK; ++k) { a0 += r0[(i - 30 + k) & 31] * w0[k]; a1 += r1[(i - 30 + k) & 31] * w1r[k]; }
                        }
                        y0[ii] = a0; y1[ii] = a1;
                    }
                    if (ch >= 0) {
#pragma unroll
                        for (int gq = 0; gq < 2; ++gq) {
                            float rb[8], rc[4], rd[2];
                            const bool b5 = (lane & 32) != 0, b4 = (lane & 16) != 0, b3 = (lane & 8) != 0, b2 = (lane & 4) != 0;
#pragma unroll
                            for (int i = 0; i < 8; ++i) { const int tl = 8 * gq + (i >> 1), th = tl + 4;
                                const float fa = (i & 1) ? y0[tl] * y0[tl] + y1[tl] * y1[tl] : y0[tl] + y1[tl], fb = (i & 1) ? y0[th] * y0[th] + y1[th] * y1[th] : y0[th] + y1[th];
                                rb[i] = (b5 ? fb : fa) + __shfl_xor(b5 ? fa : fb, 32); }
#pragma unroll
                            for (int i = 0; i < 4; ++i) rc[i] = (b4 ? rb[4 + i] : rb[i]) + __shfl_xor(b4 ? rb[i] : rb[4 + i], 16);
#pragma unroll
                            for (int i = 0; i < 2; ++i) rd[i] = (b3 ? rc[2 + i] : rc[i]) + __shfl_xor(b3 ? rc[i] : rc[2 + i], 8);
                            float rf = (b2 ? rd[1] : rd[0]) + __shfl_xor(b2 ? rd[0] : rd[1], 4);
                            rf += __shfl_xor(rf, 2); rf += __shfl_xor(rf, 1);
                            const int kidx = ((lane >> 5) & 1) * 8 + ((lane >> 4) & 1) * 4 + ((lane >> 3) & 1) * 2 + ((lane >> 2) & 1);
                            if ((lane & 3) == 0) ((LAS float*)red)[(8 * gq + (kidx >> 1)) * 16 + wave * 2 + (kidx & 1)] = rf;
                        }
                        __syncthreads();
#pragma unroll
                        for (int ii = 0; ii < 16; ++ii) {
                            float s1 = 0.f, s2 = 0.f;
#pragma unroll
                            for (int w = 0; w < 4; ++w) { const f32x4 p = ((const LAS f32x4*)red)[ii * 4 + w]; s1 += p.x + p.z; s2 += p.y + p.w; }
                            const float mean = s1 * (1.0f / CC), var = fmaxf(s2 * (1.0f / CC) - mean * mean, 0.f), rstd = 1.0f / sqrtf(var + EPS);
                            float o0 = (y0[ii] - mean) * rstd * lg.x + lb.x, o1 = (y1[ii] - mean) * rstd * lg.y + lb.y;
                            o0 = o0 * sigmoidf_(o0); o1 = o1 * sigmoidf_(o1);
                            *(unsigned*)(AC + (size_t)(tb0 + hf * 16 + ii) * DM + AW + c0) = pk2(o0, o1);
                        }
                        __syncthreads();
                    }
                }
            }
        }
    }
    SEAM(2);

    for (int rep_ = 0; rep_ < (IN(3) ? 1 : 0); ++rep_) { DECL_PTRS;
        constexpr int KH_OFF = 0, KL_OFF = 64 * KROW;
        for (int it = blk; it < NB * NH * NBLK; it += G) {
            const int bh = it >> 6, own = it & 63, b = bh >> 3, hh = bh & 7;
            if (own == 0) continue;
            f32x2 kvv[8];
#pragma unroll
            for (int i = 0; i < 8; ++i) { const int p2 = tid + 512 * i; kvv[i] = *(const f32x2*)(KBAR + (size_t)bh * NBLK * HD + 2 * p2); }
#pragma unroll
            for (int i = 0; i < 8; ++i) { const int p2 = tid + 512 * i, jr = p2 >> 6, d = (p2 & 63) * 2; const f32x2 kv = kvv[i];
                const unsigned hw = pk2s(kv.x, kv.y); const unsigned lw = pk2s(kv.x - bf_lo(hw), kv.y - bf_hi(hw));
                *(LAS unsigned*)(lds + KH_OFF + jr * KROW + d * 2) = hw; *(LAS unsigned*)(lds + KL_OFF + jr * KROW + d * 2) = lw; }
            const int ql = own * 256 + wave * 32 + l31;
            bf16x8 qf[8]; load_q(qf, Q + (size_t)(b * S + ql) * AW + hh * HD, hi);
            __syncthreads();
            f32x16 g0, g1;
#pragma unroll
            for (int r = 0; r < 16; ++r) { g0[r] = 0.f; g1[r] = 0.f; }
            const LAS unsigned char* kp = lds + l31 * KROW + 16 * hi;
#pragma unroll
            for (int ks = 0; ks < 8; ++ks) {
                g0 = __builtin_amdgcn_mfma_f32_32x32x16_bf16(*(const LAS bf16x8*)(kp + KH_OFF + 32 * ks), qf[ks], g0, 0, 0, 0);
                g0 = __builtin_amdgcn_mfma_f32_32x32x16_bf16(*(const LAS bf16x8*)(kp + KL_OFF + 32 * ks), qf[ks], g0, 0, 0, 0);
            }
            if (own > 32) {
#pragma unroll
                for (int ks = 0; ks < 8; ++ks) {
                    g1 = __builtin_amdgcn_mfma_f32_32x32x16_bf16(*(const LAS bf16x8*)(kp + KH_OFF + 32 * KROW + 32 * ks), qf[ks], g1, 0, 0, 0);
                    g1 = __builtin_amdgcn_mfma_f32_32x32x16_bf16(*(const LAS bf16x8*)(kp + KL_OFF + 32 * KROW + 32 * ks), qf[ks], g1, 0, 0, 0);
                }
            }
            float v0 = -INFINITY, v1 = -INFINITY, v2 = -INFINITY; int i0 = 64, i1 = 64, i2 = 64;
#define TOP3_INS(val, idx) do { const float dv_ = (val); const int di_ = (idx); if (di_ < own && dv_ > v2) { if (dv_ > v1) { v2 = v1; i2 = i1; if (dv_ > v0) { v1 = v0; i1 = i0; v0 = dv_; i0 = di_; } else { v1 = dv_; i1 = di_; } } else { v2 = dv_; i2 = di_; } } } while (0)
#pragma unroll
            for (int r = 0; r < 16; ++r) TOP3_INS(g0[r], crow(r, hi));
            if (own > 32) {
#pragma unroll
                for (int r = 0; r < 16; ++r) TOP3_INS(g1[r], 32 + crow(r, hi));
            }
            const float pv0 = __shfl_xor(v0, 32), pv1 = __shfl_xor(v1, 32), pv2 = __shfl_xor(v2, 32); const int pi0 = __shfl_xor(i0, 32), pi1 = __shfl_xor(i1, 32), pi2 = __shfl_xor(i2, 32);
#define TOP3_MRG(val, idx) do { const float dv_ = (val); const int di_ = (idx); if (di_ < own) { \
                if (dv_ > v2 || (dv_ == v2 && di_ < i2)) { if (dv_ > v1 || (dv_ == v1 && di_ < i1)) { v2 = v1; i2 = i1; if (dv_ > v0 || (dv_ == v0 && di_ < i0)) { v1 = v0; i1 = i0; v0 = dv_; i0 = di_; } else { v1 = dv_; i1 = di_; } } else { v2 = dv_; i2 = di_; } } } } while (0)
            TOP3_MRG(pv0, pi0); TOP3_MRG(pv1, pi1); TOP3_MRG(pv2, pi2);
            const int nsel = own < 3 ? own : 3;
            LAS unsigned char* sel = lds + 2 * 64 * KROW;
            if (hi == 0) { const int qi = wave * 32 + l31; sel[qi] = (unsigned char)(nsel > 0 ? i0 : 255); sel[256 + qi] = (unsigned char)(nsel > 1 ? i1 : 255); sel[512 + qi] = (unsigned char)(nsel > 2 ? i2 : 255); }
            __syncthreads();
            for (int jl = wave; jl < own; jl += 8) {
                unsigned long long bm[12]; bool mt[12]; unsigned total = 0u;
#pragma unroll
                for (int sk = 0; sk < 12; ++sk) { mt[sk] = sel[(sk >> 2) * 256 + lane + 64 * (sk & 3)] == (unsigned char)jl; bm[sk] = __ballot(mt[sk]); total += (unsigned)__popcll(bm[sk]); }
                if (total == 0u) continue;
                unsigned basep = 0u; if (lane == 0) basep = atomicAdd(&CNT[bh * NBLK + jl], total);
                unsigned run = (unsigned)__builtin_amdgcn_readfirstlane((int)basep);
                const unsigned long long lt = (1ull << lane) - 1ull;
#pragma unroll
                for (int sk = 0; sk < 12; ++sk) {
                    if (mt[sk]) __hip_atomic_store(&LIST[(size_t)(bh * NBLK + jl) * S + run + (unsigned)__popcll(bm[sk] & lt)], (unsigned)((own * 256 + lane + 64 * (sk & 3)) | ((sk >> 2) << 14)), __ATOMIC_RELAXED, __HIP_MEMORY_SCOPE_AGENT);
                    run += (unsigned)__popcll(bm[sk]);
                }
            }
            __syncthreads();
        }
    }
    SEAM(3);

    for (int rep_ = 0; rep_ < (IN(4) ? 1 + ((REP_MASK >> 4) & 1) : 0); ++rep_) { DECL_PTRS;
        LAS unsigned* pf = (LAS unsigned*)(lds + CNT_OFF);
        LAS unsigned* wtot = (LAS unsigned*)(lds + RED_OFF);
        {
            const unsigned c0 = __hip_atomic_load(&CNT[2 * tid], __ATOMIC_RELAXED, __HIP_MEMORY_SCOPE_AGENT), c1 = __hip_atomic_load(&CNT[2 * tid + 1], __ATOMIC_RELAXED, __HIP_MEMORY_SCOPE_AGENT);
            const unsigned ua = (c0 + 31u) >> 5, ub = (c1 + 31u) >> 5, us = ua + ub;
            unsigned v = us;
#pragma unroll
            for (int o = 1; o < 64; o <<= 1) { const unsigned u = __shfl_up(v, o); if (lane >= o) v += u; }
            if (lane == 63) wtot[wave] = v;
            __syncthreads();
            unsigned off = 0u;
            for (int w = 0; w < wave; ++w) off += wtot[w];
            const unsigned excl = off + v - us;
            pf[2 * tid] = excl + ua; pf[2 * tid + 1] = excl + us;
            __syncthreads();
        }
        const unsigned total = pf[NB * NH * NBLK - 1];
        const unsigned glo = (unsigned)(((unsigned long long)total * (unsigned)blk) / (unsigned)G), ghi = (unsigned)(((unsigned long long)total * (unsigned)(blk + 1)) / (unsigned)G);
        int lo_ = 0, hi_ = NB * NH * NBLK - 1;
        while (lo_ < hi_) { const int mid = (lo_ + hi_) >> 1; if (pf[mid] > glo) hi_ = mid; else lo_ = mid + 1; }
        int bhj = __builtin_amdgcn_readfirstlane(lo_); unsigned g = glo; int last_hh = -1;
        while (g < ghi) {
            const unsigned base = (unsigned)__builtin_amdgcn_readfirstlane((int)(bhj ? pf[bhj - 1] : 0u)), lend = (unsigned)__builtin_amdgcn_readfirstlane((int)pf[bhj]);
            const unsigned end = lend < ghi ? lend : ghi;
            const int cnt = __builtin_amdgcn_readfirstlane((int)__hip_atomic_load(&CNT[bhj], __ATOMIC_RELAXED, __HIP_MEMORY_SCOPE_AGENT));
            const int bh = bhj >> 6, j = bhj & 63, b = bh >> 3, hh = bh & 7;
            attn_stage(lds, K + (size_t)(b * S + j * 256) * AW + hh * HD, AW, VT + (size_t)(bh * HD) * S + j * 256, S, hh != last_hh ? TB + hh * 2048 : nullptr, tid); last_hh = hh;
            __syncthreads();
            const float cbias = ((const LAS float*)(lds + TB_OFF))[2047];
            unsigned gg = g + (unsigned)wave;
            unsigned e1 = (unsigned)(S - 1), e2 = (unsigned)(S - 1); bool v1 = false, v2 = false;
            bf16x8 qn[8];
            if (gg < end) { const int ix = (int)(gg - base) * 32 + l31; v1 = ix < cnt; if (v1) e1 = __hip_atomic_load(&LIST[(size_t)bhj * S + ix], __ATOMIC_RELAXED, __HIP_MEMORY_SCOPE_AGENT); }
            if (gg + 8u < end) { const int ix = (int)(gg + 8u - base) * 32 + l31; v2 = ix < cnt; if (v2) e2 = __hip_atomic_load(&LIST[(size_t)bhj * S + ix], __ATOMIC_RELAXED, __HIP_MEMORY_SCOPE_AGENT); }
            if (gg < end) load_q(qn, Q + (size_t)(b * S + (int)(e1 & 0x3fff)) * AW + hh * HD, hi);
            for (; gg < end; gg += 8u) {
                const unsigned e = e1; const bool valid = v1;
                bf16x8 qf[8];
#pragma unroll
                for (int ks = 0; ks < 8; ++ks) qf[ks] = qn[ks];
                e1 = e2; v1 = v2; e2 = (unsigned)(S - 1); v2 = false;
                if (gg + 16u < end) { const int ix = (int)(gg + 16u - base) * 32 + l31; v2 = ix < cnt; if (v2) e2 = __hip_atomic_load(&LIST[(size_t)bhj * S + ix], __ATOMIC_RELAXED, __HIP_MEMORY_SCOPE_AGENT); }
                if (gg + 8u < end) load_q(qn, Q + (size_t)(b * S + (int)(e1 & 0x3fff)) * AW + hh * HD, hi);
                const int ql = e & 0x3fff, slot = e >> 14, qrow = b * S + ql, qrel = ql - j * 256;
                const bool fast = __all(qrel - 255 >= 1512);
                f32x16 O[4]; float m, l;
                attn_core<0>(lds, qf, qrel, SC, 4, fast, cbias, O, m, l, lane);
                store_o16(PO + ((size_t)slot * T + qrow) * AW + hh * HD, O, 1.0f / l, hi, valid);
                if (valid) {
                    if (hi == 0) __hip_atomic_store((unsigned long long*)PML + ((size_t)(qrow * NH + hh) * 3 + slot), ((unsigned long long)__float_as_uint(l) << 32) | (unsigned long long)__float_as_uint(m), __ATOMIC_RELAXED, __HIP_MEMORY_SCOPE_AGENT);
                }
            }
            __syncthreads();
            g = end; ++bhj;
            while (bhj < NB * NH * NBLK && (unsigned)__builtin_amdgcn_readfirstlane((int)pf[bhj]) == lend) ++bhj;
        }
    }
    SEAM(4);

    for (int rep_ = 0; rep_ < (IN(5) ? 1 + ((REP_MASK >> 5) & 1) : 0); ++rep_) { DECL_PTRS;
        for (int it = blk; it < NB * NH * NBLK; it += G) {
            const int bh = it >> 6, j = it & 63, b = bh >> 3, hh = bh & 7;
            attn_stage(lds, K + (size_t)(b * S + j * 256) * AW + hh * HD, AW, VT + (size_t)(bh * HD) * S + j * 256, S, TB + hh * 2048, tid);
            __syncthreads();
            const int qrel = wave * 32 + l31, qrow = b * S + j * 256 + qrel;
            f32x16 O[4]; float m, l;
            bf16x8 qf[8]; load_q(qf, Q + (size_t)qrow * AW + hh * HD, hi);
            unsigned long long pw[3];
#pragma unroll
            for (int s = 0; s < 3; ++s) { pw[s] = 0ull; if (s < (j < 3 ? j : 3)) pw[s] = __hip_atomic_load((unsigned long long*)PML + ((size_t)(qrow * NH + hh) * 3 + s), __ATOMIC_RELAXED, __HIP_MEMORY_SCOPE_AGENT); }
            attn_core<1>(lds, qf, qrel, SC, (wave >> 1) + 1, false, 0.f, O, m, l, lane);
            const int nsel = j < 3 ? j : 3;
            float M = m, ms[3], lsv[3];
#pragma unroll
            for (int s = 0; s < 3; ++s) { ms[s] = -1e30f; lsv[s] = 0.f; if (s < nsel) { ms[s] = __uint_as_float((unsigned)pw[s]); lsv[s] = __uint_as_float((unsigned)(pw[s] >> 32)); M = fmaxf(M, ms[s]); } }
            const float wown = ex2(m - M); float den = l * wown, wsl[3];
#pragma unroll
            for (int s = 0; s < 3; ++s) { wsl[s] = lsv[s] * ex2(ms[s] - M); den += wsl[s]; }
            const float inv = 1.0f / den;
            bf16* op = AC + (size_t)qrow * DM + hh * HD + 4 * hi;
#pragma unroll
            for (int hf = 0; hf < 2; ++hf) {
                v2u pp[3][2][4];
#pragma unroll
                for (int s = 0; s < 3; ++s) if (s < nsel) {
#pragma unroll
                    for (int d2 = 0; d2 < 2; ++d2)
#pragma unroll
                        for (int g4 = 0; g4 < 4; ++g4) pp[s][d2][g4] = *(const v2u*)(PO + ((size_t)s * T + qrow) * AW + hh * HD + 4 * hi + 32 * (2 * hf + d2) + 8 * g4);
                }
#pragma unroll
                for (int d2 = 0; d2 < 2; ++d2)
#pragma unroll
                    for (int g4 = 0; g4 < 4; ++g4) { const int dt = 2 * hf + d2;
                        float o0 = O[dt][4 * g4] * wown, o1 = O[dt][4 * g4 + 1] * wown, o2 = O[dt][4 * g4 + 2] * wown, o3 = O[dt][4 * g4 + 3] * wown;
#pragma unroll
                        for (int s = 0; s < 3; ++s) if (s < nsel) { const v2u p = pp[s][d2][g4];
                            o0 += wsl[s] * bf_lo(p.x); o1 += wsl[s] * bf_hi(p.x); o2 += wsl[s] * bf_lo(p.y); o3 += wsl[s] * bf_hi(p.y); }
                        v2u w; w.x = pk2(o0 * inv, o1 * inv); w.y = pk2(o2 * inv, o3 * inv); *(v2u*)(op + 32 * dt + 8 * g4) = w;
                    }
            }
            __syncthreads();
        }
    }
    SEAM(5);

#if DBG == 2
    { DECL_PTRS; for (size_t i = (size_t)blk * 512 + tid; i < (size_t)T * DM; i += (size_t)G * 512) out[i] = __uint_as_float(((unsigned)AC[i] << 16)); return; }
#endif
    for (int rep_ = 0; rep_ < (IN(6) ? 1 + ((REP_MASK >> 6) & 1) : 0); ++rep_) { DECL_PTRS;
        pg8::Gemm g{AC, WOUT_T, T, DM, DM}; pg8::StaticOrder So; So.init(T, DM, G, blk);
        pg8::EpiResBf16Ssq<0> E{x, NBUF, DM, SSQ1, nullptr};
        pg8::gemm_phase<pg8::EpiResBf16Ssq<0>, pg8::StaticOrder, true, true>(lds, g, So, E, tid);
    }
    SEAM2(6, 8);
#if DBG == 3
    return;
#endif
    for (int rep_ = 0; rep_ < (IN(8) ? 1 + ((REP_MASK >> 8) & 1) : 0); ++rep_) { DECL_PTRS;
        pg8::Gemm g{NBUF, WQ_T, T, XW, DM}; pg8::StaticOrder So; So.init(T, XW, G, blk);
        pg8::EpiBf16X<0, 1> E{QC, XW, 0, 0, -1, nullptr, 1, 1, SSQ1};
        pg8::gemm_phase<pg8::EpiBf16X<0, 1>, pg8::StaticOrder, true, true>(lds, g, So, E, tid);
    }
    for (int rep_ = 0; rep_ < (IN(9) ? 1 + ((REP_MASK >> 9) & 1) : 0); ++rep_) { DECL_PTRS;
        asm volatile("s_waitcnt vmcnt(0)" ::: "memory"); __syncthreads();
        pg8::StaticOrder So8; So8.init(T, XW, G, blk); pg8::Unit u8;
        for (int ui = 0; So8.next(ui >> 1, u8); ++ui) {
            const int tl = u8.pm, hc = 2 * u8.pn + (ui & 1), b = tl / (S / 256);
            attn_stage(lds, KC + (size_t)(b * NMEM) * XW + hc * HD, XW, VCT + (size_t)((b * XH + hc) * HD) * NMEM, NMEM, nullptr, tid);
            __syncthreads();
            const int qrow = tl * 256 + wave * 32 + l31;
            f32x16 O[4]; float m, l;
            bf16x8 qf[8]; load_q(qf, QC + (size_t)qrow * XW + hc * HD, hi);
            attn_core<2>(lds, qf, 0, SC, 4, false, 0.f, O, m, l, lane);
            store_o16(OC + (size_t)qrow * XW + hc * HD, O, 1.0f / l, hi, true);
            __syncthreads();
        }
    }
    SEAM(9);
#if DBG == 10
    return;
#endif
#if DBG == 7
    { DECL_PTRS; for (size_t i = (size_t)blk * 512 + tid; i < (size_t)T * DM; i += (size_t)G * 512) { const size_t t = i >> 11, c = i & 2047; out[i] = c < 512 ? __uint_as_float(((unsigned)QC[t * 512 + c] << 16)) : 0.f; } return; }
#endif
#if DBG == 8
    { DECL_PTRS; for (size_t i = (size_t)blk * 512 + tid; i < (size_t)T * DM; i += (size_t)G * 512) { const size_t t = i >> 11, c = i & 2047; out[i] = c < 512 ? __uint_as_float(((unsigned)OC[t * 512 + c] << 16)) : 0.f; } return; }
#endif
#if DBG == 5
    { DECL_PTRS; for (size_t i = (size_t)blk * 512 + tid; i < (size_t)T * DM; i += (size_t)G * 512) { const size_t t = i >> 11, c = i & 2047; out[i] = c < 512 ? __uint_as_float(((unsigned)OC[t * 512 + c] << 16)) : (c < 1024 ? __uint_as_float(((unsigned)QC[t * 512 + c - 512] << 16)) : 0.f); } return; }
#endif
    for (int rep_ = 0; rep_ < (IN(10) ? 1 + ((REP_MASK >> 10) & 1) : 0); ++rep_) { DECL_PTRS;
        pg8::Gemm g{OC, WO_T, T, DM, XW}; pg8::StaticOrder So; So.init(T, DM, G, blk);
        pg8::EpiResBf16Ssq<1> E{NBUF, NBUF, DM, SSQ2, nullptr};
        pg8::gemm_phase<pg8::EpiResBf16Ssq<1>, pg8::StaticOrder, true, true>(lds, g, So, E, tid);
    }
    SEAM2(10, 12);
#if DBG == 4
    return;
#endif
    for (int rep_ = 0; rep_ < (IN(12) ? 1 + ((REP_MASK >> 12) & 1) : 0); ++rep_) { DECL_PTRS;
        pg8::Gemm g{NBUF, W1_T, T, FF, DM}; pg8::StaticOrder So; So.init(T, FF, G, blk);
        pg8::EpiBf16X<2, 0> E{FB, FF, 0, 0, -1, nullptr, 1, 1, nullptr};
        pg8::gemm_phase<pg8::EpiBf16X<2, 0>, pg8::StaticOrder, true, true>(lds, g, So, E, tid);
    }
    SEAM(12);
    for (int rep_ = 0; rep_ < (IN(13) ? 1 + ((REP_MASK >> 13) & 1) : 0); ++rep_) { DECL_PTRS;
        pg8::Gemm g{FB, W2_T, T, DM, FF}; pg8::StaticOrder So; So.init(T, DM, G, blk);
        pg8::EpiResBf16Ssq<1, 1> E{NBUF, NBUF, DM, SSQ3, SSQ2};
        pg8::gemm_phase<pg8::EpiResBf16Ssq<1, 1>, pg8::StaticOrder, true, true>(lds, g, So, E, tid);
    }
    SEAM(13);
    for (int rep_ = 0; rep_ < (IN(14) ? 1 : 0); ++rep_) { DECL_PTRS;
        const int gw = blk * 8 + wave, NGW = G * 8;
        f32x4 gv[8];
#pragma unroll
        for (int jj = 0; jj < 8; ++jj) gv[jj] = ((const f32x4*)g_final)[lane + 64 * jj];
        for (int mrow = gw; mrow < T; mrow += NGW) {
            const float rstd = 1.0f / sqrtf(SSQ3[mrow] * (1.0f / DM) + EPS);
            const v2u* hr = (const v2u*)(NBUF + (size_t)mrow * DM) + lane; f32x4* o = (f32x4*)(out + (size_t)mrow * DM) + lane;
            v2u hv[8];
#pragma unroll
            for (int jj = 0; jj < 8; ++jj) hv[jj] = hr[64 * jj];
#pragma unroll
            for (int jj = 0; jj < 8; ++jj) o[64 * jj] = (f32x4){bf_lo(hv[jj].x) * rstd * gv[jj].x, bf_hi(hv[jj].x) * rstd * gv[jj].y, bf_lo(hv[jj].y) * rstd * gv[jj].z, bf_hi(hv[jj].y) * rstd * gv[jj].w};
        }
    }
#undef IN
#undef SEAM
}

extern "C" void kernel_launch(void* const* d_in, const int* in_sizes, int n_in, void* d_out, int out_size, void* d_ws, size_t ws_size, hipStream_t stream) {
    static int grid = 0;
    if (grid == 0) {
        if (n_in != 20 || out_size != T * DM || ws_size < WS_END) { fprintf(stderr, "kernel_launch: unexpected sizes n_in %d out %d ws %zu\n", n_in, out_size, ws_size); grid = -1; return; }
        int dev = 0, cus = 0, per_cu = 0;
        (void)hipGetDevice(&dev); (void)hipDeviceGetAttribute(&cus, hipDeviceAttributeMultiprocessorCount, dev);
        (void)hipFuncSetAttribute((const void*)fwd, hipFuncAttributeMaxDynamicSharedMemorySize, LDS_BYTES);
        (void)hipOccupancyMaxActiveBlocksPerMultiprocessor(&per_cu, (const void*)fwd, 512, LDS_BYTES);
        if (per_cu < 1) { fprintf(stderr, "kernel_launch: occupancy query says %d blocks per CU\n", per_cu); per_cu = 1; }
        grid = cus;
        (void)hipGetLastError();
    }
    if (grid < 0) return;
    if (hipMemsetAsync((char*)d_ws + WS_CTL, 0, 1048576, stream) != hipSuccess) { fprintf(stderr, "kernel_launch: memset failed\n"); return; }
    Args a{};
    for (int i = 0; i < 20; ++i) a.in[i] = (const float*)d_in[i];
    a.out = (float*)d_out; a.ws = (unsigned char*)d_ws;
#if MK_PER_PHASE
    for (int p = 0; p < NPHASE; ++p) { if (p == 7 || p == 11) continue; a.ph_lo = p; a.ph_hi = p + 1; hipLaunchKernelGGL(fwd, dim3(grid), dim3(512), LDS_BYTES, stream, a); }
#else
    a.ph_lo = 0; a.ph_hi = NPHASE;
    void* args[] = {&a};
    hipError_t e = hipLaunchCooperativeKernel((const void*)fwd, dim3(grid), dim3(512), args, LDS_BYTES, stream);
    if (e != hipSuccess) fprintf(stderr, "kernel_launch: cooperative launch failed: %s (grid %d)\n", hipGetErrorString(e), grid);
#endif
}
```

```cpp
#include <hip/hip_runtime.h>
#include <cstdio>
#include <cstdint>
namespace pg8 {
#define PG8_LAS __attribute__((address_space(3)))
typedef unsigned short bf16_t;
typedef short bf16x8 __attribute__((ext_vector_type(8)));
typedef float f32x4 __attribute__((ext_vector_type(4)));
typedef unsigned u32x4 __attribute__((ext_vector_type(4)));
constexpr int BM = 256, BK = 64, HALF = 128, HTB = HALF * BK * 2  , STAGE_BYTES = 8 * HTB, NXCD = 8, WGM = 8;

__host__ __device__ __forceinline__ int lds_byte(int r, int c) { const int st = (r >> 4) * 2 + (c >> 5), rr = r & 15, cc = c & 31, ob = rr * 64 + cc * 2; return st * 1024 + (ob ^ (((ob >> 9) & 1) << 5)); }
__host__ __device__ __forceinline__ void stage_rc(int b, int& R, int& C) { const int st = b / 1024, sb = b % 1024, swz = sb ^ (((sb >> 9) & 1) << 5); R = (st >> 1) * 16 + swz / 64; C = (st & 1) * 32 + (swz % 64) / 2; }
__host__ __device__ __forceinline__ int perm32(int rho) { const int n = rho >> 4, i = rho & 15; return 8 * (i >> 2) + 4 * n + (i & 3); }

struct Unit { int pm, pn; };
struct Gemm { const bf16_t* A; const bf16_t* Bt; int M, N, K; };

struct StaticOrder {
    int nM, nN, nwg, G, c;
    __host__ __device__ void init(int M, int N, int G_, int c_) { nM = M / BM; nN = N / BM; nwg = nM * nN; G = G_; c = c_; }
    __host__ __device__ bool next(int i, Unit& u) const {
        const long L = (long)i * G + c; if (L >= nwg) return false;
        int wgid = (int)L; { const int q = nwg / NXCD, r = nwg % NXCD, xcd = wgid % NXCD, off = wgid / NXCD; wgid = (xcd < r ? xcd * (q + 1) : r * (q + 1) + (xcd - r) * q) + off; }
        const int nig = WGM * nN, gid = wgid / nig, fm = gid * WGM, gsz = (nM - fm) < WGM ? (nM - fm) : WGM;
        u.pm = fm + ((wgid % nig) % gsz); u.pn = (wgid % nig) / gsz; return true;
    }
    __device__ __forceinline__ void a_ready(const Unit&) const {}
    __device__ __forceinline__ void done(const Unit&) const {}
};

__device__ __forceinline__ unsigned cvt_pk_bf16(float lo, float hi) { unsigned r; asm volatile("v_cvt_pk_bf16_f32 %0, %1, %2" : "=v"(r) : "v"(lo), "v"(hi)); return r; }
typedef float f32x2 __attribute__((ext_vector_type(2)));
__device__ __forceinline__ f32x2 gelu_pk(f32x2 v) {
    const f32x2 av = __builtin_elementwise_abs(v), d = av * 0.2316418882f + 1.0f;
    f32x2 t; t.x = __builtin_amdgcn_rcpf(d.x); t.y = __builtin_amdgcn_rcpf(d.y);
    f32x2 q = t * 0.5307027145f + (-0.7265760135f); q = q * t + 0.7107068705f; q = q * t + (-0.142248368f); q = q * t + 0.127414796f; q = q * t;
    const f32x2 s = (v * v) * (-0.72134752044f);
    f32x2 e; e.x = __builtin_amdgcn_exp2f(s.x); e.y = __builtin_amdgcn_exp2f(s.y);
    const f32x2 m = v * (q * e), r = v - m;
    f32x2 o; o.x = v.x < 0.f ? m.x : r.x; o.y = v.y < 0.f ? m.y : r.y; return o;
}


__device__ __forceinline__ unsigned short bf16_1(float v) { return (unsigned short)(cvt_pk_bf16(v, v) & 0xffffu); }
template <int ACT  , int RS = 0  > struct EpiBf16X {
    static constexpr bool PERM = true, AFTER_DRAIN = false;
    bf16_t* O; int ldc; int split_cols; size_t split_stride; int tr_tile; bf16_t* OT; int seqlen; int nheads; const float* ssq;
    __device__ __forceinline__ void operator()(const f32x4 (&acc)[2][2][4][2], const Unit& u, int wr, int wc, int fr, int fq) const {
        const int row0 = u.pm * BM + wr * 64 + fr; int colt = u.pn * BM; bf16_t* base = O; int t = 0;
        if (split_cols) { t = colt / split_cols; base += (size_t)t * split_stride; colt -= t * split_cols; }
        const int col0 = colt + wc * 32 + 8 * fq;
        if (RS == 0 && t == tr_tile) {
#pragma unroll
            for (int ai = 0; ai < 2; ++ai)
#pragma unroll
                for (int m = 0; m < 4; ++m) { const int row = row0 + ai * HALF + m * 16; const int b = row / seqlen, s = row - b * seqlen;
#pragma unroll
                    for (int bj = 0; bj < 2; ++bj)
#pragma unroll
                        for (int n = 0; n < 2; ++n)
#pragma unroll
                            for (int j = 0; j < 4; ++j) { const int col = col0 + bj * HALF + 4 * n + j; const int hh = col >> 7, d = col & 127;
                                OT[((size_t)(b * nheads + hh) * 128 + d) * (size_t)seqlen + s] = bf16_1(acc[ai][bj][m][n][j]); } }
        } else {
#pragma unroll
            for (int ai = 0; ai < 2; ++ai)
#pragma unroll
                for (int m = 0; m < 4; ++m) { bf16_t* rowp = base + (size_t)(row0 + ai * HALF + m * 16) * ldc + col0;
                    float rsc = 1.f;
                    if (RS) { const float r = 1.0f / sqrtf(ssq[row0 + ai * HALF + m * 16] * (1.0f / 2048.0f) + 1e-6f); rsc = (ACT == 2) ? r * r : r; }
#pragma unroll
                    for (int bj = 0; bj < 2; ++bj) { f32x4 v0 = acc[ai][bj][m][0], v1 = acc[ai][bj][m][1];
                        if (RS && ACT != 2) { v0 = v0 * rsc; v1 = v1 * rsc; }
                        if (ACT == 2) {
#pragma unroll
                            for (int j = 0; j < 4; ++j) { float a = v0[j] > 0.f ? v0[j] : 0.f; v0[j] = a * a * rsc; float b = v1[j] > 0.f ? v1[j] : 0.f; v1[j] = b * b * rsc; } }
                        u32x4 w; w.x = cvt_pk_bf16(v0[0], v0[1]); w.y = cvt_pk_bf16(v0[2], v0[3]); w.z = cvt_pk_bf16(v1[0], v1[1]); w.w = cvt_pk_bf16(v1[2], v1[3]);
                        *(u32x4*)(rowp + bj * HALF) = w; } }
        }
    }
};
struct EpiResNorm {
    static constexpr bool PERM = false, AFTER_DRAIN = false;
    const float* base; float* out; int ldc; const float* gain; bf16_t* HG; float* ssq;
    __device__ __forceinline__ void operator()(const f32x4 (&acc)[2][2][4][2], const Unit& u, int wr, int wc, int fr, int fq) const {
        const int row0 = u.pm * BM + wr * 64 + fr, col0 = u.pn * BM + wc * 32 + 4 * fq;
        f32x4 gv[2][2];
#pragma unroll
        for (int bj = 0; bj < 2; ++bj)
#pragma unroll
            for (int n = 0; n < 2; ++n) gv[bj][n] = *(const f32x4*)(gain + col0 + bj * HALF + n * 16);
#pragma unroll
        for (int ai = 0; ai < 2; ++ai)
#pragma unroll
            for (int m = 0; m < 4; ++m) { const int row = row0 + ai * HALF + m * 16; const size_t off = (size_t)row * ldc + col0; float sq = 0.f;
#pragma unroll
                for (int bj = 0; bj < 2; ++bj)
#pragma unroll
                    for (int n = 0; n < 2; ++n) { const f32x4 h = *(const f32x4*)(base + off + bj * HALF + n * 16) + acc[ai][bj][m][n]; *(f32x4*)(out + off + bj * HALF + n * 16) = h;
                        sq += (h[0] * h[0] + h[1] * h[1]) + (h[2] * h[2] + h[3] * h[3]);
                        const f32x4 hg = h * gv[bj][n]; unsigned w0 = cvt_pk_bf16(hg[0], hg[1]), w1 = cvt_pk_bf16(hg[2], hg[3]);
                        typedef unsigned u32x2v __attribute__((ext_vector_type(2))); u32x2v w; w.x = w0; w.y = w1; *(u32x2v*)(HG + off + bj * HALF + n * 16) = w; }
                sq += __shfl_xor(sq, 16); sq += __shfl_xor(sq, 32);
                if (fq == 0) unsafeAtomicAdd(ssq + row, sq); }
    }
};
template <int B16  , int RS2 = 0  > struct EpiResBf16Ssq {
    static constexpr bool PERM = true, AFTER_DRAIN = false;
    const void* base; bf16_t* HB; int ldc; float* ssq; const float* ssq_in;
    __device__ __forceinline__ void operator()(const f32x4 (&acc)[2][2][4][2], const Unit& u, int wr, int wc, int fr, int fq) const {
        const int row0 = u.pm * BM + wr * 64 + fr, col0 = u.pn * BM + wc * 32 + 8 * fq;
        float rq[2][4], sqv[2][4];
#pragma unroll
        for (int ai = 0; ai < 2; ++ai)
#pragma unroll
            for (int m = 0; m < 4; ++m) rq[ai][m] = RS2 ? ssq_in[row0 + ai * HALF + m * 16] : 0.f;
#pragma unroll
        for (int ai = 0; ai < 2; ++ai)
#pragma unroll
            for (int m = 0; m < 4; ++m) { const int row = row0 + ai * HALF + m * 16; const size_t off = (size_t)row * ldc + col0; float sq = 0.f;
                float rs2 = 1.f; if (RS2) rs2 = 1.0f / (rq[ai][m] * (1.0f / 2048.0f) + 1e-6f);
#pragma unroll
                for (int bj = 0; bj < 2; ++bj) { f32x4 b0, b1;
                    if (B16) { const u32x4 bw = *(const u32x4*)((const bf16_t*)base + off + bj * HALF);
                        b0 = (f32x4){__uint_as_float(bw.x << 16), __uint_as_float(bw.x & 0xffff0000u), __uint_as_float(bw.y << 16), __uint_as_float(bw.y & 0xffff0000u)};
                        b1 = (f32x4){__uint_as_float(bw.z << 16), __uint_as_float(bw.z & 0xffff0000u), __uint_as_float(bw.w << 16), __uint_as_float(bw.w & 0xffff0000u)}; }
                    else { b0 = *(const f32x4*)((const float*)base + off + bj * HALF); b1 = *(const f32x4*)((const float*)base + off + bj * HALF + 4); }
                    const f32x4 h0 = RS2 ? b0 + acc[ai][bj][m][0] * rs2 : b0 + acc[ai][bj][m][0], h1 = RS2 ? b1 + acc[ai][bj][m][1] * rs2 : b1 + acc[ai][bj][m][1];
                    sq += ((h0[0] * h0[0] + h0[1] * h0[1]) + (h0[2] * h0[2] + h0[3] * h0[3])) + ((h1[0] * h1[0] + h1[1] * h1[1]) + (h1[2] * h1[2] + h1[3] * h1[3]));
                    u32x4 w; w.x = cvt_pk_bf16(h0[0], h0[1]); w.y = cvt_pk_bf16(h0[2], h0[3]); w.z = cvt_pk_bf16(h1[0], h1[1]); w.w = cvt_pk_bf16(h1[2], h1[3]);
                    *(u32x4*)(HB + off + bj * HALF) = w; }
                sqv[ai][m] = sq; }
#pragma unroll
        for (int ai = 0; ai < 2; ++ai)
#pragma unroll
            for (int m = 0; m < 4; ++m) { float sq = sqv[ai][m]; sq += __shfl_xor(sq, 16); sq += __shfl_xor(sq, 32); if (fq == 0) unsafeAtomicAdd(ssq + row0 + ai * HALF + m * 16, sq); }
    }
};
struct EpiResF32 {
    static constexpr bool PERM = false, AFTER_DRAIN = false;
    const float* base; float* out; int ldc;
    __device__ __forceinline__ void operator()(const f32x4 (&acc)[2][2][4][2], const Unit& u, int wr, int wc, int fr, int fq) const {
        const int row0 = u.pm * BM + wr * 64 + fr, col0 = u.pn * BM + wc * 32 + 4 * fq;
#pragma unroll
        for (int ai = 0; ai < 2; ++ai)
#pragma unroll
            for (int m = 0; m < 4; ++m) { const size_t off = (size_t)(row0 + ai * HALF + m * 16) * ldc + col0;
#pragma unroll
                for (int bj = 0; bj < 2; ++bj)
#pragma unroll
                    for (int n = 0; n < 2; ++n) { const f32x4 bs = *(const f32x4*)(base + off + bj * HALF + n * 16); *(f32x4*)(out + off + bj * HALF + n * 16) = bs + acc[ai][bj][m][n]; } }
    }
};

template <class Epi, class Sched, bool ALIGN_EPI = false, bool SP2 = false>
__device__ __forceinline__ void gemm_phase(PG8_LAS unsigned char* lds, const Gemm g, const Sched& S, const Epi& E, const int tid) {
    const int wid = __builtin_amdgcn_readfirstlane(tid >> 6), lane = tid & 63, wr = wid >> 2, wc = wid & 3, fr = lane & 15, fq = lane >> 4;
    const int K = g.K, nt = K / BK;
    unsigned voffA[2], voffB[2];
#pragma unroll
    for (int i = 0; i < 2; ++i) { int R, C; stage_rc(tid * 16 + i * 8192, R, C); const int Rb = Epi::PERM ? ((R & ~31) + perm32(R & 31)) : R;
        voffA[i] = (unsigned)(R * K + C) * 2u; voffB[i] = (unsigned)(Rb * K + C) * 2u; }
    const size_t kstep = (size_t)(BK * 2);
    const size_t hstep = (size_t)HALF * K * 2;
    const size_t tstep = 2 * hstep;
    const unsigned ldsw = (unsigned)wid * 1024u;
    const int aoff = lds_byte(wr * 64 + fr, fq * 8), boff = lds_byte(wc * 32 + fr, fq * 8);
#define PG8_SA(b, h) (((b) * 2 + (h)) * HTB)
#define PG8_SB(b, h) ((4 + (b) * 2 + (h)) * HTB)
#define PG8_STAGE(bufoff, gbase, voff) do { _Pragma("unroll") for (int _i = 0; _i < 2; ++_i) \
        __builtin_amdgcn_global_load_lds((const unsigned*)((const char*)(gbase) + (voff)[_i]), (PG8_LAS unsigned*)(lds + (bufoff) + ldsw + _i * 8192), 16, 0, 0); } while (0)
#define PG8_LDA(dst, b, h) do { _Pragma("unroll") for (int m = 0; m < 4; ++m) _Pragma("unroll") for (int k = 0; k < 2; ++k) dst[m][k] = *(const PG8_LAS bf16x8*)(lds + PG8_SA(b, h) + aoff + m * 2048 + k * 1024); } while (0)
#define PG8_LDB(dst, b, h) do { _Pragma("unroll") for (int n = 0; n < 2; ++n) _Pragma("unroll") for (int k = 0; k < 2; ++k) dst[n][k] = *(const PG8_LAS bf16x8*)(lds + PG8_SB(b, h) + boff + n * 2048 + k * 1024); } while (0)
#define PG8_MMA(ai, bj, At, Bt) do { __builtin_amdgcn_s_setprio(1); _Pragma("unroll") for (int m = 0; m < 4; ++m) _Pragma("unroll") for (int n = 0; n < 2; ++n) _Pragma("unroll") for (int k = 0; k < 2; ++k) \
        acc[ai][bj][m][n] = __builtin_amdgcn_mfma_f32_16x16x32_bf16(Bt[n][k], At[m][k], acc[ai][bj][m][n], 0, 0, 0); __builtin_amdgcn_s_setprio(0); } while (0)
#define PG8_WAIT_V(n) asm volatile("s_waitcnt vmcnt(" #n ")" ::: "memory")
#define PG8_WAIT_L(n) asm volatile("s_waitcnt lgkmcnt(" #n ")" ::: "memory")
#define PG8_BAR __builtin_amdgcn_s_barrier()
#define PG8_SCHED __builtin_amdgcn_sched_barrier(0)
    Unit cur, nxt; int ui = 0;
    if (!S.next(0, cur)) return;
    f32x4 acc[2][2][4][2];
#pragma unroll
    for (int a = 0; a < 2; ++a)
#pragma unroll
        for (int b = 0; b < 2; ++b)
#pragma unroll
            for (int m = 0; m < 4; ++m)
#pragma unroll
                for (int n = 0; n < 2; ++n) acc[a][b][m][n] = (f32x4){0.f, 0.f, 0.f, 0.f};
    bf16x8 At[4][2], B0[2][2], B1[2][2];
    const char* cA = (const char*)g.A + (size_t)cur.pm * tstep; const char* cB = (const char*)g.Bt + (size_t)cur.pn * tstep;
    S.a_ready(cur);
    if constexpr (SP2) {
        PG8_STAGE(PG8_SB(0, 0), cB, voffB); PG8_STAGE(PG8_SB(0, 1), cB + hstep, voffB); PG8_STAGE(PG8_SA(0, 0), cA, voffA); PG8_STAGE(PG8_SA(0, 1), cA + hstep, voffA);
        if (wr == 1) PG8_BAR;
        PG8_WAIT_V(2); PG8_BAR;
        PG8_STAGE(PG8_SB(1, 0), cB + kstep, voffB); PG8_STAGE(PG8_SA(1, 0), cA + kstep, voffA); PG8_STAGE(PG8_SB(1, 1), cB + hstep + kstep, voffB);
        PG8_WAIT_V(6); PG8_BAR;
    } else {
        PG8_STAGE(PG8_SB(0, 0), cB, voffB); PG8_STAGE(PG8_SA(0, 0), cA, voffA); PG8_STAGE(PG8_SB(0, 1), cB + hstep, voffB); PG8_STAGE(PG8_SA(0, 1), cA + hstep, voffA);
        if (wr == 1) PG8_BAR;
        PG8_WAIT_V(4); PG8_BAR;
        PG8_STAGE(PG8_SB(1, 0), cB + kstep, voffB); PG8_STAGE(PG8_SA(1, 0), cA + kstep, voffA); PG8_STAGE(PG8_SB(1, 1), cB + hstep + kstep, voffB);
        PG8_WAIT_V(6); PG8_BAR;
    }
    for (;;) {
        const bool has_next = S.next(ui + 1, nxt);
        const char* nA = has_next ? (const char*)g.A + (size_t)nxt.pm * tstep : cA; const char* nB = has_next ? (const char*)g.Bt + (size_t)nxt.pn * tstep : cB;
        for (int t = 0; t < nt; t += 2) {
            const bool last = (t == nt - 2);
            const char* a1 = cA + (size_t)(t + 1) * kstep;
            const char* a2 = last ? nA : cA + (size_t)(t + 2) * kstep; const char* b2 = last ? nB : cB + (size_t)(t + 2) * kstep;
            const char* a3 = a2 + kstep; const char* b3 = b2 + kstep;
            if (last && has_next) S.a_ready(nxt);
            if constexpr (SP2) {
            PG8_LDB(B0, 0, 0); PG8_LDB(B1, 0, 1); PG8_SCHED; PG8_LDA(At, 0, 0); PG8_STAGE(PG8_SA(1, 1), a1 + hstep, voffA);
            PG8_WAIT_V(8); PG8_WAIT_L(0); PG8_BAR; PG8_MMA(0, 0, At, B0); PG8_MMA(0, 1, At, B1); PG8_BAR; PG8_SCHED;
            PG8_LDA(At, 0, 1); PG8_STAGE(PG8_SB(0, 0), b2, voffB); PG8_STAGE(PG8_SB(0, 1), b2 + hstep, voffB); PG8_STAGE(PG8_SA(0, 0), a2, voffA);
            PG8_WAIT_V(8); PG8_WAIT_L(0); PG8_BAR; PG8_MMA(1, 0, At, B0); PG8_MMA(1, 1, At, B1); PG8_BAR; PG8_SCHED;
            PG8_LDB(B0, 1, 0); PG8_LDB(B1, 1, 1); PG8_SCHED; PG8_LDA(At, 1, 0); PG8_STAGE(PG8_SA(0, 1), a2 + hstep, voffA);
            PG8_WAIT_V(8); PG8_WAIT_L(0); PG8_BAR; PG8_MMA(0, 0, At, B0); PG8_MMA(0, 1, At, B1); PG8_BAR; PG8_SCHED;
            PG8_LDA(At, 1, 1); PG8_STAGE(PG8_SB(1, 0), b3, voffB); PG8_STAGE(PG8_SB(1, 1), b3 + hstep, voffB); PG8_STAGE(PG8_SA(1, 0), a3, voffA);
            PG8_WAIT_V(8); PG8_WAIT_L(0); PG8_BAR; PG8_MMA(1, 0, At, B0); PG8_MMA(1, 1, At, B1); PG8_BAR; PG8_SCHED;
            } else {
            PG8_LDB(B0, 0, 0); PG8_SCHED; PG8_LDA(At, 0, 0); PG8_STAGE(PG8_SA(1, 1), a1 + hstep, voffA);
            PG8_WAIT_L(8); PG8_BAR; PG8_WAIT_L(0); PG8_MMA(0, 0, At, B0); PG8_BAR; PG8_SCHED;
            PG8_LDB(B1, 0, 1); PG8_STAGE(PG8_SB(0, 0), b2, voffB);
            PG8_BAR; PG8_WAIT_L(0); PG8_MMA(0, 1, At, B1); PG8_BAR;
            PG8_LDA(At, 0, 1); PG8_STAGE(PG8_SA(0, 0), a2, voffA);
            PG8_BAR; PG8_WAIT_L(0); PG8_MMA(1, 0, At, B0); PG8_BAR; PG8_SCHED;
            PG8_STAGE(PG8_SB(0, 1), b2 + hstep, voffB);
            PG8_WAIT_V(6); PG8_BAR; PG8_MMA(1, 1, At, B1); PG8_BAR;
            PG8_LDB(B0, 1, 0); PG8_SCHED; PG8_LDA(At, 1, 0); PG8_STAGE(PG8_SA(0, 1), a2 + hstep, voffA);
            PG8_WAIT_L(8); PG8_BAR; PG8_WAIT_L(0); PG8_MMA(0, 0, At, B0); PG8_BAR; PG8_SCHED;
            PG8_LDB(B1, 1, 1); PG8_STAGE(PG8_SB(1, 0), b3, voffB);
            PG8_BAR; PG8_WAIT_L(0); PG8_MMA(0, 1, At, B1); PG8_BAR;
            PG8_LDA(At, 1, 1); PG8_STAGE(PG8_SA(1, 0), a3, voffA);
            PG8_BAR; PG8_WAIT_L(0); PG8_MMA(1, 0, At, B0); PG8_BAR; PG8_SCHED;
            PG8_STAGE(PG8_SB(1, 1), b3 + hstep, voffB);
            PG8_WAIT_V(6); PG8_BAR; PG8_MMA(1, 1, At, B1); PG8_BAR;
            }
        }
        if constexpr (ALIGN_EPI) { if (wr == 0) PG8_BAR; }
        if constexpr (!Epi::AFTER_DRAIN) { E(acc, cur, wr, wc, fr, fq); S.done(cur); }
        if (!has_next) break;
#pragma unroll
        for (int a = 0; a < 2; ++a)
#pragma unroll
            for (int b = 0; b < 2; ++b)
#pragma unroll
                for (int m = 0; m < 4; ++m)
#pragma unroll
                    for (int n = 0; n < 2; ++n) acc[a][b][m][n] = (f32x4){0.f, 0.f, 0.f, 0.f};
        cur = nxt; cA = nA; cB = nB; ++ui;
        if constexpr (ALIGN_EPI) { if (wr == 1) PG8_BAR; }
    }
    PG8_WAIT_V(0);
    if constexpr (!ALIGN_EPI) { if (wr == 0) PG8_BAR; }
    PG8_BAR;
    if constexpr (Epi::AFTER_DRAIN) { E.fused(acc, cur, wr, wc, fr, fq, lds, wid, lane); S.done(cur); }
#undef PG8_SA
#undef PG8_SB
#undef PG8_STAGE
#undef PG8_LDA
#undef PG8_LDB
#undef PG8_MMA
#undef PG8_WAIT_V
#undef PG8_WAIT_L
#undef PG8_BAR
#undef PG8_SCHED
}
}

#include <hip/hip_cooperative_groups.h>
namespace cg = cooperative_groups;
#define LAS __attribute__((address_space(3)))
typedef unsigned short bf16;
typedef unsigned v4u __attribute__((ext_vector_type(4)));
typedef unsigned v2u __attribute__((ext_vector_type(2)));
typedef float f32x4 __attribute__((ext_vector_type(4)));
typedef float f32x2 __attribute__((ext_vector_type(2)));
typedef float f32x16 __attribute__((ext_vector_type(16)));
typedef short bf16x8 __attribute__((ext_vector_type(8)));

#ifndef MK_PER_PHASE
#define MK_PER_PHASE 0
#endif
constexpr int NB = 2, S = 16384, DM = 2048, T = NB * S, NH = 8, HD = 128, AW = 1024, CC = 1024, INW = 5120, FF = 8192, NMEM = 256, XH = 4, XW = 512, CONVK = 31, NBLK = 64;
constexpr float EPS = 1e-6f, LOG2E = 1.4426950408889634f;
constexpr int NPHASE = 15;
constexpr size_t MiB = 1u << 20;
constexpr size_t WS_CTL = 0; constexpr int CW_BAR = 4096;
constexpr size_t WS_WIN = 2 * MiB, WS_WOUT = 22 * MiB, WS_WQ = 30 * MiB, WS_WKV = 32 * MiB, WS_WO = 36 * MiB, WS_W1 = 38 * MiB, WS_W2 = 70 * MiB;
constexpr size_t WS_KBAR = 102 * MiB, WS_TB = 103 * MiB, WS_MN = 104 * MiB, WS_KC = 106 * MiB, WS_VCT = 107 * MiB;
constexpr size_t WS_NB = 112 * MiB;
constexpr size_t WS_Q = 240 * MiB, WS_K = 304 * MiB, WS_VT = 368 * MiB, WS_UV = 432 * MiB, WS_UG = 496 * MiB;
constexpr size_t WS_AC = 560 * MiB;
constexpr size_t WS_F = 240 * MiB;
constexpr size_t WS_QC = 240 * MiB, WS_OC = 272 * MiB;
constexpr size_t WS_PO = 752 * MiB;
constexpr size_t WS_PML = 944 * MiB;
constexpr size_t WS_LIST = 952 * MiB;
constexpr size_t WS_END = 1016 * MiB;
constexpr int LDS_BYTES = 152064;
constexpr int KS_OFF = 0, KROW = 272, VS_OFF = 256 * 272, VROW = 528  , TB_OFF = VS_OFF + 128 * 528, RED_OFF = TB_OFF + 8192, CNT_OFF = RED_OFF + 2048, PT_OFF = CNT_OFF + 4096, ST_OFF = PT_OFF + 192;
static_assert(PT_OFF + 256 <= LDS_BYTES, "LDS map");

__device__ __forceinline__ float bf_lo(unsigned w) { return __uint_as_float(w << 16); }
__device__ __forceinline__ float bf_hi(unsigned w) { return __uint_as_float(w & 0xffff0000u); }
typedef __bf16 bf16x2_t __attribute__((ext_vector_type(2)));
__device__ __forceinline__ unsigned pk2(float lo, float hi) { return pg8::cvt_pk_bf16(lo, hi); }
__device__ __forceinline__ unsigned pk2s(float lo, float hi) { f32x2 v = {lo, hi}; bf16x2_t b = __builtin_convertvector(v, bf16x2_t); return __builtin_bit_cast(unsigned, b); }
__device__ __forceinline__ float ex2(float x) { return __builtin_amdgcn_exp2f(x); }
__device__ __forceinline__ float wave_sum(float v) {
#pragma unroll
    for (int o = 1; o < 64; o <<= 1) v += __shfl_xor(v, o);
    return v;
}
__device__ __forceinline__ float sigmoidf_(float x) { return 1.0f / (1.0f + __expf(-x)); }

__device__ __forceinline__ void p0_transpose_item(const float* W, int K, int N, bf16* WT, int row_off, LAS float* scr, int item, int lane, const float* gk = nullptr) {
    const int nblk = N / 32, kb = item / nblk, nb = item % nblk, k0 = 64 * kb, n0 = 32 * nb;
    float wv[32];
#pragma unroll
    for (int i = 0; i < 32; ++i) { const int kk = 2 * i + (lane >> 5); wv[i] = W[(size_t)(k0 + kk) * N + n0 + (lane & 31)]; }
    if (gk) {
#pragma unroll
        for (int i = 0; i < 32; ++i) wv[i] *= gk[k0 + 2 * i + (lane >> 5)];
    }
#pragma unroll
    for (int i = 0; i < 32; ++i) { const int kk = 2 * i + (lane >> 5); scr[kk * 33 + (lane & 31)] = wv[i]; }
    asm volatile("s_waitcnt lgkmcnt(0)" ::: "memory");
    const int c = lane & 7;
#pragma unroll
    for (int j = 0; j < 4; ++j) { const int n = (lane >> 3) + 8 * j; const LAS float* s = scr + (8 * c) * 33 + n;
        v4u o; o.x = pk2(s[0 * 33], s[1 * 33]); o.y = pk2(s[2 * 33], s[3 * 33]); o.z = pk2(s[4 * 33], s[5 * 33]); o.w = pk2(s[6 * 33], s[7 * 33]);
        *(v4u*)(WT + (size_t)(row_off + n0 + n) * K + k0 + 8 * c) = o; }
    asm volatile("s_waitcnt lgkmcnt(0)" ::: "memory");
}
__device__ __forceinline__ void rms_row_bf16(const float* xrow, const float* g, bf16* orow, int lane) {
    const f32x4* xr = (const f32x4*)xrow + lane; f32x4 v[8]; float s = 0.f;
#pragma unroll
    for (int j = 0; j < 8; ++j) { v[j] = xr[64 * j]; s += (v[j].x * v[j].x + v[j].y * v[j].y) + (v[j].z * v[j].z + v[j].w * v[j].w); }
    const float rstd = 1.0f / sqrtf(wave_sum(s) * (1.0f / DM) + EPS);
    const f32x4* gr = (const f32x4*)g + lane; v2u* o8 = (v2u*)orow + lane;
#pragma unroll
    for (int j = 0; j < 8; ++j) { const f32x4 gv = gr[64 * j]; v2u w; w.x = pk2(v[j].x * rstd * gv.x, v[j].y * rstd * gv.y); w.y = pk2(v[j].z * rstd * gv.z, v[j].w * rstd * gv.w); o8[64 * j] = w; }
}
__device__ __forceinline__ void rms_row_f32(const float* xrow, const float* g, float* orow, int lane) {
    const f32x4* xr = (const f32x4*)xrow + lane; f32x4 v[8]; float s = 0.f;
#pragma unroll
    for (int j = 0; j < 8; ++j) { v[j] = xr[64 * j]; s += (v[j].x * v[j].x + v[j].y * v[j].y) + (v[j].z * v[j].z + v[j].w * v[j].w); }
    const float rstd = 1.0f / sqrtf(wave_sum(s) * (1.0f / DM) + EPS);
    const f32x4* gr = (const f32x4*)g + lane; f32x4* o = (f32x4*)orow + lane;
#pragma unroll
    for (int j = 0; j < 8; ++j) { const f32x4 gv = gr[64 * j]; o[64 * j] = v[j] * rstd * gv; }
}

__device__ __forceinline__ int crow(int r, int hi) { return (r & 3) + 8 * (r >> 2) + 4 * hi; }
__device__ __forceinline__ void attn_stage(LAS unsigned char* lds, const bf16* Kg, unsigned kstride, const bf16* VTg, unsigned vstride, const float* tbg, int tid) {
    const unsigned ko = (unsigned)(tid >> 4) * (kstride * 2u) + (unsigned)(tid & 15) * 16u, vo = (unsigned)(tid >> 5) * (vstride * 2u) + (unsigned)(tid & 31) * 16u;
    const unsigned kl = (unsigned)(tid >> 4) * KROW + (unsigned)(tid & 15) * 16u, vl = (unsigned)(tid >> 5) * VROW + (unsigned)(tid & 31) * 16u;
    v4u kx[8], vx[8];
#pragma unroll
    for (int p = 0; p < 8; ++p) kx[p] = *(const v4u*)((const unsigned char*)Kg + (size_t)p * 32 * kstride * 2 + ko);
#pragma unroll
    for (int p = 0; p < 8; ++p) vx[p] = *(const v4u*)((const unsigned char*)VTg + (size_t)p * 16 * vstride * 2 + vo);
#pragma unroll
    for (int p = 0; p < 8; ++p) *(LAS v4u*)(lds + KS_OFF + p * 32 * KROW + kl) = kx[p];
    { const unsigned c = (unsigned)(tid & 31), vl2 = (unsigned)(tid >> 5) * VROW + (c >> 1) * 32u + (c & 1u) * 8u;
#pragma unroll
      for (int p = 0; p < 8; ++p) { v2u a2, b2; a2.x = vx[p].x; a2.y = vx[p].y; b2.x = vx[p].z; b2.y = vx[p].w;
        *(LAS v2u*)(lds + VS_OFF + p * 16 * VROW + vl2) = a2; *(LAS v2u*)(lds + VS_OFF + p * 16 * VROW + vl2 + 16) = b2; } }
    if (tbg) { const f32x4 x = ((const f32x4*)tbg)[tid]; ((LAS f32x4*)(lds + TB_OFF))[tid] = x; }
}
__device__ __forceinline__ void load_q(bf16x8 (&qf)[8], const bf16* qp, int hi) {
#pragma unroll
    for (int ks = 0; ks < 8; ++ks) qf[ks] = *(const bf16x8*)(qp + 16 * ks + 8 * hi);
}
__device__ __forceinline__ void store_o16(bf16* rowbase, const f32x16 (&O)[4], float scale, int hi, bool doit) {
#pragma unroll
    for (int dt = 0; dt < 4; ++dt)
#pragma unroll
        for (int gp = 0; gp < 2; ++gp) {
            const int ga = 2 * gp, gb = 2 * gp + 1;
            const unsigned ax = pk2(O[dt][4 * ga] * scale, O[dt][4 * ga + 1] * scale), ay = pk2(O[dt][4 * ga + 2] * scale, O[dt][4 * ga + 3] * scale);
            const unsigned bx = pk2(O[dt][4 * gb] * scale, O[dt][4 * gb + 1] * scale), by = pk2(O[dt][4 * gb + 2] * scale, O[dt][4 * gb + 3] * scale);
            const v2u r1 = __builtin_amdgcn_permlane32_swap(ax, bx, false, false), r2 = __builtin_amdgcn_permlane32_swap(ay, by, false, false);
            v4u w; w.x = r1.x; w.y = r2.x; w.z = r1.y; w.w = r2.y;
            if (doit) *(v4u*)(rowbase + 32 * dt + 8 * (hi ? gb : ga)) = w;
        }
}
template <int MODE>
__device__ __forceinline__ void attn_core(LAS unsigned char* lds, const bf16x8 (&qf)[8], int qrel, float sc, int nchunks, bool fast, float cbias, f32x16 (&O)[4], float& m, float& l, int lane) {
    const int l31 = lane & 31, hi = lane >> 5;
#pragma unroll
    for (int dt = 0; dt < 4; ++dt)
#pragma unroll
        for (int r = 0; r < 16; ++r) O[dt][r] = 0.f;
    m = -1e30f; l = 0.f;
    const LAS float* tb = (const LAS float*)(lds + TB_OFF);
#pragma unroll 1
    for (int c = 0; c < nchunks; ++c) {
        f32x16 s0, s1;
#pragma unroll
        for (int r = 0; r < 16; ++r) { s0[r] = 0.f; s1[r] = 0.f; }
        const LAS unsigned char* kp = lds + KS_OFF + (64 * c + l31) * KROW + 16 * hi;
#pragma unroll
        for (int h2 = 0; h2 < 2; ++h2) {
            bf16x8 ka[4], kb[4];
#pragma unroll
            for (int ks = 0; ks < 4; ++ks) { ka[ks] = *(const LAS bf16x8*)(kp + 32 * (4 * h2 + ks)); kb[ks] = *(const LAS bf16x8*)(kp + 32 * KROW + 32 * (4 * h2 + ks)); }
#pragma unroll
            for (int ks = 0; ks < 4; ++ks) {
                s0 = __builtin_amdgcn_mfma_f32_32x32x16_bf16(ka[ks], qf[4 * h2 + ks], s0, 0, 0, 0);
                s1 = __builtin_amdgcn_mfma_f32_32x32x16_bf16(kb[ks], qf[4 * h2 + ks], s1, 0, 0, 0);
            }
        }
        float mx = -INFINITY;
#pragma unroll
        for (int r = 0; r < 16; ++r) {
            const int d0 = qrel - (64 * c + crow(r, hi)), d1 = d0 - 32;
            float t0 = s0[r] * sc, t1 = s1[r] * sc;
            if (MODE == 0) { if (fast) { t0 += cbias; t1 += cbias; } else { t0 += tb[d0 < 2047 ? d0 : 2047]; t1 += tb[d1 < 2047 ? d1 : 2047]; } }
            if (MODE == 1) { t0 = d0 >= 0 ? t0 + tb[d0 > 0 ? d0 : 0] : -INFINITY; t1 = d1 >= 0 ? t1 + tb[d1 > 0 ? d1 : 0] : -INFINITY; }
            s0[r] = t0; s1[r] = t1; mx = fmaxf(mx, fmaxf(t0, t1));
        }
        { const v2u sw = __builtin_amdgcn_permlane32_swap(__float_as_uint(mx), __float_as_uint(mx), false, false); mx = fmaxf(__uint_as_float(sw.x), __uint_as_float(sw.y)); }
        const float mn = fmaxf(m, mx), alpha = ex2(m - mn); m = mn;
        float ls = 0.f;
#pragma unroll
        for (int r = 0; r < 16; ++r) { s0[r] = ex2(s0[r] - mn); s1[r] = ex2(s1[r] - mn); ls += s0[r] + s1[r]; }
        l = l * alpha + ls;
        if (c > 0) {
#pragma unroll
            for (int dt = 0; dt < 4; ++dt)
#pragma unroll
                for (int r = 0; r < 16; ++r) O[dt][r] *= alpha;
        }
#pragma unroll
        for (int kt2 = 0; kt2 < 2; ++kt2) {
            bf16x8 pb[2];
#pragma unroll
            for (int sp = 0; sp < 2; ++sp) {
                v4u pw;
                if (kt2 == 0) { pw.x = pk2s(s0[8 * sp + 0], s0[8 * sp + 1]); pw.y = pk2s(s0[8 * sp + 2], s0[8 * sp + 3]); pw.z = pk2s(s0[8 * sp + 4], s0[8 * sp + 5]); pw.w = pk2s(s0[8 * sp + 6], s0[8 * sp + 7]); }
                else          { pw.x = pk2s(s1[8 * sp + 0], s1[8 * sp + 1]); pw.y = pk2s(s1[8 * sp + 2], s1[8 * sp + 3]); pw.z = pk2s(s1[8 * sp + 4], s1[8 * sp + 5]); pw.w = pk2s(s1[8 * sp + 6], s1[8 * sp + 7]); }
                pb[sp] = __builtin_bit_cast(bf16x8, pw);
            }
            const LAS unsigned char* vp = lds + VS_OFF + l31 * VROW + (64 * c + 32 * kt2) * 2 + 16 * hi;
            bf16x8 va[2][4];
#pragma unroll
            for (int sp = 0; sp < 2; ++sp)
#pragma unroll
                for (int dt = 0; dt < 4; ++dt) va[sp][dt] = *(const LAS bf16x8*)(vp + sp * 32 + dt * 32 * VROW);
#pragma unroll
            for (int sp = 0; sp < 2; ++sp)
#pragma unroll
                for (int dt = 0; dt < 4; ++dt) O[dt] = __builtin_amdgcn_mfma_f32_32x32x16_bf16(va[sp][dt], pb[sp], O[dt], 0, 0, 0);
        }
    }
    { const v2u sw = __builtin_amdgcn_permlane32_swap(__float_as_uint(l), __float_as_uint(l), false, false); l = __uint_as_float(sw.x) + __uint_as_float(sw.y); }
}

#define XB_TMO      128
#define XB_XCNT(j)  (256  + 64 * (j))
#define XB_XSUB(j)  (1280 + 64 * (j))
#define XB_XGEN(j)  (2304 + 64 * (j))
#define XB_TOP      3328
#define XB_TOPGEN   3392
#define XCD_BAR_WORDS 3456
#define XB_SPIN_CAP (1u << 18)

__device__ __forceinline__ unsigned xb_ld(unsigned* p)              { return __hip_atomic_load(p, __ATOMIC_RELAXED, __HIP_MEMORY_SCOPE_AGENT); }
__device__ __forceinline__ unsigned xb_add(unsigned* p, unsigned v) { return __hip_atomic_fetch_add(p, v, __ATOMIC_RELAXED, __HIP_MEMORY_SCOPE_AGENT); }
__device__ __forceinline__ unsigned xb_xcc_id() { return (unsigned)__builtin_amdgcn_s_getreg((3 << 11) | 20) & 0xFu; }
#define XB_SPIN(cond, bar) do { unsigned _sp = 0; while (cond) { __builtin_amdgcn_s_sleep(1); \
    if ((++_sp & 255u) == 0u) { if (xb_ld(&(bar)[XB_TMO])) break; if (_sp > XB_SPIN_CAP) { atomicAdd(&(bar)[XB_TMO], 1u); break; } } } } while (0)

struct XcdBarrier {
    unsigned* bar; unsigned x;
    volatile LAS unsigned* st;
};

__device__ __forceinline__ XcdBarrier xcd_barrier_post(unsigned* bar, volatile LAS unsigned* st, int tid) {
    XcdBarrier b; b.bar = bar; b.x = xb_xcc_id(); b.st = st;
    if (tid == 0) (void)xb_add(&bar[XB_XCNT(b.x)], 1u);
    return b;
}
__device__ __forceinline__ void xcd_barrier_complete(unsigned* bar, unsigned x, unsigned& nloc, unsigned& nx) {
    const unsigned G = gridDim.x * gridDim.y * gridDim.z;
    unsigned sum, cnt, mine, sp = 0u;
    for (;;) {
        sum = 0u; cnt = 0u; mine = 0u;
#pragma unroll
        for (unsigned j = 0; j < 16; ++j) { const unsigned c = xb_ld(&bar[XB_XCNT(j)]); sum += c; cnt += (c > 0u) ? 1u : 0u; mine = (j == x) ? c : mine; }
        if (sum == G) break;
        __builtin_amdgcn_s_sleep(1);
        if ((++sp & 255u) == 0u) { if (xb_ld(&bar[XB_TMO])) break; if (sp > XB_SPIN_CAP) { atomicAdd(&bar[XB_TMO], 1u); break; } }
    }
    nloc = mine > 0u ? mine : 1u; nx = cnt > 0u ? cnt : 1u;
}

__device__ __forceinline__ void xcd_barrier(const XcdBarrier& b, int tid) {
    asm volatile("s_waitcnt vmcnt(0)" ::: "memory");
    __syncthreads();
    if (tid == 0) {
        unsigned* bar = b.bar;
        __builtin_amdgcn_s_waitcnt(0);
        unsigned nloc = b.st[0], nx = b.st[1];
        if (nloc == 0u) { xcd_barrier_complete(bar, b.x, nloc, nx); b.st[0] = nloc; b.st[1] = nx; }
        const unsigned old = xb_add(&bar[XB_XSUB(b.x)], 1u);
        const unsigned gen = old / nloc;
        if (old + 1u == (gen + 1u) * nloc) {
            __builtin_amdgcn_fence(__ATOMIC_RELEASE, "agent");
            asm volatile("s_waitcnt vmcnt(0)" ::: "memory");
            const unsigned og = xb_add(&bar[XB_TOP], 1u);
            const unsigned tg = og / nx;
            if (og + 1u == (tg + 1u) * nx) xb_add(&bar[XB_TOPGEN], 1u);
            else XB_SPIN(xb_ld(&bar[XB_TOPGEN]) == tg, bar);
            __builtin_amdgcn_fence(__ATOMIC_ACQUIRE, "agent");
            xb_add(&bar[XB_XGEN(b.x)], 1u);
            asm volatile("s_waitcnt vmcnt(0)" ::: "memory");
        } else {
            XB_SPIN(xb_ld(&bar[XB_XGEN(b.x)]) == gen, bar);
            __builtin_amdgcn_fence(__ATOMIC_ACQUIRE, "agent");
            asm volatile("s_waitcnt vmcnt(0)" ::: "memory");
        }
    }
    __syncthreads();
}

struct Args { const float* in[20]; float* out; unsigned char* ws; int ph_lo, ph_hi; };

__global__ void __launch_bounds__(512, 2) fwd(Args a) {
    extern __shared__ __attribute__((aligned(16))) unsigned char lds_raw[];
    LAS unsigned char* lds = (LAS unsigned char*)lds_raw;
    const int wave = __builtin_amdgcn_readfirstlane((int)threadIdx.x >> 6);
    const int G = gridDim.x, blk = blockIdx.x;
    const int lo = a.ph_lo, hiP = a.ph_hi;
    LAS unsigned long long* ptab = (LAS unsigned long long*)(lds + PT_OFF);
    if (threadIdx.x == 0) {
#pragma unroll
        for (int i = 0; i < 20; ++i) ptab[i] = (unsigned long long)a.in[i];
        ptab[20] = (unsigned long long)a.out; ptab[21] = (unsigned long long)a.ws;
        ((LAS unsigned*)(lds + ST_OFF))[0] = 0u; ((LAS unsigned*)(lds + ST_OFF))[1] = 0u;
    }
    __syncthreads();
    if (a.ph_hi - a.ph_lo > 1) {
        cg::this_grid().sync();
        const int lane_ = (int)__builtin_amdgcn_mbcnt_hi(~0u, __builtin_amdgcn_mbcnt_lo(~0u, 0u));
        (void)xcd_barrier_post((unsigned*)(a.ws + WS_CTL) + CW_BAR, (volatile LAS unsigned*)(lds + ST_OFF), wave * 64 + lane_);
    }
#define LDP(i) ((unsigned char*)(__attribute__((address_space(1))) unsigned char*)(((unsigned long long)(unsigned)__builtin_amdgcn_readfirstlane((int)(unsigned)(ptab[i] >> 32)) << 32) | (unsigned long long)(unsigned)__builtin_amdgcn_readfirstlane((int)(unsigned)ptab[i])))
#define DECL_PTRS \
    const int lane = (int)__builtin_amdgcn_mbcnt_hi(~0u, __builtin_amdgcn_mbcnt_lo(~0u, 0u)), tid = wave * 64 + lane, l31 = lane & 31, hi = lane >> 5; (void)tid; (void)l31; (void)hi; \
    const float* const x = (const float*)LDP(0); (void)x; \
    const float* const mem = (const float*)LDP(1); (void)mem; \
    const float* const g_mix = (const float*)LDP(2); (void)g_mix; \
    const float* const w_in = (const float*)LDP(3); (void)w_in; \
    const float* const conv_w = (const float*)LDP(4); (void)conv_w; \
    const float* const conv_b = (const float*)LDP(5); (void)conv_b; \
    const float* const ln_g = (const float*)LDP(6); (void)ln_g; \
    const float* const ln_b = (const float*)LDP(7); (void)ln_b; \
    const float* const w_out = (const float*)LDP(8); (void)w_out; \
    const float* const rel_bias = (const float*)LDP(9); (void)rel_bias; \
    const float* const g_cross = (const float*)LDP(10); (void)g_cross; \
    const float* const g_mem = (const float*)LDP(11); (void)g_mem; \
    const float* const wq_c = (const float*)LDP(12); (void)wq_c; \
    const float* const wk_c = (const float*)LDP(13); (void)wk_c; \
    const float* const wv_c = (const float*)LDP(14); (void)wv_c; \
    const float* const wo_c = (const float*)LDP(15); (void)wo_c; \
    const float* const g_mlp = (const float*)LDP(16); (void)g_mlp; \
    const float* const w1 = (const float*)LDP(17); (void)w1; \
    const float* const w2 = (const float*)LDP(18); (void)w2; \
    const float* const g_final = (const float*)LDP(19); (void)g_final; \
    float* const out = (float*)LDP(20); (void)out; unsigned char* const ws = LDP(21); (void)ws; \
    unsigned* const CNT = (unsigned*)(ws + WS_CTL); (void)CNT; float* const SSQ1 = (float*)(ws + WS_CTL + 262144); (void)SSQ1; float* const SSQ2 = (float*)(ws + WS_CTL + 524288); (void)SSQ2; float* const SSQ3 = (float*)(ws + WS_CTL + 786432); (void)SSQ3; \
    bf16* const WIN_T = (bf16*)(ws + WS_WIN); (void)WIN_T; \
    bf16* const WOUT_T = (bf16*)(ws + WS_WOUT); (void)WOUT_T; \
    bf16* const WQ_T = (bf16*)(ws + WS_WQ); (void)WQ_T; \
    bf16* const WKV_T = (bf16*)(ws + WS_WKV); (void)WKV_T; \
    bf16* const WO_T = (bf16*)(ws + WS_WO); (void)WO_T; \
    bf16* const W1_T = (bf16*)(ws + WS_W1); (void)W1_T; \
    bf16* const W2_T = (bf16*)(ws + WS_W2); (void)W2_T; \
    float* const KBAR = (float*)(ws + WS_KBAR); (void)KBAR; \
    float* const TB = (float*)(ws + WS_TB); (void)TB; \
    bf16* const MN = (bf16*)(ws + WS_MN); (void)MN; \
    bf16* const KC = (bf16*)(ws + WS_KC); (void)KC; \
    bf16* const VCT = (bf16*)(ws + WS_VCT); (void)VCT; \
    bf16* const NBUF = (bf16*)(ws + WS_NB); (void)NBUF; \
    bf16* const Q = (bf16*)(ws + WS_Q); (void)Q; \
    bf16* const K = (bf16*)(ws + WS_K); (void)K; \
    bf16* const VT = (bf16*)(ws + WS_VT); (void)VT; \
    bf16* const UV = (bf16*)(ws + WS_UV); (void)UV; \
    bf16* const UG = (bf16*)(ws + WS_UG); (void)UG; \
    bf16* const AC = (bf16*)(ws + WS_AC); (void)AC; \
    bf16* const FB = (bf16*)(ws + WS_F); (void)FB; \
    bf16* const QC = (bf16*)(ws + WS_QC); (void)QC; \
    bf16* const OC = (bf16*)(ws + WS_OC); (void)OC; \
    bf16* const PO = (bf16*)(ws + WS_PO); (void)PO; \
    float* const PML = (float*)(ws + WS_PML); (void)PML; \
    unsigned* const LIST = (unsigned*)(ws + WS_LIST); (void)LIST; \
    do {} while (0)
    const float SC = 0.08838834764831845f * LOG2E;
#ifndef DBG
#define DBG 0
#endif
#ifndef REP_MASK
#define REP_MASK 0
#endif
#ifndef PH_MASK
#define PH_MASK 0x7fff
#endif
#define IN(k) (((PH_MASK >> (k)) & 1) && lo <= (k) && (k) < hiP)
#define SEAM2(k, kn) do { if (IN(k) && IN(kn)) { const int lane_ = (int)__builtin_amdgcn_mbcnt_hi(~0u, __builtin_amdgcn_mbcnt_lo(~0u, 0u)); \
        XcdBarrier b_; b_.bar = (unsigned*)(LDP(21) + WS_CTL) + CW_BAR; b_.x = xb_xcc_id(); b_.st = (volatile LAS unsigned*)(lds + ST_OFF); xcd_barrier(b_, wave * 64 + lane_); } } while (0)
#define SEAM(k) SEAM2(k, (k) + 1)
#define GRID_BAR() do { const int lane_ = (int)__builtin_amdgcn_mbcnt_hi(~0u, __builtin_amdgcn_mbcnt_lo(~0u, 0u)); \
        XcdBarrier b_; b_.bar = (unsigned*)(LDP(21) + WS_CTL) + CW_BAR; b_.x = xb_xcc_id(); b_.st = (volatile LAS unsigned*)(lds + ST_OFF); xcd_barrier(b_, wave * 64 + lane_); } while (0)

    for (int rep_ = 0; rep_ < (IN(0) ? 1 + ((REP_MASK >> 0) & 1) : 0); ++rep_) { DECL_PTRS;
        LAS float* scr = (LAS float*)(lds + wave * 16384);
        const int gw = blk * 8 + wave, NGW = G * 8;
        constexpr int I_IN = (DM / 64) * (INW / 32), I_OUT = (DM / 64) * (DM / 32), I_X = (DM / 64) * (XW / 32), I_O = (XW / 64) * (DM / 32), I_1 = (DM / 64) * (FF / 32), I_2 = (FF / 64) * (DM / 32);
        constexpr int NITEMS = I_IN + I_OUT + 3 * I_X + I_O + I_1 + I_2;
        const bool early = (G > 16) && (hiP - lo > 1);
        for (int it = gw; it < 2 * I_X; it += NGW) { if (it < I_X) p0_transpose_item(wk_c, DM, XW, WKV_T, 0, scr, it, lane); else p0_transpose_item(wv_c, DM, XW, WKV_T, XW, scr, it - I_X, lane); }
        for (int mrow = gw; mrow < NB * NMEM; mrow += NGW) rms_row_bf16(mem + (size_t)mrow * DM, g_mem, MN + (size_t)mrow * DM, lane);
        for (int i = blk * 512 + tid; i < NH * 2048; i += G * 512) {
            const int hh = i >> 11, d = i & 2047; int bucket = d;
            if (d >= 16) { const int lg = 16 + (int)(logf((float)d / 16.0f) / 4.852030263919617f * 16.0f); bucket = lg < 31 ? lg : 31; }
            TB[i] = rel_bias[bucket * NH + hh] * LOG2E;
        }
        if (early) { GRID_BAR(); }
        if (early && blk < 8) {
            pg8::Gemm g{MN, WKV_T, NB * NMEM, 2 * XW, DM}; pg8::StaticOrder So; So.init(NB * NMEM, 2 * XW, 8, blk);
            pg8::EpiBf16X<0> E{KC, XW, XW, (size_t)NB * NMEM * XW, 1, VCT, NMEM, XH, nullptr};
            pg8::gemm_phase<pg8::EpiBf16X<0>, pg8::StaticOrder, true, true>(lds, g, So, E, tid);
        } else {
        const int nb0 = early ? 8 : 0, gwb = (blk - nb0) * 8 + wave, NGWB = (G - nb0) * 8;
        constexpr int NREST = I_IN + I_OUT + I_X + I_O + I_1 + I_2;
        for (int it = gwb; it < NREST; it += NGWB) {
            int r = it;
            if (r < I_IN) { p0_transpose_item(w_in, DM, INW, WIN_T, 0, scr, r, lane); continue; } r -= I_IN;
            if (r < I_OUT) { p0_transpose_item(w_out, DM, DM, WOUT_T, 0, scr, r, lane); continue; } r -= I_OUT;
            if (r < I_X) { p0_transpose_item(wq_c, DM, XW, WQ_T, 0, scr, r, lane, g_cross); continue; } r -= I_X;
            if (r < I_O) { p0_transpose_item(wo_c, XW, DM, WO_T, 0, scr, r, lane); continue; } r -= I_O;
            if (r < I_1) { p0_transpose_item(w1, DM, FF, W1_T, 0, scr, r, lane, g_mlp); continue; } r -= I_1;
            p0_transpose_item(w2, FF, DM, W2_T, 0, scr, r, lane);
        }
        for (int mrow = gwb; mrow < T; mrow += 2 * NGWB) {
            const int r2 = mrow + NGWB;
            const f32x4* xa = (const f32x4*)(x + (size_t)mrow * DM) + lane; const f32x4* xb = (const f32x4*)(x + (size_t)(r2 < T ? r2 : mrow) * DM) + lane;
            f32x4 va[8], vb[8]; float sa = 0.f, sb = 0.f;
#pragma unroll
            for (int jj = 0; jj < 8; ++jj) { va[jj] = xa[64 * jj]; vb[jj] = xb[64 * jj]; }
#pragma unroll
            for (int jj = 0; jj < 8; ++jj) { sa += (va[jj].x * va[jj].x + va[jj].y * va[jj].y) + (va[jj].z * va[jj].z + va[jj].w * va[jj].w); sb += (vb[jj].x * vb[jj].x + vb[jj].y * vb[jj].y) + (vb[jj].z * vb[jj].z + vb[jj].w * vb[jj].w); }
            const float ra = 1.0f / sqrtf(wave_sum(sa) * (1.0f / DM) + EPS), rb = 1.0f / sqrtf(wave_sum(sb) * (1.0f / DM) + EPS);
            const f32x4* gr = (const f32x4*)g_mix + lane; v2u* oa = (v2u*)(NBUF + (size_t)mrow * DM) + lane; v2u* ob = (v2u*)(NBUF + (size_t)(r2 < T ? r2 : mrow) * DM) + lane;
#pragma unroll
            for (int jj = 0; jj < 8; ++jj) { const f32x4 gv = gr[64 * jj]; v2u w; w.x = pk2(va[jj].x * ra * gv.x, va[jj].y * ra * gv.y); w.y = pk2(va[jj].z * ra * gv.z, va[jj].w * ra * gv.w); oa[64 * jj] = w;
                if (r2 < T) { v2u w2; w2.x = pk2(vb[jj].x * rb * gv.x, vb[jj].y * rb * gv.y); w2.y = pk2(vb[jj].z * rb * gv.z, vb[jj].w * rb * gv.w); ob[64 * jj] = w2; } }
        }
        }
        __syncthreads();
    }
    SEAM(0);

    for (int rep_ = 0; rep_ < (IN(1) ? 1 + ((REP_MASK >> 1) & 1) : 0); ++rep_) { DECL_PTRS;
        { pg8::Gemm g{NBUF, WIN_T, T, INW, DM}; pg8::StaticOrder So; So.init(T, INW, G, blk);
          pg8::EpiBf16X<0> E{Q, AW, AW, (size_t)T * AW, 2, VT, S, NH, nullptr};
          pg8::gemm_phase<pg8::EpiBf16X<0>, pg8::StaticOrder, true, true>(lds, g, So, E, tid); }
        if (!((G > 16) && (hiP - lo > 1)))
        { pg8::Gemm g{MN, WKV_T, NB * NMEM, 2 * XW, DM}; pg8::StaticOrder So; So.init(NB * NMEM, 2 * XW, G, blk);
          pg8::EpiBf16X<0> E{KC, XW, XW, (size_t)NB * NMEM * XW, 1, VCT, NMEM, XH, nullptr};
          pg8::gemm_phase<pg8::EpiBf16X<0>, pg8::StaticOrder, true, true>(lds, g, So, E, tid); }
    }
    SEAM(1);

#if DBG == 9
    { DECL_PTRS; for (size_t i = (size_t)blk * 512 + tid; i < (size_t)T * DM; i += (size_t)G * 512) { out[i] = i < 262144 ? __uint_as_float(((unsigned)KC[i] << 16)) : (i < 524288 ? __uint_as_float(((unsigned)VCT[i - 262144] << 16)) : 0.f); } return; }
#endif
#if DBG == 1
    { DECL_PTRS; for (size_t i = (size_t)blk * 512 + tid; i < (size_t)T * DM; i += (size_t)G * 512) { const size_t t = i >> 11, c = i & 2047, e = t * 1024 + (c & 1023);
        const unsigned short v = c < 1024 ? (unsigned short)(Q[e] ^ UV[e]) : (unsigned short)(K[e] ^ UG[e] ^ VT[e]); out[i] = __uint_as_float(((unsigned)v << 16)) ; } return; }
#endif
    for (int rep_ = 0; rep_ < (IN(2) ? 1 + ((REP_MASK >> 2) & 1) : 0); ++rep_) { DECL_PTRS;
        for (int it = blk; it < 256; it += G) {
            const int b = it >> 7, j = (it >> 1) & 63, chh = it & 1, cp = tid & 255, rh = tid >> 8;
            const bf16* kp = K + (size_t)(b * S + j * 256 + rh * 128) * AW + chh * 512 + 2 * cp;
            float s0 = 0.f, s1 = 0.f;
#pragma unroll 8
            for (int r = 0; r < 128; ++r) { const unsigned w = *(const unsigned*)(kp + (size_t)r * AW); s0 += bf_lo(w); s1 += bf_hi(w); }
            LAS f32x2* red = (LAS f32x2*)lds;
            if (rh == 1) red[cp] = (f32x2){s0, s1};
            __syncthreads();
            if (rh == 0) { const f32x2 o = red[cp]; const int col = chh * 512 + 2 * cp, hh = col >> 7, d = col & 127;
                *(f32x2*)(KBAR + ((size_t)((b * NH + hh) * NBLK + j)) * HD + d) = (f32x2){(s0 + o.x) * (1.0f / 256.0f), (s1 + o.y) * (1.0f / 256.0f)}; }
            __syncthreads();
        }
        for (int seg = blk; seg < T / 128; seg += G) {
            const int t0 = seg * 128, c0 = 2 * tid;
            float w0[CONVK], w1r[CONVK];
#pragma unroll
            for (int k = 0; k < CONVK; ++k) { const f32x2 wv = *(const f32x2*)(conv_w + k * CC + c0); w0[k] = wv.x; w1r[k] = wv.y; }
            const f32x2 cb = *(const f32x2*)(conv_b + c0), lg = *(const f32x2*)(ln_g + c0), lb = *(const f32x2*)(ln_b + c0);
            float r0[32], r1[32];
#pragma unroll
            for (int i = 0; i < 32; ++i) { r0[i] = 0.f; r1[i] = 0.f; }
            LAS f32x2* red = (LAS f32x2*)(lds + RED_OFF);
#pragma unroll 1
            for (int ch = -1; ch < 4; ++ch) {
                const int tb0 = t0 + ch * 32;
                const bool zero = (ch < 0) && ((t0 & (S - 1)) == 0);
#pragma unroll
                for (int hf = 0; hf < 2; ++hf) {
                    float y0[16], y1[16];
#pragma unroll
                    for (int ii = 0; ii < 16; ++ii) {
                        const int i = hf * 16 + ii;
                        float h0 = 0.f, h1 = 0.f;
                        if (!zero) { const size_t off = (size_t)(tb0 + i) * CC + c0; const unsigned vv = *(const unsigned*)(UV + off), gg = *(const unsigned*)(UG + off);
                            h0 = bf_lo(vv) * sigmoidf_(bf_lo(gg)); h1 = bf_hi(vv) * sigmoidf_(bf_hi(gg)); }
                        r0[i] = h0; r1[i] = h1;
                        float a0 = cb.x, a1 = cb.y;
                        if (ch >= 0) {
#pragma unroll
                            for (int k = 0; k < CONVK; ++k) { a0 += r0[(i - 30 + k) & 31] * w0[k]; a1 += r1[(i - 30 + k) & 31] * w1r[k]; }
                        }
                        y0[ii] = a0; y1[ii] = a1;
                    }
                    if (ch >= 0) {
#pragma unroll
                        for (int gq = 0; gq < 2; ++gq) {
                            float rb[8], rc[4], rd[2];
                            const bool b5 = (lane & 32) != 0, b4 = (lane & 16) != 0, b3 = (lane & 8) != 0, b2 = (lane & 4) != 0;
#pragma unroll
                            for (int i = 0; i < 8; ++i) { const int tl = 8 * gq + (i >> 1), th = tl + 4;
                                const float fa = (i & 1) ? y0[tl] * y0[tl] + y1[tl] * y1[tl] : y0[tl] + y1[tl], fb = (i & 1) ? y0[th] * y0[th] + y1[th] * y1[th] : y0[th] + y1[th];
                                rb[i] = (b5 ? fb : fa) + __shfl_xor(b5 ? fa : fb, 32); }
#pragma unroll
                            for (int i = 0; i < 4; ++i) rc[i] = (b4 ? rb[4 + i] : rb[i]) + __shfl_xor(b4 ? rb[i] : rb[4 + i], 16);
#pragma unroll
                            for (int i = 0; i < 2; ++i) rd[i] = (b3 ? rc[2 + i] : rc[i]) + __shfl_xor(b3 ? rc[i] : rc[2 + i], 8);
                            float rf = (b2 ? rd[1] : rd[0]) + __shfl_xor(b2 ? rd[0] : rd[1], 4);
                            rf += __shfl_xor(rf, 2); rf += __shfl_xor(rf, 1);
                            const int kidx = ((lane >> 5) & 1) * 8 + ((lane >> 4) & 1) * 4 + ((lane >> 3) & 1) * 2 + ((lane >> 2) & 1);
                            if ((lane & 3) == 0) ((LAS float*)red)[(8 * gq + (kidx >> 1)) * 16 + wave * 2 + (kidx & 1)] = rf;
                        }
                        __syncthreads();
#pragma unroll
                        for (int ii = 0; ii < 16; ++ii) {
                            float s1 = 0.f, s2 = 0.f;
#pragma unroll
                            for (int w = 0; w < 4; ++w) { const f32x4 p = ((const LAS f32x4*)red)[ii * 4 + w]; s1 += p.x + p.z; s2 += p.y + p.w; }
                            const float mean = s1 * (1.0f / CC), var = fmaxf(s2 * (1.0f / CC) - mean * mean, 0.f), rstd = 1.0f / sqrtf(var + EPS);
                            float o0 = (y0[ii] - mean) * rstd * lg.x + lb.x, o1 = (y1[ii] - mean) * rstd * lg.y + lb.y;
                            o0 = o0 * sigmoidf_(o0); o1 = o1 * sigmoidf_(o1);
                            *(unsigned*)(AC + (size_t)(tb0 + hf * 16 + ii) * DM + AW + c0) = pk2(o0, o1);
                        }
                        __syncthreads();
                    }
                }
            }
        }
    }
    SEAM(2);

    for (int rep_ = 0; rep_ < (IN(3) ? 1 : 0); ++rep_) { DECL_PTRS;
        constexpr int KH_OFF = 0, KL_OFF = 64 * KROW;
        for (int it = blk; it < NB * NH * NBLK; it += G) {
            const int bh = it >> 6, own = it & 63, b = bh >> 3, hh = bh & 7;
            if (own == 0) continue;
            f32x2 kvv[8];
#pragma unroll
            for (int i = 0; i < 8; ++i) { const int p2 = tid + 512 * i; kvv[i] = *(const f32x2*)(KBAR + (size_t)bh * NBLK * HD + 2 * p2); }
#pragma unroll
            for (int i = 0; i < 8; ++i) { const int p2 = tid + 512 * i, jr = p2 >> 6, d = (p2 & 63) * 2; const f32x2 kv = kvv[i];
                const unsigned hw = pk2s(kv.x, kv.y); const unsigned lw = pk2s(kv.x - bf_lo(hw), kv.y - bf_hi(hw));
                *(LAS unsigned*)(lds + KH_OFF + jr * KROW + d * 2) = hw; *(LAS unsigned*)(lds + KL_OFF + jr * KROW + d * 2) = lw; }
            const int ql = own * 256 + wave * 32 + l31;
            bf16x8 qf[8]; load_q(qf, Q + (size_t)(b * S + ql) * AW + hh * HD, hi);
            __syncthreads();
            f32x16 g0, g1;
#pragma unroll
            for (int r = 0; r < 16; ++r) { g0[r] = 0.f; g1[r] = 0.f; }
            const LAS unsigned char* kp = lds + l31 * KROW + 16 * hi;
#pragma unroll
            for (int ks = 0; ks < 8; ++ks) {
                g0 = __builtin_amdgcn_mfma_f32_32x32x16_bf16(*(const LAS bf16x8*)(kp + KH_OFF + 32 * ks), qf[ks], g0, 0, 0, 0);
                g0 = __builtin_amdgcn_mfma_f32_32x32x16_bf16(*(const LAS bf16x8*)(kp + KL_OFF + 32 * ks), qf[ks], g0, 0, 0, 0);
            }
            if (own > 32) {
#pragma unroll
                for (int ks = 0; ks < 8; ++ks) {
                    g1 = __builtin_amdgcn_mfma_f32_32x32x16_bf16(*(const LAS bf16x8*)(kp + KH_OFF + 32 * KROW + 32 * ks), qf[ks], g1, 0, 0, 0);
                    g1 = __builtin_amdgcn_mfma_f32_32x32x16_bf16(*(const LAS bf16x8*)(kp + KL_OFF + 32 * KROW + 32 * ks), qf[ks], g1, 0, 0, 0);
                }
            }
            float v0 = -INFINITY, v1 = -INFINITY, v2 = -INFINITY; int i0 = 64, i1 = 64, i2 = 64;
#define TOP3_INS(val, idx) do { const float dv_ = (val); const int di_ = (idx); if (di_ < own && dv_ > v2) { if (dv_ > v1) { v2 = v1; i2 = i1; if (dv_ > v0) { v1 = v0; i1 = i0; v0 = dv_; i0 = di_; } else { v1 = dv_; i1 = di_; } } else { v2 = dv_; i2 = di_; } } } while (0)
#pragma unroll
            for (int r = 0; r < 16; ++r) TOP3_INS(g0[r], crow(r, hi));
            if (own > 32) {
#pragma unroll
                for (int r = 0; r < 16; ++r) TOP3_INS(g1[r], 32 + crow(r, hi));
            }
            const float pv0 = __shfl_xor(v0, 32), pv1 = __shfl_xor(v1, 32), pv2 = __shfl_xor(v2, 32); const int pi0 = __shfl_xor(i0, 32), pi1 = __shfl_xor(i1, 32), pi2 = __shfl_xor(i2, 32);
#define TOP3_MRG(val, idx) do { const float dv_ = (val); const int di_ = (idx); if (di_ < own) { \
                if (dv_ > v2 || (dv_ == v2 && di_ < i2)) { if (dv_ > v1 || (dv_ == v1 && di_ < i1)) { v2 = v1; i2 = i1; if (dv_ > v0 || (dv_ == v0 && di_ < i0)) { v1 = v0; i1 = i0; v0 = dv_; i0 = di_; } else { v1 = dv_; i1 = di_; } } else { v2 = dv_; i2 = di_; } } } } while (0)
            TOP3_MRG(pv0, pi0); TOP3_MRG(pv1, pi1); TOP3_MRG(pv2, pi2);
            const int nsel = own < 3 ? own : 3;
            LAS unsigned char* sel = lds + 2 * 64 * KROW;
            if (hi == 0) { const int qi = wave * 32 + l31; sel[qi] = (unsigned char)(nsel > 0 ? i0 : 255); sel[256 + qi] = (unsigned char)(nsel > 1 ? i1 : 255); sel[512 + qi] = (unsigned char)(nsel > 2 ? i2 : 255); }
            __syncthreads();
            for (int jl = wave; jl < own; jl += 8) {
                unsigned long long bm[12]; bool mt[12]; unsigned total = 0u;
#pragma unroll
                for (int sk = 0; sk < 12; ++sk) { mt[sk] = sel[(sk >> 2) * 256 + lane + 64 * (sk & 3)] == (unsigned char)jl; bm[sk] = __ballot(mt[sk]); total += (unsigned)__popcll(bm[sk]); }
                if (total == 0u) continue;
                unsigned basep = 0u; if (lane == 0) basep = atomicAdd(&CNT[bh * NBLK + jl], total);
                unsigned run = (unsigned)__builtin_amdgcn_readfirstlane((int)basep);
                const unsigned long long lt = (1ull << lane) - 1ull;
#pragma unroll
                for (int sk = 0; sk < 12; ++sk) {
                    if (mt[sk]) __hip_atomic_store(&LIST[(size_t)(bh * NBLK + jl) * S + run + (unsigned)__popcll(bm[sk] & lt)], (unsigned)((own * 256 + lane + 64 * (sk & 3)) | ((sk >> 2) << 14)), __ATOMIC_RELAXED, __HIP_MEMORY_SCOPE_AGENT);
                    run += (unsigned)__popcll(bm[sk]);
                }
            }
            __syncthreads();
        }
    }
    SEAM(3);

    for (int rep_ = 0; rep_ < (IN(4) ? 1 + ((REP_MASK >> 4) & 1) : 0); ++rep_) { DECL_PTRS;
        LAS unsigned* pf = (LAS unsigned*)(lds + CNT_OFF);
        LAS unsigned* wtot = (LAS unsigned*)(lds + RED_OFF);
        {
            const unsigned c0 = __hip_atomic_load(&CNT[2 * tid], __ATOMIC_RELAXED, __HIP_MEMORY_SCOPE_AGENT), c1 = __hip_atomic_load(&CNT[2 * tid + 1], __ATOMIC_RELAXED, __HIP_MEMORY_SCOPE_AGENT);
            const unsigned ua = (c0 + 31u) >> 5, ub = (c1 + 31u) >> 5, us = ua + ub;
            unsigned v = us;
#pragma unroll
            for (int o = 1; o < 64; o <<= 1) { const unsigned u = __shfl_up(v, o); if (lane >= o) v += u; }
            if (lane == 63) wtot[wave] = v;
            __syncthreads();
            unsigned off = 0u;
            for (int w = 0; w < wave; ++w) off += wtot[w];
            const unsigned excl = off + v - us;
            pf[2 * tid] = excl + ua; pf[2 * tid + 1] = excl + us;
            __syncthreads();
        }
        const unsigned total = pf[NB * NH * NBLK - 1];
        const unsigned glo = (unsigned)(((unsigned long long)total * (unsigned)blk) / (unsigned)G), ghi = (unsigned)(((unsigned long long)total * (unsigned)(blk + 1)) / (unsigned)G);
        int lo_ = 0, hi_ = NB * NH * NBLK - 1;
        while (lo_ < hi_) { const int mid = (lo_ + hi_) >> 1; if (pf[mid] > glo) hi_ = mid; else lo_ = mid + 1; }
        int bhj = __builtin_amdgcn_readfirstlane(lo_); unsigned g = glo; int last_hh = -1;
        while (g < ghi) {
            const unsigned base = (unsigned)__builtin_amdgcn_readfirstlane((int)(bhj ? pf[bhj - 1] : 0u)), lend = (unsigned)__builtin_amdgcn_readfirstlane((int)pf[bhj]);
            const unsigned end = lend < ghi ? lend : ghi;
            const int cnt = __builtin_amdgcn_readfirstlane((int)__hip_atomic_load(&CNT[bhj], __ATOMIC_RELAXED, __HIP_MEMORY_SCOPE_AGENT));
            const int bh = bhj >> 6, j = bhj & 63, b = bh >> 3, hh = bh & 7;
            attn_stage(lds, K + (size_t)(b * S + j * 256) * AW + hh * HD, AW, VT + (size_t)(bh * HD) * S + j * 256, S, hh != last_hh ? TB + hh * 2048 : nullptr, tid); last_hh = hh;
            __syncthreads();
            const float cbias = ((const LAS float*)(lds + TB_OFF))[2047];
            unsigned gg = g + (unsigned)wave;
            unsigned e1 = (unsigned)(S - 1), e2 = (unsigned)(S - 1); bool v1 = false, v2 = false;
            bf16x8 qn[8];
            if (gg < end) { const int ix = (int)(gg - base) * 32 + l31; v1 = ix < cnt; if (v1) e1 = __hip_atomic_load(&LIST[(size_t)bhj * S + ix], __ATOMIC_RELAXED, __HIP_MEMORY_SCOPE_AGENT); }
            if (gg + 8u < end) { const int ix = (int)(gg + 8u - base) * 32 + l31; v2 = ix < cnt; if (v2) e2 = __hip_atomic_load(&LIST[(size_t)bhj * S + ix], __ATOMIC_RELAXED, __HIP_MEMORY_SCOPE_AGENT); }
            if (gg < end) load_q(qn, Q + (size_t)(b * S + (int)(e1 & 0x3fff)) * AW + hh * HD, hi);
            for (; gg < end; gg += 8u) {
                const unsigned e = e1; const bool valid = v1;
                bf16x8 qf[8];
#pragma unroll
                for (int ks = 0; ks < 8; ++ks) qf[ks] = qn[ks];
                e1 = e2; v1 = v2; e2 = (unsigned)(S - 1); v2 = false;
                if (gg + 16u < end) { const int ix = (int)(gg + 16u - base) * 32 + l31; v2 = ix < cnt; if (v2) e2 = __hip_atomic_load(&LIST[(size_t)bhj * S + ix], __ATOMIC_RELAXED, __HIP_MEMORY_SCOPE_AGENT); }
                if (gg + 8u < end) load_q(qn, Q + (size_t)(b * S + (int)(e1 & 0x3fff)) * AW + hh * HD, hi);
                const int ql = e & 0x3fff, slot = e >> 14, qrow = b * S + ql, qrel = ql - j * 256;
                const bool fast = __all(qrel - 255 >= 1512);
                f32x16 O[4]; float m, l;
                attn_core<0>(lds, qf, qrel, SC, 4, fast, cbias, O, m, l, lane);
                store_o16(PO + ((size_t)slot * T + qrow) * AW + hh * HD, O, 1.0f / l, hi, valid);
                if (valid) {
                    if (hi == 0) __hip_atomic_store((unsigned long long*)PML + ((size_t)(qrow * NH + hh) * 3 + slot), ((unsigned long long)__float_as_uint(l) << 32) | (unsigned long long)__float_as_uint(m), __ATOMIC_RELAXED, __HIP_MEMORY_SCOPE_AGENT);
                }
            }
            __syncthreads();
            g = end; ++bhj;
            while (bhj < NB * NH * NBLK && (unsigned)__builtin_amdgcn_readfirstlane((int)pf[bhj]) == lend) ++bhj;
        }
    }
    SEAM(4);

    for (int rep_ = 0; rep_ < (IN(5) ? 1 + ((REP_MASK >> 5) & 1) : 0); ++rep_) { DECL_PTRS;
        for (int it = blk; it < NB * NH * NBLK; it += G) {
            const int bh = it >> 6, j = it & 63, b = bh >> 3, hh = bh & 7;
            attn_stage(lds, K + (size_t)(b * S + j * 256) * AW + hh * HD, AW, VT + (size_t)(bh * HD) * S + j * 256, S, TB + hh * 2048, tid);
            __syncthreads();
            const int qrel = wave * 32 + l31, qrow = b * S + j * 256 + qrel;
            f32x16 O[4]; float m, l;
            bf16x8 qf[8]; load_q(qf, Q + (size_t)qrow * AW + hh * HD, hi);
            unsigned long long pw[3];
#pragma unroll
            for (int s = 0; s < 3; ++s) { pw[s] = 0ull; if (s < (j < 3 ? j : 3)) pw[s] = __hip_atomic_load((unsigned long long*)PML + ((size_t)(qrow * NH + hh) * 3 + s), __ATOMIC_RELAXED, __HIP_MEMORY_SCOPE_AGENT); }
            attn_core<1>(lds, qf, qrel, SC, (wave >> 1) + 1, false, 0.f, O, m, l, lane);
            const int nsel = j < 3 ? j : 3;
            float M = m, ms[3], lsv[3];
#pragma unroll
            for (int s = 0; s < 3; ++s) { ms[s] = -1e30f; lsv[s] = 0.f; if (s < nsel) { ms[s] = __uint_as_float((unsigned)pw[s]); lsv[s] = __uint_as_float((unsigned)(pw[s] >> 32)); M = fmaxf(M, ms[s]); } }
            const float wown = ex2(m - M); float den = l * wown, wsl[3];
#pragma unroll
            for (int s = 0; s < 3; ++s) { wsl[s] = lsv[s] * ex2(ms[s] - M); den += wsl[s]; }
            const float inv = 1.0f / den;
            bf16* op = AC + (size_t)qrow * DM + hh * HD + 4 * hi;
#pragma unroll
            for (int hf = 0; hf < 2; ++hf) {
                v2u pp[3][2][4];
#pragma unroll
                for (int s = 0; s < 3; ++s) if (s < nsel) {
#pragma unroll
                    for (int d2 = 0; d2 < 2; ++d2)
#pragma unroll
                        for (int g4 = 0; g4 < 4; ++g4) pp[s][d2][g4] = *(const v2u*)(PO + ((size_t)s * T + qrow) * AW + hh * HD + 4 * hi + 32 * (2 * hf + d2) + 8 * g4);
                }
#pragma unroll
                for (int d2 = 0; d2 < 2; ++d2)
#pragma unroll
                    for (int g4 = 0; g4 < 4; ++g4) { const int dt = 2 * hf + d2;
                        float o0 = O[dt][4 * g4] * wown, o1 = O[dt][4 * g4 + 1] * wown, o2 = O[dt][4 * g4 + 2] * wown, o3 = O[dt][4 * g4 + 3] * wown;
#pragma unroll
                        for (int s = 0; s < 3; ++s) if (s < nsel) { const v2u p = pp[s][d2][g4];
                            o0 += wsl[s] * bf_lo(p.x); o1 += wsl[s] * bf_hi(p.x); o2 += wsl[s] * bf_lo(p.y); o3 += wsl[s] * bf_hi(p.y); }
                        v2u w; w.x = pk2(o0 * inv, o1 * inv); w.y = pk2(o2 * inv, o3 * inv); *(v2u*)(op + 32 * dt + 8 * g4) = w;
                    }
            }
            __syncthreads();
        }
    }
    SEAM(5);

#if DBG == 2
    { DECL_PTRS; for (size_t i = (size_t)blk * 512 + tid; i < (size_t)T * DM; i += (size_t)G * 512) out[i] = __uint_as_float(((unsigned)AC[i] << 16)); return; }
#endif
    for (int rep_ = 0; rep_ < (IN(6) ? 1 + ((REP_MASK >> 6) & 1) : 0); ++rep_) { DECL_PTRS;
        pg8::Gemm g{AC, WOUT_T, T, DM, DM}; pg8::StaticOrder So; So.init(T, DM, G, blk);
        pg8::EpiResBf16Ssq<0> E{x, NBUF, DM, SSQ1, nullptr};
        pg8::gemm_phase<pg8::EpiResBf16Ssq<0>, pg8::StaticOrder, true, true>(lds, g, So, E, tid);
    }
    SEAM2(6, 8);
#if DBG == 3
    return;
#endif
    for (int rep_ = 0; rep_ < (IN(8) ? 1 + ((REP_MASK >> 8) & 1) : 0); ++rep_) { DECL_PTRS;
        pg8::Gemm g{NBUF, WQ_T, T, XW, DM}; pg8::StaticOrder So; So.init(T, XW, G, blk);
        pg8::EpiBf16X<0, 1> E{QC, XW, 0, 0, -1, nullptr, 1, 1, SSQ1};
        pg8::gemm_phase<pg8::EpiBf16X<0, 1>, pg8::StaticOrder, true, true>(lds, g, So, E, tid);
    }
    for (int rep_ = 0; rep_ < (IN(9) ? 1 + ((REP_MASK >> 9) & 1) : 0); ++rep_) { DECL_PTRS;
        asm volatile("s_waitcnt vmcnt(0)" ::: "memory"); __syncthreads();
        pg8::StaticOrder So8; So8.init(T, XW, G, blk); pg8::Unit u8;
        for (int ui = 0; So8.next(ui >> 1, u8); ++ui) {
            const int tl = u8.pm, hc = 2 * u8.pn + (ui & 1), b = tl / (S / 256);
            attn_stage(lds, KC + (size_t)(b * NMEM) * XW + hc * HD, XW, VCT + (size_t)((b * XH + hc) * HD) * NMEM, NMEM, nullptr, tid);
            __syncthreads();
            const int qrow = tl * 256 + wave * 32 + l31;
            f32x16 O[4]; float m, l;
            bf16x8 qf[8]; load_q(qf, QC + (size_t)qrow * XW + hc * HD, hi);
            attn_core<2>(lds, qf, 0, SC, 4, false, 0.f, O, m, l, lane);
            store_o16(OC + (size_t)qrow * XW + hc * HD, O, 1.0f / l, hi, true);
            __syncthreads();
        }
    }
    SEAM(9);
#if DBG == 10
    return;
#endif
#if DBG == 7
    { DECL_PTRS; for (size_t i = (size_t)blk * 512 + tid; i < (size_t)T * DM; i += (size_t)G * 512) { const size_t t = i >> 11, c = i & 2047; out[i] = c < 512 ? __uint_as_float(((unsigned)QC[t * 512 + c] << 16)) : 0.f; } return; }
#endif
#if DBG == 8
    { DECL_PTRS; for (size_t i = (size_t)blk * 512 + tid; i < (size_t)T * DM; i += (size_t)G * 512) { const size_t t = i >> 11, c = i & 2047; out[i] = c < 512 ? __uint_as_float(((unsigned)OC[t * 512 + c] << 16)) : 0.f; } return; }
#endif
#if DBG == 5
    { DECL_PTRS; for (size_t i = (size_t)blk * 512 + tid; i < (size_t)T * DM; i += (size_t)G * 512) { const size_t t = i >> 11, c = i & 2047; out[i] = c < 512 ? __uint_as_float(((unsigned)OC[t * 512 + c] << 16)) : (c < 1024 ? __uint_as_float(((unsigned)QC[t * 512 + c - 512] << 16)) : 0.f); } return; }
#endif
    for (int rep_ = 0; rep_ < (IN(10) ? 1 + ((REP_MASK >> 10) & 1) : 0); ++rep_) { DECL_PTRS;
        pg8::Gemm g{OC, WO_T, T, DM, XW}; pg8::StaticOrder So; So.init(T, DM, G, blk);
        pg8::EpiResBf16Ssq<1> E{NBUF, NBUF, DM, SSQ2, nullptr};
        pg8::gemm_phase<pg8::EpiResBf16Ssq<1>, pg8::StaticOrder, true, true>(lds, g, So, E, tid);
    }
    SEAM2(10, 12);
#if DBG == 4
    return;
#endif
    for (int rep_ = 0; rep_ < (IN(12) ? 1 + ((REP_MASK >> 12) & 1) : 0); ++rep_) { DECL_PTRS;
        pg8::Gemm g{NBUF, W1_T, T, FF, DM}; pg8::StaticOrder So; So.init(T, FF, G, blk);
        pg8::EpiBf16X<2, 0> E{FB, FF, 0, 0, -1, nullptr, 1, 1, nullptr};
        pg8::gemm_phase<pg8::EpiBf16X<2, 0>, pg8::StaticOrder, true, true>(lds, g, So, E, tid);
    }
    SEAM(12);
    for (int rep_ = 0; rep_ < (IN(13) ? 1 + ((REP_MASK >> 13) & 1) : 0); ++rep_) { DECL_PTRS;
        pg8::Gemm g{FB, W2_T, T, DM, FF}; pg8::StaticOrder So; So.init(T, DM, G, blk);
        pg8::EpiResBf16Ssq<1, 1> E{NBUF, NBUF, DM, SSQ3, SSQ2};
        pg8::gemm_phase<pg8::EpiResBf16Ssq<1, 1>, pg8::StaticOrder, true, true>(lds, g, So, E, tid);
    }
    SEAM(13);
    for (int rep_ = 0; rep_ < (IN(14) ? 1 : 0); ++rep_) { DECL_PTRS;
        const int gw = blk * 8 + wave, NGW = G * 8;
        f32x4 gv[8];
#pragma unroll
        for (int jj = 0; jj < 8; ++jj) gv[jj] = ((const f32x4*)g_final)[lane + 64 * jj];
        for (int mrow = gw; mrow < T; mrow += NGW) {
            const float rstd = 1.0f / sqrtf(SSQ3[mrow] * (1.0f / DM) + EPS);
            const v2u* hr = (const v2u*)(NBUF + (size_t)mrow * DM) + lane; f32x4* o = (f32x4*)(out + (size_t)mrow * DM) + lane;
            v2u hv[8];
#pragma unroll
            for (int jj = 0; jj < 8; ++jj) hv[jj] = hr[64 * jj];
#pragma unroll
            for (int jj = 0; jj < 8; ++jj) o[64 * jj] = (f32x4){bf_lo(hv[jj].x) * rstd * gv[jj].x, bf_hi(hv[jj].x) * rstd * gv[jj].y, bf_lo(hv[jj].y) * rstd * gv[jj].z, bf_hi(hv[jj].y) * rstd * gv[jj].w};
        }
    }
#undef IN
#undef SEAM
}

extern "C" void kernel_launch(void* const* d_in, const int* in_sizes, int n_in, void* d_out, int out_size, void* d_ws, size_t ws_size, hipStream_t stream) {
    static int grid = 0;
    if (grid == 0) {
        if (n_in != 20 || out_size != T * DM || ws_size < WS_END) { fprintf(stderr, "kernel_launch: unexpected sizes n_in %d out %d ws %zu\n", n_in, out_size, ws_size); grid = -1; return; }
        int dev = 0, cus = 0, per_cu = 0;
        (void)hipGetDevice(&dev); (void)hipDeviceGetAttribute(&cus, hipDeviceAttributeMultiprocessorCount, dev);
        (void)hipFuncSetAttribute((const void*)fwd, hipFuncAttributeMaxDynamicSharedMemorySize, LDS_BYTES);
        (void)hipOccupancyMaxActiveBlocksPerMultiprocessor(&per_cu, (const void*)fwd, 512, LDS_BYTES);
        if (per_cu < 1) { fprintf(stderr, "kernel_launch: occupancy query says %d blocks per CU\n", per_cu); per_cu = 1; }
        grid = cus;
        (void)hipGetLastError();
    }
    if (grid < 0) return;
    if (hipMemsetAsync((char*)d_ws + WS_CTL, 0, 1048576, stream) != hipSuccess) { fprintf(stderr, "kernel_launch: memset failed\n"); return; }
    Args a{};
    for (int i = 0; i < 20; ++i) a.in[i] = (const float*)d_in[i];
    a.out = (float*)d_out; a.ws = (unsigned char*)d_ws;
#if MK_PER_PHASE
    for (int p = 0; p < NPHASE; ++p) { if (p == 7 || p == 11) continue; a.ph_lo = p; a.ph_hi = p + 1; hipLaunchKernelGGL(fwd, dim3(grid), dim3(512), LDS_BYTES, stream, a); }
#else
    a.ph_lo = 0; a.ph_hi = NPHASE;
    void* args[] = {&a};
    hipError_t e = hipLaunchCooperativeKernel((const void*)fwd, dim3(grid), dim3(512), args, LDS_BYTES, stream);
    if (e != hipSuccess) fprintf(stderr, "kernel_launch: cooperative launch failed: %s (grid %d)\n", hipGetErrorString(e), grid);
#endif
}
```
